# Optimizing an MI355X kernel written in HIP

```python
import math
import jax, jax.numpy as jnp
from jax import lax
import numpy as np

D_MODEL = 1024
BATCH = 2
SEQ = 16384
DEPTH = 2

CTX_LEN = 256
GRID_W = 64
HEAD_DIM = 64
ROPE_BASE = 10000.0
NEG_INF = -1e30

A_HEADS = 8
A_KV_HEADS = 2
A_WINDOW = 128
A_BLOCK = 128
B_HEADS = 8
NA_ROWS = 8
NA_COLS = 16
C_HEADS = 8
C_Q_RANK = 384
C_KV_RANK = 256
C_NOPE = 64
C_ROPE = 32
C_V = 64
D_HEADS = 4
D_QK = 64
D_V = 128
Q_BLOCK = 128
N_GROUPS = 4
EXP_PER_GROUP = 8
N_EXPERTS = N_GROUPS * EXP_PER_GROUP
TOP_K = 2
D_EXPERT = 512
MOE_BLOCK = 128

DN_ALPHA = (2 * DEPTH) ** 0.25
DN_BETA = (8 * DEPTH) ** -0.25

A_QW = A_HEADS * HEAD_DIM
A_KVW = A_KV_HEADS * HEAD_DIM
B_W = B_HEADS * HEAD_DIM
AB_SPLITS = (A_QW, A_QW + A_KVW, A_QW + 2 * A_KVW, A_QW + 2 * A_KVW + B_W, A_QW + 2 * A_KVW + 2 * B_W)
AB_IN = A_QW + 2 * A_KVW + 3 * B_W
AB_OUT = A_QW + B_W
D_QW = D_HEADS * 2 * D_QK
D_VW = D_HEADS * D_V
CD_SPLITS = (C_Q_RANK, C_Q_RANK + C_KV_RANK, C_Q_RANK + C_KV_RANK + C_ROPE, C_Q_RANK + C_KV_RANK + C_ROPE + D_QW, C_Q_RANK + C_KV_RANK + C_ROPE + 2 * D_QW)
CD_IN = C_Q_RANK + C_KV_RANK + C_ROPE + 2 * D_QW + D_VW
CD_OUT = C_HEADS * C_V + D_VW
N_EVEN = (DEPTH + 1) // 2
N_ODD = DEPTH // 2

kernel_name = 'hybrid_dit_window_natten_mla_diff_hmoe'


def layer_norm(x, g, b, eps=1e-5):
    xf = x.astype(jnp.float32)
    mu = jnp.mean(xf, -1, keepdims=True)
    var = jnp.mean(jnp.square(xf - mu), -1, keepdims=True)
    return ((xf - mu) * lax.rsqrt(var + eps) * g + b).astype(x.dtype)


def rms_norm(x, g, eps=1e-6):
    xf = x.astype(jnp.float32)
    return (xf * lax.rsqrt(jnp.mean(xf * xf, -1, keepdims=True) + eps) * g).astype(x.dtype)


def axial_rope_tables(n_tok, dim):
    t = jnp.arange(n_tok)
    pos_r = (t // GRID_W).astype(jnp.float32)
    pos_c = (t % GRID_W).astype(jnp.float32)
    quarter = dim // 4
    inv = ROPE_BASE ** (-jnp.arange(quarter, dtype=jnp.float32) / quarter)
    ang_r = pos_r[:, None] * inv
    ang_c = pos_c[:, None] * inv
    ang = jnp.concatenate([ang_r, ang_r, ang_c, ang_c], -1)
    return jnp.cos(ang), jnp.sin(ang)


def apply_rope(x, cos, sin):
    r1, r2, c1, c2 = jnp.split(x, 4, axis=-1)
    rot = jnp.concatenate([-r2, r1, -c2, c1], -1)
    y = x.astype(jnp.float32) * cos[:, None] + rot.astype(jnp.float32) * sin[:, None]
    return y.astype(x.dtype)


def joint_softmax(parts):
    m = parts[0].max(-1, keepdims=True)
    for p in parts[1:]:
        m = jnp.maximum(m, p.max(-1, keepdims=True))
    es = [jnp.exp(p - m) for p in parts]
    denom = sum(e.sum(-1, keepdims=True) for e in es)
    return [e / denom for e in es]


def sweep_query_blocks(fn, q):
    Bn, S = q.shape[0], q.shape[1]
    nblk = S // Q_BLOCK
    qb = jnp.moveaxis(q.reshape((Bn, nblk, Q_BLOCK) + q.shape[2:]), 1, 0)
    out = lax.map(fn, qb)
    return jnp.moveaxis(out, 0, 1).reshape((Bn, S) + out.shape[3:])


def window_gqa(q, k, v, q_c, k_c, v_c, sink, need_ctx):
    Bn, S = q.shape[0], q.shape[1]
    L = k_c.shape[1]
    G = A_HEADS // A_KV_HEADS
    nblk = S // A_BLOCK
    scale = HEAD_DIM ** -0.5
    pad = ((0, 0), (A_BLOCK, A_BLOCK), (0, 0), (0, 0))

    def band(t):
        tb = jnp.pad(t, pad).reshape(Bn, nblk + 2, A_BLOCK, A_KV_HEADS, HEAD_DIM)
        return jnp.concatenate([tb[:, :-2], tb[:, 1:-1], tb[:, 2:]], axis=2)

    kb, vb = band(k), band(v)
    qb = q.reshape(Bn, nblk, A_BLOCK, A_KV_HEADS, G, HEAD_DIM)
    s_loc = jnp.einsum('bnqhgd,bnkhd->bnhgqk', qb, kb).astype(jnp.float32) * scale
    qi = jnp.arange(A_BLOCK)
    kj = jnp.arange(3 * A_BLOCK)
    rel = kj[None, :] - A_BLOCK - qi[:, None]
    kpos = jnp.arange(nblk)[:, None] * A_BLOCK + kj[None, :] - A_BLOCK
    valid = (jnp.abs(rel)[None] <= A_WINDOW) & ((kpos >= 0) & (kpos < S))[:, None, :]
    s_loc = jnp.where(valid[None, :, None, None], s_loc, NEG_INF)
    s_ctx = jnp.einsum('bnqhgd,blhd->bnhgql', qb, k_c).astype(jnp.float32) * scale
    s_sink = jnp.broadcast_to(sink.astype(jnp.float32).reshape(A_KV_HEADS, G, 1, 1), s_ctx.shape[:-1] + (1,))
    _, p_ctx, p_loc = joint_softmax([s_sink, s_ctx, s_loc])
    o = (jnp.einsum('bnhgql,blhd->bnqhgd', p_ctx.astype(v.dtype), v_c)
         + jnp.einsum('bnhgqk,bnkhd->bnqhgd', p_loc.astype(v.dtype), vb))
    o = o.reshape(Bn, S, A_HEADS * HEAD_DIM)
    o_c = None
    if need_ctx:
        qc = q_c.reshape(Bn, L, A_KV_HEADS, G, HEAD_DIM)
        sc = jnp.einsum('blhgd,bmhd->bhglm', qc, k_c).astype(jnp.float32) * scale
        sc_sink = jnp.broadcast_to(sink.astype(jnp.float32).reshape(A_KV_HEADS, G, 1, 1), sc.shape[:-1] + (1,))
        _, pc = joint_softmax([sc_sink, sc])
        o_c = jnp.einsum('bhglm,bmhd->blhgd', pc.astype(v.dtype), v_c).reshape(Bn, L, A_HEADS * HEAD_DIM)
    return o, o_c


def neighbourhood_attn(q, k, v, q_c, k_c, v_c, rpb, need_ctx):
    Bn, S = q.shape[0], q.shape[1]
    L = k_c.shape[1]
    rows = S // GRID_W
    kr = min(NA_ROWS, rows)
    scale = HEAD_DIM ** -0.5
    qg = q.reshape(Bn, rows, GRID_W, B_HEADS, HEAD_DIM)
    r = jnp.arange(rows)
    row_idx = jnp.clip(r - kr // 2, 0, rows - kr)[:, None] + jnp.arange(kr)[None, :]
    kg = k.reshape(Bn, rows, GRID_W, B_HEADS, HEAD_DIM)[:, row_idx]
    vg = v.reshape(Bn, rows, GRID_W, B_HEADS, HEAD_DIM)[:, row_idx]
    s_loc = jnp.einsum('brqhd,brxkhd->brhqxk', qg, kg).astype(jnp.float32) * scale
    col = jnp.arange(GRID_W)
    col_start = jnp.clip(col - NA_COLS // 2, 0, GRID_W - NA_COLS)
    valid = (col[None, :] >= col_start[:, None]) & (col[None, :] < col_start[:, None] + NA_COLS)
    dr = row_idx - r[:, None] + (NA_ROWS - 1)
    dc = jnp.clip(col[None, :] - col[:, None], -(NA_COLS - 1), NA_COLS - 1) + (NA_COLS - 1)
    bias = rpb.astype(jnp.float32)[:, dr][:, :, :, dc]
    s_loc = jnp.where(valid[:, None, :], s_loc + bias.transpose(1, 0, 3, 2, 4), NEG_INF)
    s_loc = s_loc.reshape(Bn, rows, B_HEADS, GRID_W, kr * GRID_W)
    s_ctx = jnp.einsum('brqhd,blhd->brhql', qg, k_c).astype(jnp.float32) * scale
    p_ctx, p_loc = joint_softmax([s_ctx, s_loc])
    p_loc = p_loc.reshape(Bn, rows, B_HEADS, GRID_W, kr, GRID_W)
    o = (jnp.einsum('brhql,blhd->brqhd', p_ctx.astype(v.dtype), v_c)
         + jnp.einsum('brhqxk,brxkhd->brqhd', p_loc.astype(v.dtype), vg))
    o = o.reshape(Bn, S, B_HEADS * HEAD_DIM)
    o_c = None
    if need_ctx:
        sc = jnp.einsum('blhd,bmhd->bhlm', q_c, k_c).astype(jnp.float32) * scale
        pc = jax.nn.softmax(sc, axis=-1).astype(v.dtype)
        o_c = jnp.einsum('bhlm,bmhd->blhd', pc, v_c).reshape(Bn, L, B_HEADS * HEAD_DIM)
    return o, o_c


def mixer_ab(h, hc, w_in, sink, rpb, w_out, cos, sin, need_ctx):
    Bn, S = h.shape[0], h.shape[1]
    L = hc.shape[1]

    def project(t, n):
        aq, ak, av, bq, bk, bv = jnp.split(t @ w_in, AB_SPLITS, axis=-1)
        return (aq.reshape(Bn, n, A_HEADS, HEAD_DIM), ak.reshape(Bn, n, A_KV_HEADS, HEAD_DIM),
                av.reshape(Bn, n, A_KV_HEADS, HEAD_DIM), bq.reshape(Bn, n, B_HEADS, HEAD_DIM),
                bk.reshape(Bn, n, B_HEADS, HEAD_DIM), bv.reshape(Bn, n, B_HEADS, HEAD_DIM))

    aq, ak, av, bq, bk, bv = project(h, S)
    aqc, akc, avc, bqc, bkc, bvc = project(hc, L)
    aq = apply_rope(aq, cos, sin)
    ak = apply_rope(ak, cos, sin)
    oa, oac = window_gqa(aq, ak, av, aqc, akc, avc, sink, need_ctx)
    ob, obc = neighbourhood_attn(bq, bk, bv, bqc, bkc, bvc, rpb, need_ctx)
    y = jnp.concatenate([oa, ob], -1) @ w_out
    yc = jnp.concatenate([oac, obc], -1) @ w_out if need_ctx else None
    return y, yc


def mla_attend(q, k, v):
    s = jnp.einsum('bqhd,bkhd->bhqk', q, k).astype(jnp.float32) * (C_NOPE + C_ROPE) ** -0.5
    p = jax.nn.softmax(s, axis=-1).astype(v.dtype)
    return jnp.einsum('bhqk,bkhd->bqhd', p, v)


def diff_attend(q, k, v, lam):
    s = jnp.einsum('bqhid,bkhid->bhiqk', q, k).astype(jnp.float32) * D_QK ** -0.5
    p = jax.nn.softmax(s, axis=-1)
    pd = (p[:, :, 0] - lam * p[:, :, 1]).astype(v.dtype)
    return jnp.einsum('bhqk,bkhd->bqhd', pd, v)


def mixer_cd(h, hc, w_in, q_norm, w_uq, kv_norm, w_ukv, lam_p, subln, w_out,
             cos32, sin32, cos64, sin64, lam_init, need_ctx):
    Bn, S = h.shape[0], h.shape[1]
    L = hc.shape[1]

    def project(t, n, rope):
        cq, ckv, krope, dq, dk, dv = jnp.split(t @ w_in, CD_SPLITS, axis=-1)
        q = (rms_norm(cq, q_norm) @ w_uq).reshape(Bn, n, C_HEADS, C_NOPE + C_ROPE)
        kv = (rms_norm(ckv, kv_norm) @ w_ukv).reshape(Bn, n, C_HEADS, C_NOPE + C_V)
        q_nope, q_rope = jnp.split(q, [C_NOPE], axis=-1)
        k_nope, cv = jnp.split(kv, [C_NOPE], axis=-1)
        k_rope = krope.reshape(Bn, n, 1, C_ROPE)
        dq = dq.reshape(Bn, n, 2 * D_HEADS, D_QK)
        dk = dk.reshape(Bn, n, 2 * D_HEADS, D_QK)
        if rope:
            q_rope = apply_rope(q_rope, cos32, sin32)
            k_rope = apply_rope(k_rope, cos32, sin32)
            dq = apply_rope(dq, cos64, sin64)
            dk = apply_rope(dk, cos64, sin64)
        cq_full = jnp.concatenate([q_nope, q_rope], -1)
        ck_full = jnp.concatenate([k_nope, jnp.broadcast_to(k_rope, (Bn, n, C_HEADS, C_ROPE))], -1)
        return (cq_full, ck_full, cv, dq.reshape(Bn, n, D_HEADS, 2, D_QK),
                dk.reshape(Bn, n, D_HEADS, 2, D_QK), dv.reshape(Bn, n, D_HEADS, D_V))

    cq, ck, cv, dq, dk, dv = project(h, S, True)
    cqc, ckc, cvc, dqc, dkc, dvc = project(hc, L, False)
    lp = lam_p.astype(jnp.float32)
    lam = jnp.exp(jnp.sum(lp[0] * lp[1])) - jnp.exp(jnp.sum(lp[2] * lp[3])) + lam_init

    ck_all = jnp.concatenate([ckc, ck], 1)
    cv_all = jnp.concatenate([cvc, cv], 1)
    dk_all = jnp.concatenate([dkc, dk], 1)
    dv_all = jnp.concatenate([dvc, dv], 1)
    oc = sweep_query_blocks(lambda qb: mla_attend(qb, ck_all, cv_all), cq)
    od = sweep_query_blocks(lambda qb: diff_attend(qb, dk_all, dv_all, lam), dq)
    od = rms_norm(od, subln) * (1.0 - lam_init)
    y = jnp.concatenate([oc.reshape(Bn, S, C_HEADS * C_V), od.reshape(Bn, S, D_VW)], -1) @ w_out
    yc = None
    if need_ctx:
        occ = mla_attend(cqc, ckc, cvc).reshape(Bn, L, C_HEADS * C_V)
        odc = rms_norm(diff_attend(dqc, dkc, dvc, lam), subln) * (1.0 - lam_init)
        yc = jnp.concatenate([occ, odc.reshape(Bn, L, D_VW)], -1) @ w_out
    return y, yc


def hier_moe(h, w_group, b_group, w_er, b_er, w_gu, w_dn):
    T, D = h.shape
    g_prob = jax.nn.softmax((h @ w_group + b_group).astype(jnp.float32), axis=-1)
    g_val, g_idx = lax.top_k(g_prob, 1)
    g_val, g_idx = g_val[:, 0], g_idx[:, 0]
    e_logits = (h @ w_er + b_er).astype(jnp.float32).reshape(T, N_GROUPS, EXP_PER_GROUP)
    e_prob = jax.nn.softmax(e_logits[jnp.arange(T), g_idx], axis=-1)
    e_val, e_idx = lax.top_k(e_prob, TOP_K)
    wts = g_val[:, None] * e_val / e_val.sum(-1, keepdims=True)
    experts = g_idx[:, None] * EXP_PER_GROUP + e_idx

    A = T * TOP_K
    flat_e = experts.reshape(-1)
    flat_tok = jnp.broadcast_to(jnp.arange(T)[:, None], (T, TOP_K)).reshape(-1)
    flat_w = wts.reshape(-1)
    order = jnp.argsort(flat_e)
    se, stok, sw = flat_e[order], flat_tok[order], flat_w[order]
    counts = jnp.bincount(flat_e, length=N_EXPERTS)
    starts = jnp.cumsum(counts) - counts
    pcounts = ((counts + MOE_BLOCK - 1) // MOE_BLOCK) * MOE_BLOCK
    pends = jnp.cumsum(pcounts)
    pstarts = pends - pcounts
    dest = pstarts[se] + (jnp.arange(A) - starts[se])
    NB = -(-A // MOE_BLOCK) + N_EXPERTS
    R = NB * MOE_BLOCK
    row_tok = jnp.full((R,), T, jnp.int32).at[dest].set(stok)
    row_w = jnp.zeros((R,), h.dtype).at[dest].set(sw.astype(h.dtype))
    block_e = jnp.minimum(jnp.searchsorted(pends, jnp.arange(NB) * MOE_BLOCK, side='right'), N_EXPERTS - 1)
    h_pad = jnp.concatenate([h, jnp.zeros((1, D), h.dtype)], 0)
    xs = h_pad[row_tok].reshape(NB, MOE_BLOCK, D)

    def expert_block(args):
        xb, e = args
        gate, up = jnp.split(xb @ w_gu[e], 2, axis=-1)
        return (jax.nn.silu(gate) * up) @ w_dn[e]

    ys = lax.map(expert_block, (xs, block_e)).reshape(R, D)
    out = jnp.zeros((T + 1, D), h.dtype).at[row_tok].add(ys * row_w[:, None])
    return out[:T]


def setup_inputs(seed: int = 0) -> dict:
    key = jax.random.key(seed)
    ks = jax.random.split(key, 26)
    f32 = jnp.float32
    D = D_MODEL

    def nrm(k, shape, scale):
        return jax.random.normal(k, shape, f32) * scale

    return {
        'x': nrm(ks[0], (BATCH, SEQ, D), 1.0),
        'c': nrm(ks[1], (BATCH, D), 1.0),
        'ctx': nrm(ks[2], (BATCH, CTX_LEN, D), 1.0),
        'c_ctx': nrm(ks[3], (D,), 1.0),
        'w_ada': nrm(ks[4], (DEPTH, D, 6 * D), 0.5 * D ** -0.5),
        'b_ada': nrm(ks[5], (DEPTH, 6 * D), 0.02),
        'ln_g': 1.0 + nrm(ks[6], (DEPTH, 2, D), 0.02),
        'ln_b': nrm(ks[7], (DEPTH, 2, D), 0.02),
        'ab_w_in': nrm(ks[8], (N_EVEN, D, AB_IN), D ** -0.5),
        'a_sink': nrm(ks[9], (N_EVEN, A_HEADS), 0.5),
        'b_rpb': nrm(ks[10], (N_EVEN, B_HEADS, 2 * NA_ROWS - 1, 2 * NA_COLS - 1), 0.1),
        'ab_w_out': nrm(ks[11], (N_EVEN, AB_OUT, D), DN_BETA * AB_OUT ** -0.5),
        'cd_w_in': nrm(ks[12], (N_ODD, D, CD_IN), D ** -0.5),
        'c_q_norm': 1.0 + nrm(ks[13], (N_ODD, C_Q_RANK), 0.02),
        'c_w_uq': nrm(ks[14], (N_ODD, C_Q_RANK, C_HEADS * (C_NOPE + C_ROPE)), C_Q_RANK ** -0.5),
        'c_kv_norm': 1.0 + nrm(ks[15], (N_ODD, C_KV_RANK), 0.02),
        'c_w_ukv': nrm(ks[16], (N_ODD, C_KV_RANK, C_HEADS * (C_NOPE + C_V)), C_KV_RANK ** -0.5),
        'd_lambda': nrm(ks[17], (N_ODD, 4, D_QK), 0.1),
        'd_subln': 1.0 + nrm(ks[18], (N_ODD, D_V), 0.02),
        'cd_w_out': nrm(ks[19], (N_ODD, CD_OUT, D), DN_BETA * CD_OUT ** -0.5),
        'w_group': nrm(ks[20], (DEPTH, D, N_GROUPS), D ** -0.5),
        'b_group': nrm(ks[21], (DEPTH, N_GROUPS), 0.01),
        'w_exp_router': nrm(ks[22], (DEPTH, D, N_EXPERTS), D ** -0.5),
        'b_exp_router': nrm(ks[23], (DEPTH, N_EXPERTS), 0.01),
        'w_gate_up': nrm(ks[24], (DEPTH, N_EXPERTS, D, 2 * D_EXPERT), D ** -0.5),
        'w_down': nrm(ks[25], (DEPTH, N_EXPERTS, D_EXPERT, D), DN_BETA * D_EXPERT ** -0.5),
    }


def reference(x, c, ctx, c_ctx, w_ada, b_ada, ln_g, ln_b, ab_w_in, a_sink, b_rpb, ab_w_out,
              cd_w_in, c_q_norm, c_w_uq, c_kv_norm, c_w_ukv, d_lambda, d_subln, cd_w_out,
              w_group, b_group, w_exp_router, b_exp_router, w_gate_up, w_down):
    Bn, S, D = x.shape
    L = ctx.shape[1]
    cos64, sin64 = axial_rope_tables(S, HEAD_DIM)
    cos32, sin32 = axial_rope_tables(S, C_ROPE)
    for l in range(DEPTH):
        need_ctx = l < DEPTH - 1
        mod = jax.nn.silu(c) @ w_ada[l] + b_ada[l]
        mod_c = jax.nn.silu(c_ctx) @ w_ada[l] + b_ada[l]
        sh1, sc1, g1, sh2, sc2, g2 = [m[:, None, :] for m in jnp.split(mod, 6, axis=-1)]
        sh1c, sc1c, g1c, sh2c, sc2c, g2c = jnp.split(mod_c, 6, axis=-1)

        h = x * (1.0 + sc1) + sh1
        hc = ctx * (1.0 + sc1c) + sh1c
        if l % 2 == 0:
            e = l // 2
            y, yc = mixer_ab(h, hc, ab_w_in[e], a_sink[e], b_rpb[e], ab_w_out[e], cos64, sin64, need_ctx)
        else:
            o = l // 2
            lam_init = 0.8 - 0.6 * math.exp(-0.3 * l)
            y, yc = mixer_cd(h, hc, cd_w_in[o], c_q_norm[o], c_w_uq[o], c_kv_norm[o], c_w_ukv[o],
                             d_lambda[o], d_subln[o], cd_w_out[o], cos32, sin32, cos64, sin64,
                             lam_init, need_ctx)
        x = layer_norm(DN_ALPHA * x + g1 * y, ln_g[l, 0], ln_b[l, 0])
        if need_ctx:
            ctx = layer_norm(DN_ALPHA * ctx + g1c * yc, ln_g[l, 0], ln_b[l, 0])

        h = (x * (1.0 + sc2) + sh2).reshape(Bn * S, D)
        if need_ctx:
            hc = (ctx * (1.0 + sc2c) + sh2c).reshape(Bn * L, D)
            h = jnp.concatenate([h, hc], 0)
        y_all = hier_moe(h, w_group[l], b_group[l], w_exp_router[l], b_exp_router[l], w_gate_up[l], w_down[l])
        y = y_all[:Bn * S].reshape(Bn, S, D)
        x = layer_norm(DN_ALPHA * x + g2 * y, ln_g[l, 1], ln_b[l, 1])
        if need_ctx:
            yc = y_all[Bn * S:].reshape(Bn, L, D)
            ctx = layer_norm(DN_ALPHA * ctx + g2c * yc, ln_g[l, 1], ln_b[l, 1])
    return x
```

```cpp
#include <hip/hip_runtime.h>
#include <cstdio>
#include <cstdint>

#define GAS __attribute__((address_space(1)))
#define LAS __attribute__((address_space(3)))
typedef unsigned short bf16_t;
typedef short bf16x8 __attribute__((ext_vector_type(8)));
typedef short s16x4 __attribute__((ext_vector_type(4)));
typedef float f32x4 __attribute__((ext_vector_type(4)));
typedef float f32x2 __attribute__((ext_vector_type(2)));
typedef float f32x16 __attribute__((ext_vector_type(16)));
typedef unsigned u32x4 __attribute__((ext_vector_type(4)));
typedef unsigned u32x2 __attribute__((ext_vector_type(2)));
typedef __bf16 bf16x2_t __attribute__((ext_vector_type(2)));
typedef short v4i16_t __attribute__((ext_vector_type(4)));
typedef GAS unsigned gu32;
#define RLX_AGENT __ATOMIC_RELAXED, __HIP_MEMORY_SCOPE_AGENT
#define DI __device__ __forceinline__

constexpr int DM = 1024, NB = 2, SEQ = 16384, CTXL = 256;
constexpr int RB = SEQ + CTXL;
constexpr int MU = NB * RB;
constexpr int NEXP = 32, DEXP = 512;
constexpr float LOG2E = 1.4426950408889634f;
constexpr float DN_ALPHA = 1.4142135623730951f;
constexpr float LAM_INIT = 0.8f - 0.6f * 0.7408182206817179f;
constexpr int NQKV = 2304;
constexpr int LIST_CAP = MU;
constexpr int RMAX = 74752;

constexpr size_t MiB = 1u << 20;
constexpr size_t WS_CTL = 0, CTL_ZERO_BYTES = 64 * 1024;
constexpr size_t WS_MOD = 1 * MiB;
constexpr size_t WS_ROPE = 1 * MiB + 256 * 1024;
constexpr size_t WS_TOKINFO = 2 * MiB;
constexpr size_t WS_LIST = 4 * MiB;
constexpr size_t WS_WAB_IN = 10 * MiB, WS_WAB_OUT = 15 * MiB, WS_WCD_IN = 17 * MiB, WS_WCD_OUT = 22 * MiB, WS_WUQ = 24 * MiB, WS_WUKV = 25 * MiB;
constexpr size_t WS_WGU = 26 * MiB;
constexpr size_t WS_WDN = 154 * MiB;
constexpr size_t WS_XA = 218 * MiB, WS_XB = 348 * MiB;
constexpr size_t WS_H = 478 * MiB;
constexpr size_t WS_AO = 543 * MiB;
constexpr size_t WS_S = 608 * MiB;
constexpr size_t WS_QKV = WS_S;
constexpr size_t WS_QM = WS_S + 147 * MiB;
constexpr size_t WS_KVM = WS_S + 196 * MiB;
constexpr size_t WS_YP = WS_S;
constexpr size_t WS_ACT = WS_S + 65 * MiB;
constexpr size_t WS_YS = WS_S + 138 * MiB;
constexpr size_t WS_END = WS_S + 284 * MiB;
constexpr size_t WS_VT8M = 892 * MiB, WS_VT8D = 910 * MiB;
constexpr size_t WS_K8M = 928 * MiB, WS_K8D = 946 * MiB, WS_K8R = 964 * MiB;
constexpr size_t WS_Q8M = WS_QM, WS_Q8D = WS_QM + 26 * MiB;
constexpr size_t WS_Q8A = WS_QM, WS_Q8B = WS_QM + 17 * MiB, WS_K8A = WS_K8D, WS_K8B = WS_K8M, WS_VT8A = WS_VT8D, WS_VT8B = WS_VT8M;
static_assert(WS_YS + (size_t)RMAX * 1024 * 2 <= WS_END && WS_KVM + (size_t)MU * 1024 * 2 <= WS_END && WS_QM + (size_t)MU * 768 * 2 <= WS_KVM && WS_QKV + (size_t)MU * NQKV * 2 <= WS_QM, "ws map");
static_assert(WS_ACT + (size_t)RMAX * 512 * 2 <= WS_YS && WS_YP + (size_t)MU * 1024 * 2 <= WS_ACT, "ws map 2");

constexpr int CW_TMO = 0, CW_CODE = 1;
constexpr int CW_BAR = 4096;
constexpr int CW_CNT = 8192;

constexpr int RING_BYTES = 131072;
constexpr int LDS_AUX = RING_BYTES;
constexpr int LDS_MISC = 159744 - 64;
constexpr int LDS_BYTES = 159744;

DI unsigned cvtpk(float lo, float hi) { f32x2 v = {lo, hi}; bf16x2_t b = __builtin_convertvector(v, bf16x2_t); return __builtin_bit_cast(unsigned, b); }
DI float bf_lo(unsigned u) { return __uint_as_float(u << 16); }
DI float bf_hi(unsigned u) { return __uint_as_float(u & 0xffff0000u); }
DI float wave_sum(float v) {
#pragma unroll
    for (int o = 1; o < 64; o <<= 1) v += __shfl_xor(v, o);
    return v;
}
DI float fast_exp2(float x) { return __builtin_amdgcn_exp2f(x); }
DI float fast_rcp(float x) { return __builtin_amdgcn_rcpf(x); }

#define XB_TMO      128
#define XB_XCNT(j)  (256  + 64 * (j))
#define XB_XSUB(j)  (1280 + 64 * (j))
#define XB_XGEN(j)  (2304 + 64 * (j))
#define XB_TOP      3328
#define XB_TOPGEN   3392
#define XCD_BAR_WORDS 3456
#define XB_SPIN_CAP (1u << 22)

DI unsigned xb_ld(unsigned* p)              { return __hip_atomic_load(p, __ATOMIC_RELAXED, __HIP_MEMORY_SCOPE_AGENT); }
DI unsigned xb_add(unsigned* p, unsigned v) { return __hip_atomic_fetch_add(p, v, __ATOMIC_RELAXED, __HIP_MEMORY_SCOPE_AGENT); }
DI unsigned xb_xcc_id() { return (unsigned)__builtin_amdgcn_s_getreg((3 << 11) | 20) & 0xFu; }
#define XB_SPIN(cond, bar) do { unsigned _sp = 0; while (cond) { __builtin_amdgcn_s_sleep(1); \
    if ((++_sp & 255u) == 0u) { if (xb_ld(&(bar)[XB_TMO])) break; if (_sp > XB_SPIN_CAP) { atomicAdd(&(bar)[XB_TMO], 1u); break; } } } } while (0)

struct XcdBarrier { unsigned* bar; unsigned x; volatile LAS unsigned* st; };

DI XcdBarrier xcd_barrier_post(unsigned* bar, volatile LAS unsigned* st) {
    XcdBarrier b; b.bar = bar; b.x = xb_xcc_id(); b.st = st;
    if (threadIdx.x == 0) (void)xb_add(&bar[XB_XCNT(b.x)], 1u);
    return b;
}
DI void xcd_barrier_complete(unsigned* bar, unsigned x, unsigned& nloc, unsigned& nx) {
    const unsigned G = gridDim.x * gridDim.y * gridDim.z;
    unsigned sum, cnt, mine, sp = 0u;
    for (;;) {
        sum = 0u; cnt = 0u; mine = 0u;
#pragma unroll
        for (unsigned j = 0; j < 16; ++j) { const unsigned c = xb_ld(&bar[XB_XCNT(j)]); sum += c; cnt += (c > 0u) ? 1u : 0u; mine = (j == x) ? c : mine; }
        if (sum == G) break;
        __builtin_amdgcn_s_sleep(1);
        if ((++sp & 255u) == 0u) { if (xb_ld(&bar[XB_TMO])) break; if (sp > XB_SPIN_CAP) { atomicAdd(&bar[XB_TMO], 1u); break; } }
    }
    nloc = mine > 0u ? mine : 1u; nx = cnt > 0u ? cnt : 1u;
}
DI void xcd_barrier(const XcdBarrier& b) {
    asm volatile("s_waitcnt vmcnt(0)" ::: "memory");
    __syncthreads();
    if (threadIdx.x == 0) {
        unsigned* bar = b.bar;
        __builtin_amdgcn_s_waitcnt(0);
        unsigned nloc = b.st[0], nx = b.st[1];
        if (nloc == 0u) { xcd_barrier_complete(bar, b.x, nloc, nx); b.st[0] = nloc; b.st[1] = nx; }
        const unsigned old = xb_add(&bar[XB_XSUB(b.x)], 1u);
        const unsigned gen = old / nloc;
        if (old + 1u == (gen + 1u) * nloc) {
            __builtin_amdgcn_fence(__ATOMIC_RELEASE, "agent");
            asm volatile("s_waitcnt vmcnt(0)" ::: "memory");
            const unsigned og = xb_add(&bar[XB_TOP], 1u);
            const unsigned tg = og / nx;
            if (og + 1u == (tg + 1u) * nx) xb_add(&bar[XB_TOPGEN], 1u);
            else XB_SPIN(xb_ld(&bar[XB_TOPGEN]) == tg, bar);
            __builtin_amdgcn_fence(__ATOMIC_ACQUIRE, "agent");
            xb_add(&bar[XB_XGEN(b.x)], 1u);
            asm volatile("s_waitcnt vmcnt(0)" ::: "memory");
        } else {
            XB_SPIN(xb_ld(&bar[XB_XGEN(b.x)]) == gen, bar);
            __builtin_amdgcn_fence(__ATOMIC_ACQUIRE, "agent");
            asm volatile("s_waitcnt vmcnt(0)" ::: "memory");
        }
    }
    __syncthreads();
}

namespace pg8 {
constexpr int BM = 256, BK = 64, HALF = 128, HTB = HALF * BK * 2, STAGE_BYTES = 8 * HTB, NXCD = 8, WGM = 8;
__host__ __device__ __forceinline__ int lds_byte(int r, int c) { const int st = (r >> 4) * 2 + (c >> 5), rr = r & 15, cc = c & 31, ob = rr * 64 + cc * 2; return st * 1024 + (ob ^ (((ob >> 9) & 1) << 5)); }
__host__ __device__ __forceinline__ void stage_rc(int b, int& R, int& C) { const int st = b / 1024, sb = b % 1024, swz = sb ^ (((sb >> 9) & 1) << 5); R = (st >> 1) * 16 + swz / 64; C = (st & 1) * 32 + (swz % 64) / 2; }
__host__ __device__ __forceinline__ int perm32(int rho) { const int n = rho >> 4, i = rho & 15; return 8 * (i >> 2) + 4 * n + (i & 3); }

typedef int v8i_g __attribute__((ext_vector_type(8)));
struct Unit { int pm, pn; const char* A; const char* B; int aux0, aux1; };

struct DenseOrder {
    int nM, nN, nwg, G, c; bool latent_only; const char* A; const char* Bt; size_t tstepA, tstepB;
    DI void init(int nM_, int nN_, int G_, int c_, bool lat, const void* A_, int lda, const void* Bt_, int K) {
        nM = nM_; nN = nN_; nwg = nM * nN; G = G_; c = c_; latent_only = lat; A = (const char*)A_; Bt = (const char*)Bt_; tstepA = (size_t)BM * lda * 2; tstepB = (size_t)BM * K * 2; }
    DI bool next(int i, Unit& u) const {
        const long L = (long)i * G + c; if (L >= nwg) return false;
        int wgid = (int)L; { const int q = nwg / NXCD, r = nwg % NXCD, xcd = wgid % NXCD, off = wgid / NXCD; wgid = (xcd < r ? xcd * (q + 1) : r * (q + 1) + (xcd - r) * q) + off; }
        const int nig = WGM * nN, gid = wgid / nig, fm = gid * WGM, gsz = (nM - fm) < WGM ? (nM - fm) : WGM;
        int pm = fm + ((wgid % nig) % gsz); const int pn = (wgid % nig) / gsz;
        if (latent_only) pm = pm + 1 + (pm >= 64 ? 1 : 0);
        u.pm = pm; u.pn = pn; u.A = A + (size_t)pm * tstepA; u.B = Bt + (size_t)pn * tstepB; u.aux0 = 0; u.aux1 = 0; return true;
    }
    DI unsigned gather(const Unit&, int) const { return 0u; }
};

template <class Epi, class Sched, bool GATHER, bool F8 = false>
DI void gemm_phase(LAS unsigned char* lds, const int lda, const int K, const Sched& S, const Epi& E, const int sc_x8 = 0x7f7f7f7f) {
    const int tid = threadIdx.x, wid = __builtin_amdgcn_readfirstlane(tid >> 6), lane = tid & 63, wr = wid >> 2, wc = wid & 3, fr = lane & 15, fq = lane >> 4;
    const int nt = K / BK;
    int RR[2], CC[2]; unsigned voffB[2];
#pragma unroll
    for (int i = 0; i < 2; ++i) { stage_rc(tid * 16 + i * 8192, RR[i], CC[i]); const int Rb = Epi::PERM ? ((RR[i] & ~31) + perm32(RR[i] & 31)) : RR[i]; voffB[i] = (unsigned)(Rb * K + CC[i]) * 2u; }
    unsigned cv0[2], cv1[2], nv0[2], nv1[2];
    const size_t kstep = (size_t)(BK * 2);
    const size_t hstepB = (size_t)HALF * K * 2;
    const unsigned ldsw = (unsigned)wid * 1024u;
    const int aoff = lds_byte(wr * 64 + fr, fq * 8), boff = lds_byte(wc * 32 + fr, fq * 8);
#define PG8_SA(b, h) (((b) * 2 + (h)) * HTB)
#define PG8_SB(b, h) ((4 + (b) * 2 + (h)) * HTB)
#define PG8_STAGE(bufoff, gbase, voff) do { _Pragma("unroll") for (int _i = 0; _i < 2; ++_i) \
        __builtin_amdgcn_global_load_lds((const unsigned*)((const char*)(gbase) + (voff)[_i]), (LAS unsigned*)(lds + (bufoff) + ldsw + _i * 8192), 16, 0, 0); } while (0)
#define PG8_LDA(dst, b, h) do { _Pragma("unroll") for (int m = 0; m < 4; ++m) _Pragma("unroll") for (int k = 0; k < 2; ++k) dst[m][k] = *(const LAS bf16x8*)(lds + PG8_SA(b, h) + aoff + m * 2048 + k * 1024); } while (0)
#define PG8_LDB(dst, b, h) do { _Pragma("unroll") for (int n = 0; n < 2; ++n) _Pragma("unroll") for (int k = 0; k < 2; ++k) dst[n][k] = *(const LAS bf16x8*)(lds + PG8_SB(b, h) + boff + n * 2048 + k * 1024); } while (0)
#define PG8_MMA(ai, bj, At, Bt) do { __builtin_amdgcn_s_setprio(1); _Pragma("unroll") for (int m = 0; m < 4; ++m) _Pragma("unroll") for (int n = 0; n < 2; ++n) { \
        if (F8) { const u32x4 b0_ = __builtin_bit_cast(u32x4, Bt[n][0]), b1_ = __builtin_bit_cast(u32x4, Bt[n][1]), a0_ = __builtin_bit_cast(u32x4, At[m][0]), a1_ = __builtin_bit_cast(u32x4, At[m][1]); \
            const v8i_g wf_ = (v8i_g){(int)b0_[0], (int)b0_[1], (int)b0_[2], (int)b0_[3], (int)b1_[0], (int)b1_[1], (int)b1_[2], (int)b1_[3]}; \
            const v8i_g xf_ = (v8i_g){(int)a0_[0], (int)a0_[1], (int)a0_[2], (int)a0_[3], (int)a1_[0], (int)a1_[1], (int)a1_[2], (int)a1_[3]}; \
            asm volatile("v_mfma_scale_f32_16x16x128_f8f6f4 %0, %1, %2, %0, %3, %4 op_sel_hi:[0,0,0]" : "+v"(acc[ai][bj][m][n]) : "v"(wf_), "v"(xf_), "v"(sc_w8), "v"(sc_x8)); } \
        else { _Pragma("unroll") for (int k = 0; k < 2; ++k) acc[ai][bj][m][n] = __builtin_amdgcn_mfma_f32_16x16x32_bf16(Bt[n][k], At[m][k], acc[ai][bj][m][n], 0, 0, 0); } } \
        __builtin_amdgcn_s_setprio(0); } while (0)
#define PG8_WAIT_V(n) asm volatile("s_waitcnt vmcnt(" #n ")" ::: "memory")
#define PG8_WAIT_L(n) asm volatile("s_waitcnt lgkmcnt(" #n ")" ::: "memory")
#define PG8_BAR __builtin_amdgcn_s_barrier()
#define PG8_SCHED __builtin_amdgcn_sched_barrier(0)
#define PG8_SETV(v0, v1, u) do { _Pragma("unroll") for (int _i = 0; _i < 2; ++_i) { \
        if (GATHER) { v0[_i] = S.gather(u, RR[_i]) + (unsigned)CC[_i] * 2u; v1[_i] = S.gather(u, HALF + RR[_i]) + (unsigned)CC[_i] * 2u; } \
        else { v0[_i] = (unsigned)(RR[_i] * lda + CC[_i]) * 2u; v1[_i] = (unsigned)((HALF + RR[_i]) * lda + CC[_i]) * 2u; } } } while (0)
    const int sc_w8 = 0x79797979;
    Unit cur, nxt; int ui = 0;
    if (!S.next(0, cur)) return;
    PG8_SETV(cv0, cv1, cur);
    f32x4 acc[2][2][4][2];
#pragma unroll
    for (int a = 0; a < 2; ++a)
#pragma unroll
        for (int b = 0; b < 2; ++b)
#pragma unroll
            for (int m = 0; m < 4; ++m)
#pragma unroll
                for (int n = 0; n < 2; ++n) acc[a][b][m][n] = (f32x4){0.f, 0.f, 0.f, 0.f};
    bf16x8 At[4][2], B0[2][2], B1[2][2];
    const char* cA = cur.A; const char* cB = cur.B;
    PG8_STAGE(PG8_SB(0, 0), cB, voffB); PG8_STAGE(PG8_SB(0, 1), cB + hstepB, voffB); PG8_STAGE(PG8_SA(0, 0), cA, cv0); PG8_STAGE(PG8_SA(0, 1), cA, cv1);
    if (wr == 1) PG8_BAR;
    PG8_WAIT_V(2); PG8_BAR;
    PG8_STAGE(PG8_SB(1, 0), cB + kstep, voffB); PG8_STAGE(PG8_SA(1, 0), cA + kstep, cv0); PG8_STAGE(PG8_SB(1, 1), cB + hstepB + kstep, voffB);
    PG8_WAIT_V(6); PG8_BAR;
    for (;;) {
        const bool has_next = S.next(ui + 1, nxt);
        const char* nA = has_next ? nxt.A : cA; const char* nB = has_next ? nxt.B : cB;
        if (GATHER) { if (has_next) { PG8_SETV(nv0, nv1, nxt); } else {
#pragma unroll
            for (int i = 0; i < 2; ++i) { nv0[i] = cv0[i]; nv1[i] = cv1[i]; } } }
#pragma nounroll
        for (int t = 0; t < nt; t += 2) {
            const bool last = (t == nt - 2);
            const char* a1 = cA + (size_t)(t + 1) * kstep;
            const char* a2 = last ? nA : cA + (size_t)(t + 2) * kstep; const char* b2 = last ? nB : cB + (size_t)(t + 2) * kstep;
            const char* a3 = a2 + kstep; const char* b3 = b2 + kstep;
            unsigned s0[2], s1[2];
#pragma unroll
            for (int i = 0; i < 2; ++i) { s0[i] = (GATHER && last) ? nv0[i] : cv0[i]; s1[i] = (GATHER && last) ? nv1[i] : cv1[i]; }
            PG8_LDB(B0, 0, 0); PG8_LDB(B1, 0, 1); PG8_SCHED; PG8_LDA(At, 0, 0); PG8_STAGE(PG8_SA(1, 1), a1, cv1);
            PG8_WAIT_V(8); PG8_WAIT_L(0); PG8_BAR; PG8_MMA(0, 0, At, B0); PG8_MMA(0, 1, At, B1); PG8_BAR; PG8_SCHED;
            PG8_LDA(At, 0, 1); PG8_STAGE(PG8_SB(0, 0), b2, voffB); PG8_STAGE(PG8_SB(0, 1), b2 + hstepB, voffB); PG8_STAGE(PG8_SA(0, 0), a2, s0);
            PG8_WAIT_V(8); PG8_WAIT_L(0); PG8_BAR; PG8_MMA(1, 0, At, B0); PG8_MMA(1, 1, At, B1); PG8_BAR; PG8_SCHED;
            PG8_LDB(B0, 1, 0); PG8_LDB(B1, 1, 1); PG8_SCHED; PG8_LDA(At, 1, 0); PG8_STAGE(PG8_SA(0, 1), a2, s1);
            PG8_WAIT_V(8); PG8_WAIT_L(0); PG8_BAR; PG8_MMA(0, 0, At, B0); PG8_MMA(0, 1, At, B1); PG8_BAR; PG8_SCHED;
            PG8_LDA(At, 1, 1); PG8_STAGE(PG8_SB(1, 0), b3, voffB); PG8_STAGE(PG8_SB(1, 1), b3 + hstepB, voffB); PG8_STAGE(PG8_SA(1, 0), a3, s0);
            PG8_WAIT_V(8); PG8_WAIT_L(0); PG8_BAR; PG8_MMA(1, 0, At, B0); PG8_MMA(1, 1, At, B1); PG8_BAR; PG8_SCHED;
        }
        if (wr == 0) PG8_BAR;
        if (F8) asm volatile("s_nop 15\n\ts_nop 7" ::: "memory");
        E(acc, cur, ui, wr, wc, fr, fq);
        if (!has_next) break;
#pragma unroll
        for (int a = 0; a < 2; ++a)
#pragma unroll
            for (int b = 0; b < 2; ++b)
#pragma unroll
                for (int m = 0; m < 4; ++m)
#pragma unroll
                    for (int n = 0; n < 2; ++n) acc[a][b][m][n] = (f32x4){0.f, 0.f, 0.f, 0.f};
        cur = nxt; cA = nA; cB = nB; ++ui;
        if (GATHER) {
#pragma unroll
            for (int i = 0; i < 2; ++i) { cv0[i] = nv0[i]; cv1[i] = nv1[i]; } }
        if (wr == 1) PG8_BAR;
    }
    PG8_WAIT_V(0);
    PG8_BAR;
#undef PG8_SA
#undef PG8_SB
#undef PG8_STAGE
#undef PG8_LDA
#undef PG8_LDB
#undef PG8_MMA
#undef PG8_WAIT_V
#undef PG8_WAIT_L
#undef PG8_BAR
#undef PG8_SCHED
#undef PG8_SETV
}

DI void st4(bf16_t* p, f32x4 v) { u32x2 w; w.x = cvtpk(v[0], v[1]); w.y = cvtpk(v[2], v[3]); *(u32x2*)p = w; }
DI void st8(bf16_t* p, f32x4 a, f32x4 b) { u32x4 w; w.x = cvtpk(a[0], a[1]); w.y = cvtpk(a[2], a[3]); w.z = cvtpk(b[0], b[1]); w.w = cvtpk(b[2], b[3]); *(u32x4*)p = w; }

DI unsigned pk_fp8x4(f32x4 v) { int w = __builtin_amdgcn_cvt_pk_fp8_f32(v[0], v[1], 0, false); w = __builtin_amdgcn_cvt_pk_fp8_f32(v[2], v[3], w, true); return (unsigned)w; }
DI unsigned vt8_keyoff(int kap) { const int a = kap >> 5, c = kap & 31, h = (c >> 2) & 1, i = (c & 3) | ((c >> 3) << 2); return (unsigned)((h * 2 + a) * 512 + i); }
DI void st_fp8x4_strided(unsigned char* p, f32x4 v) {
    int w = __builtin_amdgcn_cvt_pk_fp8_f32(v[0], v[1], 0, false); w = __builtin_amdgcn_cvt_pk_fp8_f32(v[2], v[3], w, true);
    p[0] = (unsigned char)(w & 0xff); p[16] = (unsigned char)((w >> 8) & 0xff); p[32] = (unsigned char)((w >> 16) & 0xff); p[48] = (unsigned char)((unsigned)w >> 24);
}
struct EpiPlain {
    static constexpr bool PERM = true;
    bf16_t* O; int ldc;
    DI void operator()(const f32x4 (&acc)[2][2][4][2], const Unit& u, int ui, int wr, int wc, int fr, int fq) const {
        const int row0 = u.pm * BM + wr * 64 + fr, col0 = u.pn * BM + wc * 32 + 8 * fq;
#pragma unroll
        for (int ai = 0; ai < 2; ++ai)
#pragma unroll
            for (int m = 0; m < 4; ++m) { bf16_t* rowp = O + (size_t)(row0 + ai * HALF + m * 16) * ldc + col0;
#pragma unroll
                for (int bj = 0; bj < 2; ++bj) st8(rowp + bj * HALF, acc[ai][bj][m][0], acc[ai][bj][m][1]); }
    }
};
struct EpiGU {
    static constexpr bool PERM = true;
    unsigned char* O;
    DI static f32x4 silu_mul(f32x4 g, f32x4 u) { f32x4 r;
#pragma unroll
        for (int e = 0; e < 4; ++e) r[e] = g[e] * fast_rcp(1.f + fast_exp2(-g[e] * LOG2E)) * u[e];
        return r; }
    DI void operator()(const f32x4 (&acc)[2][2][4][2], const Unit& u, int ui, int wr, int wc, int fr, int fq) const {
        const int row0 = u.pm * BM + wr * 64 + fr, col0 = u.pn * HALF + wc * 32 + 8 * fq;
#pragma unroll
        for (int ai = 0; ai < 2; ++ai)
#pragma unroll
            for (int m = 0; m < 4; ++m) { unsigned char* rowp = O + (size_t)(row0 + ai * HALF + m * 16) * DEXP + col0;
                u32x2 w; w.x = pk_fp8x4(silu_mul(acc[ai][0][m][0], acc[ai][1][m][0])); w.y = pk_fp8x4(silu_mul(acc[ai][0][m][1], acc[ai][1][m][1])); *(u32x2*)rowp = w; }
    }
};
template <int LAYER> struct EpiInProj {
    static constexpr bool PERM = false;
    unsigned char* ws;
    DI void operator()(const f32x4 (&acc)[2][2][4][2], const Unit& u, int ui, int wr, int wc, int fr_in, int fq) const {
        int fr = fr_in; asm volatile("" : "+v"(fr));
        bf16_t* const O = (bf16_t*)(ws + WS_QKV); const float* const r64c = (const float*)(ws + WS_ROPE); const float* const r64s = r64c + 4096; const float* const r32c = r64s + 4096; const float* const r32s = r32c + 2048;
        unsigned char* const vt8 = ws + WS_VT8D; unsigned char* const q8d = ws + WS_Q8D; unsigned char* const k8d = ws + WS_K8D; unsigned char* const k8r = ws + WS_K8R;
        const int bidx = u.pm / 65; const bool ctx = (u.pm - bidx * 65) == 0;
        const float C2 = 0.125f * LOG2E;
#pragma unroll
        for (int bj = 0; bj < 2; ++bj) {
            const int g = 2 * u.pn + bj;
            bool rope64, scale, rope32 = false, skip = false;
            if (LAYER == 0) { rope64 = !ctx && g <= 4; scale = (g <= 3) || (g >= 6 && g <= 9); }
            else { rope64 = !ctx && g <= 7; scale = g <= 3; rope32 = !ctx && g == 17 && wc == 0; skip = (g == 17 && wc != 0); }
            if (skip) continue;
            const int col0 = g * HALF + wc * 32 + 4 * fq;
#pragma unroll
            for (int ai = 0; ai < 2; ++ai)
#pragma unroll
                for (int m = 0; m < 4; ++m) {
                    const int row = u.pm * BM + ai * HALF + wr * 64 + m * 16 + fr;
                    const int s = row - (bidx * RB + CTXL);
                    f32x4 v0 = acc[ai][bj][m][0], v1 = acc[ai][bj][m][1];
                    if (rope64) { const int pos = (wc & 1) ? (s & 63) : (s >> 6);
                        const f32x4 c4 = *(const f32x4*)(r64c + pos * 16 + 4 * fq), s4 = *(const f32x4*)(r64s + pos * 16 + 4 * fq);
                        const f32x4 y0 = v0 * c4 - v1 * s4, y1 = v1 * c4 + v0 * s4; v0 = y0; v1 = y1; }
                    if (rope32) { const int pos = (fq >= 2) ? (s & 63) : (s >> 6);
                        const f32x4 c4 = *(const f32x4*)(r32c + pos * 8 + 4 * (fq & 1)), s4 = *(const f32x4*)(r32s + pos * 8 + 4 * (fq & 1));
                        const f32x4 y0 = v0 * c4 - v1 * s4, y1 = v1 * c4 + v0 * s4; v0 = y0; v1 = y1; }
                    if (scale) { v0 = v0 * C2; v1 = v1 * C2; }
                    if (LAYER == 0) {
                        const int hsel = wc >> 1, dim0 = (wc & 1) * 32 + 4 * fq;
                        const int rr = row - bidx * RB, kt = rr >> 6, kap = rr & 63;
                        if (g <= 3 || (g >= 6 && g <= 9)) {
                            const int head = (g <= 3) ? (2 * g + hsel) : (2 * (g - 6) + hsel);
                            unsigned char* p8 = ws + (g <= 3 ? WS_Q8A : WS_Q8B) + (size_t)row * 512 + head * 64 + dim0;
                            *(unsigned*)p8 = pk_fp8x4(v0 * 8.f); *(unsigned*)(p8 + 16) = pk_fp8x4(v1 * 8.f);
                        } else if (g == 4 || (g >= 10 && g <= 13)) {
                            const size_t img = (g == 4) ? ((size_t)(bidx * 2 + hsel) * 260 + kt) : ((size_t)(bidx * 8 + 2 * (g - 10) + hsel) * 260 + kt);
                            unsigned char* p8 = ws + (g == 4 ? WS_K8A : WS_K8B) + img * 4096 + ((wc & 1) * 2) * 1024 + kap * 16 + 4 * fq;
                            *(unsigned*)p8 = pk_fp8x4(v0); *(unsigned*)(p8 + 1024) = pk_fp8x4(v1);
                        } else {
                            const size_t img = (g == 5) ? ((size_t)(bidx * 2 + hsel) * 260 + kt) : ((size_t)(bidx * 8 + 2 * (g - 14) + hsel) * 260 + kt);
                            unsigned char* p8 = ws + (g == 5 ? WS_VT8A : WS_VT8B) + img * 4096 + (wc & 1) * 2048 + vt8_keyoff(kap) + (4 * fq) * 16;
                            st_fp8x4_strided(p8, v0); st_fp8x4_strided(p8 + 256, v1);
                        }
                        if (m & 1) asm volatile("" ::: "memory"); continue;
                    }
                    if (LAYER == 1 && g <= 3) {
                        unsigned char* p8 = q8d + (size_t)row * 512 + g * HALF + wc * 32 + 4 * fq;
                        *(unsigned*)p8 = pk_fp8x4(v0 * 8.f); *(unsigned*)(p8 + 16) = pk_fp8x4(v1 * 8.f);
                        if (m & 1) asm volatile("" ::: "memory"); continue;
                    }
                    if (LAYER == 1 && g >= 4 && g <= 7) {
                        const int rr = row - bidx * RB, kt = rr >> 6, kap = rr & 63;
                        unsigned char* p8 = k8d + ((size_t)(bidx * 4 + (g - 4)) * 260 + kt) * 8192 + (wc >> 1) * 4096 + ((wc & 1) * 2) * 1024 + kap * 16 + 4 * fq;
                        *(unsigned*)p8 = pk_fp8x4(v0); *(unsigned*)(p8 + 1024) = pk_fp8x4(v1);
                        if (m & 1) asm volatile("" ::: "memory"); continue;
                    }
                    if (LAYER == 1 && g == 17) {
                        const int rr = row - bidx * RB, kt = rr >> 6, kap = rr & 63;
                        unsigned char* p8 = k8r + ((size_t)bidx * 260 + kt) * 2048 + kap * 16 + 4 * fq;
                        *(unsigned*)p8 = pk_fp8x4(v0); *(unsigned*)(p8 + 1024) = pk_fp8x4(v1);
                        if (m & 1) asm volatile("" ::: "memory"); continue;
                    }
                    if (LAYER == 1 && g >= 8 && g <= 11) {
                        const int rr = row - bidx * RB, kt = rr >> 6;
                        unsigned char* p8 = vt8 + ((size_t)(bidx * 4 + (g - 8)) * 260 + kt) * 8192 + wc * 2048 + vt8_keyoff(rr & 63) + (4 * fq) * 16;
                        st_fp8x4_strided(p8, v0); st_fp8x4_strided(p8 + 256, v1);
                        if (m & 1) asm volatile("" ::: "memory"); continue;
                    }
                    bf16_t* p = O + (size_t)row * NQKV + col0;
                    st4(p, v0); st4(p + 16, v1);
                    if (m & 1) asm volatile("" ::: "memory");
                }
        }
    }
};

struct EpiUKV {
    static constexpr bool PERM = true;
    unsigned char* k8; const LAS float* rs; unsigned char* vt8;
    DI void operator()(const f32x4 (&acc)[2][2][4][2], const Unit& u, int ui, int wr, int wc, int fr_in, int fq) const {
        int fr = fr_in;
        asm volatile("" : "+v"(fr));
        const int lr0 = wr * 64 + fr, bidx = u.pm / 65;
#pragma unroll
        for (int ai = 0; ai < 2; ++ai)
#pragma unroll
            for (int m = 0; m < 4; ++m) { const int lr = lr0 + ai * HALF + m * 16; const float s = rs[ui * 256 + lr]; const int row = u.pm * BM + lr;
                if (u.pn < 2) { const int rr = row - bidx * RB, kt = rr >> 6, kap = rr & 63;
#pragma unroll
                    for (int bj = 0; bj < 2; ++bj) { const int col = u.pn * BM + bj * HALF + wc * 32 + 8 * fq, head = col >> 6, dim = col & 63;
                        unsigned char* p = k8 + ((size_t)(bidx * 8 + head) * 260 + kt) * 4096 + (dim >> 4) * 1024 + kap * 16 + (dim & 15);
                        u32x2 w; w.x = pk_fp8x4(acc[ai][bj][m][0] * s); w.y = pk_fp8x4(acc[ai][bj][m][1] * s); *(u32x2*)p = w; }
                } else { const int rr = row - bidx * RB, kt = rr >> 6;
#pragma unroll
                    for (int bj = 0; bj < 2; ++bj) { const int col = (u.pn - 2) * BM + bj * HALF + wc * 32 + 8 * fq, head = col >> 6, d = col & 63;
                        unsigned char* p = vt8 + ((size_t)(bidx * 8 + head) * 260 + kt) * 4096 + (d >> 5) * 2048 + vt8_keyoff(rr & 63) + (d & 31) * 16;
                        st_fp8x4_strided(p, acc[ai][bj][m][0] * s); st_fp8x4_strided(p + 64, acc[ai][bj][m][1] * s); } }
            }
    }
};
struct EpiUQ {
    static constexpr bool PERM = false;
    unsigned char* q8; const LAS float* rs; const float* r32c; const float* r32s;
    DI void operator()(const f32x4 (&acc)[2][2][4][2], const Unit& u, int ui, int wr, int wc, int fr, int fq) const {
        const int bidx = u.pm / 65;
        const float C2 = 0.10206207261596577f * LOG2E * 8.f;
#pragma unroll
        for (int bj = 0; bj < 2; ++bj) {
            int off;
            if (u.pn < 2) { const int col = u.pn * BM + bj * HALF + wc * 32 + 4 * fq; off = (col >> 6) * 96 + (col & 63); }
            else off = (bj * 4 + wc) * 96 + 64 + 4 * fq;
#pragma unroll
            for (int ai = 0; ai < 2; ++ai)
#pragma unroll
                for (int m = 0; m < 4; ++m) {
                    const int lr = ai * HALF + wr * 64 + m * 16 + fr, row = u.pm * BM + lr;
                    const int s = row - (bidx * RB + CTXL);
                    const float sc = rs[ui * 256 + lr] * C2;
                    f32x4 v0 = acc[ai][bj][m][0] * sc, v1 = acc[ai][bj][m][1] * sc;
                    if (u.pn == 2) { const int pos = (fq >= 2) ? (s & 63) : (s >> 6);
                        const f32x4 c4 = *(const f32x4*)(r32c + pos * 8 + 4 * (fq & 1)), s4 = *(const f32x4*)(r32s + pos * 8 + 4 * (fq & 1));
                        const f32x4 y0 = v0 * c4 - v1 * s4, y1 = v1 * c4 + v0 * s4; v0 = y0; v1 = y1; }
                    unsigned char* p = q8 + (size_t)row * 768 + off;
                    *(unsigned*)p = pk_fp8x4(v0); *(unsigned*)(p + 16) = pk_fp8x4(v1);
                }
        }
    }
};
}

namespace att {
constexpr float THR = 8.f;
struct P {
    const unsigned char* q8; int qpitch;
    const unsigned char* k8; const unsigned char* k8r;
    const unsigned char* v8;
    unsigned char* o; int opitch;
    int nt, t_lo, kind, s0;
    float sink2, lam; const float* subln;
};
DI int crow(int r, int hi) { return (r & 3) + 8 * (r >> 2) + 4 * hi; }
DI float xsum32(float v) { auto rr = __builtin_amdgcn_permlane32_swap(__float_as_uint(v), __float_as_uint(v), false, false); return __uint_as_float(rr[0]) + __uint_as_float(rr[1]); }
DI int ximax32(int v) { auto rr = __builtin_amdgcn_permlane32_swap((unsigned)v, (unsigned)v, false, false); const int a = (int)rr[0], b = (int)rr[1]; return a > b ? a : b; }
DI float xmax32(float v) { auto rr = __builtin_amdgcn_permlane32_swap(__float_as_uint(v), __float_as_uint(v), false, false); float r; asm("v_max_f32 %0, %1, %2" : "=v"(r) : "v"(rr[0]), "v"(rr[1])); return r; }
#define ATT_WAITBAR() asm volatile("s_waitcnt vmcnt(0) lgkmcnt(0)\n\ts_barrier" ::: "memory")

DI void glds16s(unsigned voff, const void* sbase, unsigned lds_dst) { unsigned keep;
    asm volatile("s_mov_b32 %0, m0\n\ts_mov_b32 m0, %3\n\ts_nop 0\n\tglobal_load_lds_dwordx4 %1, %2\n\ts_mov_b32 m0, %0" : "=&s"(keep) : "v"(voff), "s"(sbase), "s"(lds_dst) : "memory"); }
#define ATT_WAITN_BAR(N) asm volatile("s_waitcnt vmcnt(" #N ") lgkmcnt(0)\n\ts_barrier" ::: "memory")
typedef int v8i_t __attribute__((ext_vector_type(8)));
DI f32x16 mfma_f8(v8i_t a, v8i_t b, f32x16 c) { return __builtin_amdgcn_mfma_scale_f32_32x32x64_f8f6f4(a, b, c, 0, 0, 0, 0x7f7f7f7f, 0, 0x7f7f7f7f); }
DI f32x16 mfma_f8s(v8i_t a, v8i_t b, f32x16 c, int sb) { return __builtin_amdgcn_mfma_scale_f32_32x32x64_f8f6f4(a, b, c, 0, 0, 0, 0x7f7f7f7f, 0, sb); }
typedef float f32x4v __attribute__((ext_vector_type(4)));
DI f32x4v mfma_f8s16(v8i_t a, v8i_t b, f32x4v c, int sb) { return __builtin_amdgcn_mfma_scale_f32_16x16x128_f8f6f4(a, b, c, 0, 0, 0, 0x7f7f7f7f, 0, sb); }
constexpr float F8_OFF = 4.f;
DI f32x16 mfma_f8q(v8i_t a, v8i_t b, f32x16 c) { return __builtin_amdgcn_mfma_scale_f32_32x32x64_f8f6f4(a, b, c, 0, 0, 0, 0x7f7f7f7f, 0, 0x7c7c7c7c); }
template <int MODE> DI void attn_unit_f8q(const P& p, LAS unsigned char* lds) {
    constexpr int DV = MODE == 2 ? 128 : 64;
    constexpr int NKC = MODE == 1 ? 6 : 8;
    constexpr int KSLOT = NKC * 1024, VSLOT = DV * 64, VRING = 4 * KSLOT, NDB = DV / 32;
    constexpr int NQK = MODE == 1 ? 4 : 2;
    const int tid = threadIdx.x, lane = tid & 63, r32 = lane & 31, hi = lane >> 5; const int wid = __builtin_amdgcn_readfirstlane(tid >> 6);
    const int sub = (MODE == 2) ? (wid >> 2) : 0;
    const int qrow = (MODE == 2) ? (32 * (wid & 3) + r32) : (32 * wid + r32);
    const int nt = p.nt;
    const unsigned ldsb = (unsigned)(size_t)lds;
    v8i_t qf[MODE == 1 ? 2 : 1];
    { const unsigned char* qp = p.q8 + (size_t)qrow * p.qpitch + (MODE == 2 ? sub * 64 : 0);
      const u32x4 a0 = *(const u32x4*)(qp + 32 * hi), a1 = *(const u32x4*)(qp + 32 * hi + 16);
      qf[0] = (v8i_t){(int)a0[0], (int)a0[1], (int)a0[2], (int)a0[3], (int)a1[0], (int)a1[1], (int)a1[2], (int)a1[3]};
      if (MODE == 1) { u32x4 b0 = *(const u32x4*)(qp + 64), b1 = *(const u32x4*)(qp + 80);
          if (hi) { b0 = (u32x4){0u, 0u, 0u, 0u}; b1 = b0; }
          qf[MODE == 1 ? 1 : 0] = (v8i_t){(int)b0[0], (int)b0[1], (int)b0[2], (int)b0[3], (int)b1[0], (int)b1[1], (int)b1[2], (int)b1[3]}; } }
    const int kpc = (MODE == 1) ? (wid < 6 ? wid : wid - 2) : wid;
    const int vpc = (MODE == 1) ? (wid & 3) : wid;
    const unsigned koff = (unsigned)(((MODE == 1 && kpc >= 4) ? (kpc - 4) : kpc) * 1024 + lane * 16);
    const unsigned voff = (unsigned)(vpc * 1024 + lane * 16);
    const unsigned char* kbase = (MODE == 1 && kpc >= 4) ? p.k8r : p.k8;
    const size_t kstep = (MODE == 1) ? ((kpc >= 4) ? 2048 : 4096) : 8192;
#define AQ_ISSUE_K(t) do { const int t_ = (t); if (t_ < nt) { const unsigned sb_ = ldsb + (unsigned)((t_ & 3) * KSLOT); \
        glds16s(koff, kbase + (size_t)t_ * kstep, (unsigned)__builtin_amdgcn_readfirstlane(sb_ + kpc * 1024)); } } while (0)
#define AQ_ISSUE_V(t) do { const int t_ = (t); if (t_ < nt) { const unsigned sb_ = ldsb + (unsigned)(VRING + (t_ & 7) * VSLOT); \
        glds16s(voff, p.v8 + (size_t)t_ * VSLOT, (unsigned)__builtin_amdgcn_readfirstlane(sb_ + vpc * 1024)); } } while (0)
    float m = 0.f, l = 0.f;
    if (wid >= 4) __builtin_amdgcn_s_setprio(1);
    f32x16 o[NDB], negm, sa0, sa1, sb0, sb1;
#pragma unroll
    for (int db = 0; db < NDB; ++db)
#pragma unroll
        for (int i = 0; i < 16; ++i) o[db][i] = 0.f;
#pragma unroll
    for (int i = 0; i < 16; ++i) negm[i] = 0.f;
    const int vo = hi * 1024 + r32 * 16;
    const int ko_n = ((MODE == 2 ? sub * 4 : 0) + 2 * hi) * 1024 + r32 * 16;
    const int ko_r = 4 * 1024 + r32 * 16;
    u32x4 kfl[MODE == 1 ? 2 : 1], kfh[MODE == 1 ? 2 : 1], vfl[MODE == 1 ? 2 : 1], vfh[MODE == 1 ? 2 : 1]; v8i_t pfa, pfb;
    f32x4v ol = (f32x4v){0.f, 0.f, 0.f, 0.f};
    const int onesw = ((lane & 15) == ((lane >> 4) & 1)) ? 0x38383838 : 0;
    const v8i_t ones_fr = (v8i_t){onesw, onesw, onesw, onesw, onesw, onesw, onesw, onesw};
#define AQ_SB() __builtin_amdgcn_sched_barrier(0)
#define AQ_LDKF(s_, j, Ks_) do { const int o_ = ((MODE == 1 && ((j) >> 1)) ? ko_r : ko_n) + ((j) & 1) * 512; kfl[s_] = *(const LAS u32x4*)((Ks_) + o_); kfh[s_] = *(const LAS u32x4*)((Ks_) + o_ + 1024); } while (0)
#define AQ_LDVF(s_, db, Vs_) do { vfl[s_] = *(const LAS u32x4*)((Vs_) + (db) * 2048); vfh[s_] = *(const LAS u32x4*)((Vs_) + (db) * 2048 + 512); } while (0)
#define AQ_KF(s_) ((v8i_t){(int)kfl[s_][0], (int)kfl[s_][1], (int)kfl[s_][2], (int)kfl[s_][3], (int)kfh[s_][0], (int)kfh[s_][1], (int)kfh[s_][2], (int)kfh[s_][3]})
#define AQ_VF(s_) ((v8i_t){(int)vfl[s_][0], (int)vfl[s_][1], (int)vfl[s_][2], (int)vfl[s_][3], (int)vfh[s_][0], (int)vfh[s_][1], (int)vfh[s_][2], (int)vfh[s_][3]})
#define AQ_Q(j, s_, N0, N1) do { if ((j) & 1) { if ((j) < 2) N1 = mfma_f8q(AQ_KF(s_), qf[0], negm); else N1 = mfma_f8q(AQ_KF(s_), qf[MODE == 1 ? 1 : 0], N1); asm volatile("" : "+v"(N1)); } \
        else { if ((j) < 2) N0 = mfma_f8q(AQ_KF(s_), qf[0], negm); else N0 = mfma_f8q(AQ_KF(s_), qf[MODE == 1 ? 1 : 0], N0); asm volatile("" : "+v"(N0)); } } while (0)
#define AQ_P(db, s_, PF) do { o[db] = mfma_f8(AQ_VF(s_), PF, o[db]); asm volatile("" : "+v"(o[db])); } while (0)
#define AQ_PL(PF) do { ol = mfma_f8s16(ones_fr, PF, ol, 0x7f7f7f7f); asm volatile("" : "+v"(ol)); } while (0)
#define AQ_EXP8(g, C) do { const int b_ = 8 * ((g) & 1); _Pragma("unroll") for (int i_ = 0; i_ < 8; ++i_) { C[b_ + i_] = fast_exp2(C[b_ + i_]); asm volatile("" : "+v"(C[b_ + i_])); } } while (0)
#define AQ_CVT4(g, C, PF) do { const int b_ = 8 * ((g) & 1); \
        int w0_, w1_; asm volatile("" : "=v"(w0_), "=v"(w1_));                                                    \
        w0_ = __builtin_amdgcn_cvt_pk_fp8_f32(C[b_ + 0], C[b_ + 1], w0_, false); w0_ = __builtin_amdgcn_cvt_pk_fp8_f32(C[b_ + 2], C[b_ + 3], w0_, true); \
        w1_ = __builtin_amdgcn_cvt_pk_fp8_f32(C[b_ + 4], C[b_ + 5], w1_, false); w1_ = __builtin_amdgcn_cvt_pk_fp8_f32(C[b_ + 6], C[b_ + 7], w1_, true); \
        asm volatile("" : "+v"(w0_), "+v"(w1_)); PF[2 * (g)] = w0_; PF[2 * (g) + 1] = w1_; } while (0)
#define AQ_EXP(g, C0, C1) do { if ((g) < 2) AQ_EXP8(g, C0); else AQ_EXP8(g, C1); } while (0)
#define AQ_CVT(g, C0, C1, PF) do { if ((g) < 2) AQ_CVT4(g, C0, PF); else AQ_CVT4(g, C1, PF); } while (0)
#define AQ_IMAX(a_, b_) ((a_) > (b_) ? (a_) : (b_))
#define AQ_TILE(C0, C1, N0, N1, PFC, PFP, HASN, HASP, MID, tm) do { \
        const LAS unsigned char* Ks_ = lds + ks_next * KSLOT; const LAS unsigned char* Vs_ = lds + VRING + vs_prev * VSLOT + vo; \
        if (HASN) { AQ_LDKF(0, 0, Ks_); if (MODE == 1) AQ_LDKF(1, 1, Ks_); } if (HASP) { AQ_LDVF(0, 0, Vs_); if (MODE == 1) AQ_LDVF(1, 1, Vs_); } \
        AQ_EXP(0, C0, C1); AQ_SB(); \
        if (MODE == 1) { if (HASN) { AQ_Q(0, 0, N0, N1); AQ_Q(1, 1, N0, N1); AQ_LDKF(0, 2, Ks_); AQ_LDKF(1, 3, Ks_); } } \
        else { if (HASN) { AQ_Q(0, 0, N0, N1); AQ_LDKF(0, 1, Ks_); } if (HASP) { AQ_P(0, 0, PFP); AQ_LDVF(0, 1, Vs_); } } AQ_SB(); \
        AQ_CVT(0, C0, C1, PFC); AQ_EXP(1, C0, C1); AQ_SB(); \
        if (MODE == 1) { if (HASN) { AQ_Q(2, 0, N0, N1); AQ_Q(3, 1, N0, N1); } } \
        else { if (HASN) AQ_Q(1, 0, N0, N1); if (HASP) { AQ_P(1, 0, PFP); AQ_LDVF(0, 2, Vs_); } } AQ_SB(); \
        AQ_CVT(1, C0, C1, PFC); AQ_SB(); \
        if (MID) ATT_WAITN_BAR(0);                                         \
        if (HASP) { if (MODE == 1) { AQ_P(0, 0, PFP); AQ_P(1, 1, PFP); } else { AQ_P(2, 0, PFP); AQ_LDVF(0, 3, Vs_); AQ_PL(PFP); } } \
        if (MID) { AQ_ISSUE_K((tm) + 4); AQ_ISSUE_K((tm) + 5); AQ_ISSUE_V((tm) + 2); AQ_ISSUE_V((tm) + 3); } AQ_SB(); \
        AQ_EXP(2, C0, C1); AQ_CVT(2, C0, C1, PFC); AQ_EXP(3, C0, C1); AQ_SB(); \
        if (HASP) { if (MODE == 1) AQ_PL(PFP); else AQ_P(3, 0, PFP); } AQ_SB(); \
        AQ_CVT(3, C0, C1, PFC); \
        if (HASN) { int ri_ = AQ_IMAX(AQ_IMAX(__float_as_int(N0[0]), __float_as_int(N1[0])), __float_as_int(N0[1]));     \
            _Pragma("unroll") for (int i_ = 1; i_ < 15; ++i_) ri_ = AQ_IMAX(AQ_IMAX(ri_, __float_as_int(N1[i_])), __float_as_int(N0[i_ + 1])); \
            ri_ = AQ_IMAX(ri_, __float_as_int(N1[15])); \
            const float rm_ = __int_as_float(ximax32(ri_)); \
            if (__any(rm_ > THR)) { \
                { const LAS unsigned char* Vn_ = lds + VRING + ((vs_prev + 1) & 7) * VSLOT + vo;                    \
                  _Pragma("unroll") for (int db_ = 0; db_ < NDB; ++db_) { AQ_LDVF(0, db_, Vn_); AQ_P(db_, 0, PFC); } AQ_PL(PFC); \
                  _Pragma("unroll") for (int i_ = 0; i_ < 8; ++i_) PFC[i_] = 0; } \
                const float dl_ = fmaxf(rm_ - F8_OFF, 0.f); m += dl_; const float f_ = fast_exp2(-dl_); ol[0] *= __shfl(f_, lane & 15); ol[1] *= __shfl(f_, (lane & 15) + 16); \
                _Pragma("unroll") for (int i_ = 0; i_ < 16; ++i_) { N0[i_] -= dl_; N1[i_] -= dl_; negm[i_] = -m; } \
                _Pragma("unroll") for (int db_ = 0; db_ < NDB; ++db_) _Pragma("unroll") for (int i_ = 0; i_ < 16; ++i_) o[db_][i_] *= f_; } } \
        ks_next = (ks_next + 1) & 3; vs_prev = (vs_prev + 1) & 7; } while (0)
    AQ_ISSUE_K(0); AQ_ISSUE_K(1); AQ_ISSUE_K(2); AQ_ISSUE_V(0);
    ATT_WAITN_BAR(0);
    { const LAS unsigned char* Ks_ = lds;
#pragma unroll
      for (int j = 0; j < NQK; ++j) { AQ_LDKF(MODE == 1 ? (j & 1) : 0, j, Ks_); AQ_Q(j, MODE == 1 ? (j & 1) : 0, sa0, sa1); }
      float rm = fmaxf(sa0[0], sa1[0]);
#pragma unroll
      for (int i = 1; i < 16; ++i) rm = fmaxf(fmaxf(rm, sa0[i]), sa1[i]);
      rm = xmax32(rm) - F8_OFF; m = rm;
#pragma unroll
      for (int i = 0; i < 16; ++i) { sa0[i] -= rm; sa1[i] -= rm; negm[i] = -rm; } }
    int ks_next = 1, vs_prev = 7;
    ATT_WAITN_BAR(0); AQ_ISSUE_K(3); AQ_ISSUE_K(4); AQ_ISSUE_V(1); AQ_ISSUE_V(2);
    AQ_TILE(sa0, sa1, sb0, sb1, pfa, pfb, true, false, false, 0); AQ_TILE(sb0, sb1, sa0, sa1, pfb, pfa, true, true, true, 1);
    for (int t = 2; t < nt - 2; t += 2) {
        AQ_TILE(sa0, sa1, sb0, sb1, pfa, pfb, true, true, false, 0); AQ_TILE(sb0, sb1, sa0, sa1, pfb, pfa, true, true, true, t + 1);
    }
    AQ_TILE(sa0, sa1, sb0, sb1, pfa, pfb, true, true, false, 0); AQ_TILE(sb0, sb1, sa0, sa1, pfb, pfa, false, true, true, nt - 1);
    { const LAS unsigned char* Vs_ = lds + VRING + vs_prev * VSLOT + vo;
      if (MODE == 1) { AQ_LDVF(0, 0, Vs_); AQ_LDVF(1, 1, Vs_); AQ_P(0, 0, pfb); AQ_P(1, 1, pfb); }
      else {
#pragma unroll
          for (int db = 0; db < NDB; ++db) { AQ_LDVF(0, db, Vs_); AQ_P(db, 0, pfb); } }
      AQ_PL(pfb); }
    { const float l0 = __shfl(ol[0], lane & 15), l1 = __shfl(ol[1], lane & 15); l = (lane & 16) ? l1 : l0; }
    const float inv = fast_rcp(l);
    if (MODE != 2) {
#pragma unroll
        for (int db = 0; db < NDB; ++db)
#pragma unroll
            for (int g = 0; g < 4; ++g) { const f32x4 v4 = (f32x4){o[db][4 * g], o[db][4 * g + 1], o[db][4 * g + 2], o[db][4 * g + 3]} * inv;
                *(unsigned*)(p.o + (size_t)qrow * p.opitch + 32 * db + 8 * g + 4 * hi) = pg8::pk_fp8x4(v4 * 32.f); }
    } else {
        LAS float* X = (LAS float*)lds;
        ATT_WAITBAR();
        if (sub == 1) {
#pragma unroll
            for (int db = 0; db < NDB; ++db)
#pragma unroll
                for (int i = 0; i < 16; ++i) X[((wid - 4) * 64 + db * 16 + i) * 64 + lane] = o[db][i] * inv;
        }
        ATT_WAITBAR();
        if (sub == 0) {
            float ss = 0.f;
#pragma unroll
            for (int db = 0; db < NDB; ++db)
#pragma unroll
                for (int i = 0; i < 16; ++i) { const float val = o[db][i] * inv - p.lam * X[(wid * 64 + db * 16 + i) * 64 + lane]; o[db][i] = val; ss += val * val; }
            ss = xsum32(ss);
            const float rstd = (1.0f - LAM_INIT) / sqrtf(ss * (1.0f / 128.0f) + 1e-6f);
#pragma unroll
            for (int db = 0; db < NDB; ++db)
#pragma unroll
                for (int g = 0; g < 4; ++g) { const int d = 32 * db + 8 * g + 4 * hi; const f32x4 w4 = *(const f32x4*)(p.subln + d);
                    const f32x4 v4 = (f32x4){o[db][4 * g], o[db][4 * g + 1], o[db][4 * g + 2], o[db][4 * g + 3]} * rstd * w4;
                    *(unsigned*)(p.o + (size_t)qrow * p.opitch + d) = pg8::pk_fp8x4(v4 * 32.f); }
        }
    }
    __builtin_amdgcn_s_setprio(0);
    ATT_WAITBAR();
#undef AQ_ISSUE_K
#undef AQ_ISSUE_V
#undef AQ_SB
#undef AQ_LDKF
#undef AQ_LDVF
#undef AQ_KF
#undef AQ_VF
#undef AQ_Q
#undef AQ_P
#undef AQ_PL
#undef AQ_EXP8
#undef AQ_CVT4
#undef AQ_EXP
#undef AQ_CVT
#undef AQ_IMAX
#undef AQ_TILE
}

DI void attn_unit_f8l0(const P& p, LAS unsigned char* lds, const LAS float* rpbL) {
    constexpr int KSLOT = 4096, VSLOT = 4096, VRING = 3 * KSLOT, NDB = 2;
    const int tid = threadIdx.x, lane = tid & 63, r32 = lane & 31, hi = lane >> 5; const int wid = __builtin_amdgcn_readfirstlane(tid >> 6);
    const int qrow = 32 * wid + r32;
    const int nt = p.nt;
    const unsigned ldsb = (unsigned)(size_t)lds;
    v8i_t qf;
    { const unsigned char* qp = p.q8 + (size_t)qrow * p.qpitch;
      const u32x4 a0 = *(const u32x4*)(qp + 32 * hi), a1 = *(const u32x4*)(qp + 32 * hi + 16);
      qf = (v8i_t){(int)a0[0], (int)a0[1], (int)a0[2], (int)a0[3], (int)a1[0], (int)a1[1], (int)a1[2], (int)a1[3]}; }
    const bool isk = wid < 4; const int pc = wid & 3;
    const unsigned doff = (unsigned)(pc * 1024 + lane * 16);
    const unsigned char* dbase = isk ? p.k8 : p.v8;
#define L0_UT(t) (((t) >= 4) ? (p.t_lo + (t) - 4) : (t))
#define L0_ISSUE(t) do { const int tt_ = isk ? (t) + 3 : (t) + 2; if (tt_ >= 0 && tt_ < nt) { const unsigned sb_ = ldsb + (unsigned)((isk ? 0 : VRING) + (tt_ % 3) * 4096); \
        glds16s(doff, dbase + (size_t)L0_UT(tt_) * 4096, (unsigned)__builtin_amdgcn_readfirstlane(sb_ + pc * 1024)); } } while (0)
    float m = 0.f, l = 0.f;
    f32x16 o[NDB], negm, sa0, sa1, sb0, sb1, ol;
#pragma unroll
    for (int db = 0; db < NDB; ++db)
#pragma unroll
        for (int i = 0; i < 16; ++i) o[db][i] = 0.f;
#pragma unroll
    for (int i = 0; i < 16; ++i) { negm[i] = 0.f; ol[i] = 0.f; }
    const int onesw = (r32 == 0) ? 0x38383838 : 0;
    const v8i_t ones_fr = (v8i_t){onesw, onesw, onesw, onesw, onesw, onesw, onesw, onesw};
    const bool has_sink = (p.kind & 1) == 0;
    const int vo = hi * 1024 + r32 * 16;
    const int ko_n = (2 * hi) * 1024 + r32 * 16;
    u32x4 klo[2], khi[2]; v8i_t pf; u32x4 vlo[NDB], vhi[NDB];
#define L0_SB() __builtin_amdgcn_sched_barrier(0)
#define L0_LDK(j, Ks_) do { klo[j] = *(const LAS u32x4*)((Ks_) + ko_n + (j) * 512); khi[j] = *(const LAS u32x4*)((Ks_) + ko_n + (j) * 512 + 1024); } while (0)
#define L0_LDV(Vs_) do { _Pragma("unroll") for (int db_ = 0; db_ < NDB; ++db_) { vlo[db_] = *(const LAS u32x4*)((Vs_) + db_ * 2048); vhi[db_] = *(const LAS u32x4*)((Vs_) + db_ * 2048 + 512); } } while (0)
#define L0_KFR(j) ((v8i_t){(int)klo[j][0], (int)klo[j][1], (int)klo[j][2], (int)klo[j][3], (int)khi[j][0], (int)khi[j][1], (int)khi[j][2], (int)khi[j][3]})
#define L0_PV() do { _Pragma("unroll") for (int db_ = 0; db_ < NDB; ++db_) { \
        const v8i_t vfr_ = (v8i_t){(int)vlo[db_][0], (int)vlo[db_][1], (int)vlo[db_][2], (int)vlo[db_][3], (int)vhi[db_][0], (int)vhi[db_][1], (int)vhi[db_][2], (int)vhi[db_][3]}; \
        o[db_] = mfma_f8(vfr_, pf, o[db_]); } ol = mfma_f8(ones_fr, pf, ol); } while (0)
#define L0_VALU8(g, C) do { const int b_ = 8 * ((g) & 1); \
        _Pragma("unroll") for (int i_ = 0; i_ < 8; ++i_) { C[b_ + i_] = fast_exp2(C[b_ + i_]); } \
        int w0_, w1_; asm volatile("" : "=v"(w0_), "=v"(w1_));                                                    \
        w0_ = __builtin_amdgcn_cvt_pk_fp8_f32(C[b_ + 0], C[b_ + 1], w0_, false); w0_ = __builtin_amdgcn_cvt_pk_fp8_f32(C[b_ + 2], C[b_ + 3], w0_, true); \
        w1_ = __builtin_amdgcn_cvt_pk_fp8_f32(C[b_ + 4], C[b_ + 5], w1_, false); w1_ = __builtin_amdgcn_cvt_pk_fp8_f32(C[b_ + 6], C[b_ + 7], w1_, true); \
        asm volatile("" : "+v"(w0_), "+v"(w1_)); pf[2 * (g)] = w0_; pf[2 * (g) + 1] = w1_; } while (0)
#define L0_VALU(g, C0, C1) do { if ((g) < 2) L0_VALU8(g, C0); else L0_VALU8(g, C1); } while (0)
#define L0_CR(i_) (((i_) & 3) + 8 * ((i_) >> 2))
#define L0_MASK(tn, N0, N1) do { if ((tn) >= 4) { const int ut_ = L0_UT(tn); \
        if (p.kind == 0) { const int kb_ = (ut_ - 4) * 64 - (p.s0 + qrow) + 4 * hi + 128;                 \
            if (!__all(kb_ >= 0 && kb_ + 59 <= 256)) { \
            _Pragma("unroll") for (int i_ = 0; i_ < 16; ++i_) { if ((unsigned)(kb_ + L0_CR(i_)) > 256u) N0[i_] = -INFINITY; if ((unsigned)(kb_ + L0_CR(i_) + 32) > 256u) N1[i_] = -INFINITY; } } \
        } else if (p.kind == 1) { const int kr_ = ut_ - 4, r_ = (p.s0 >> 6) + (wid >> 1), qc_ = 32 * (wid & 1) + r32; int rs_ = r_ - 4; rs_ = rs_ < 0 ? 0 : (rs_ > 248 ? 248 : rs_); \
            const bool rowok_ = (kr_ >= rs_) && (kr_ < rs_ + 8); int cs_ = qc_ - 8; cs_ = cs_ < 0 ? 0 : (cs_ > 48 ? 48 : cs_); \
            int bri_ = kr_ - r_ + 7; bri_ = bri_ < 0 ? 0 : (bri_ > 14 ? 14 : bri_); \
            const LAS float* bp_ = rpbL + bri_ * 31 + (4 * hi - qc_ + 15);                                  \
            const int cb_ = rowok_ ? (4 * hi - cs_) : 4096;                                                     \
            _Pragma("unroll") for (int i_ = 0; i_ < 16; ++i_) { \
                const float b0_ = bp_[L0_CR(i_)], b1_ = bp_[L0_CR(i_) + 32]; \
                N0[i_] = ((unsigned)(cb_ + L0_CR(i_)) < 16u) ? N0[i_] + b0_ : -INFINITY; N1[i_] = ((unsigned)(cb_ + L0_CR(i_) + 32) < 16u) ? N1[i_] + b1_ : -INFINITY; } } } } while (0)
#define L0_TILE(t, C0, C1, N0, N1, HASN) do { \
        const LAS unsigned char* Ks_ = lds + ks_next * KSLOT; const LAS unsigned char* Vs_ = lds + VRING + vs_cur * VSLOT + vo; \
        if (HASN) L0_LDK(0, Ks_); L0_VALU(0, C0, C1); L0_SB(); \
        L0_VALU(1, C0, C1); if (HASN) { N0 = mfma_f8q(L0_KFR(0), qf, negm); asm volatile("" : "+v"(N0)); } L0_SB(); \
        if (HASN) L0_LDK(1, Ks_); L0_VALU(2, C0, C1); L0_SB(); \
        L0_LDV(Vs_); L0_VALU(3, C0, C1); if (HASN) { N1 = mfma_f8q(L0_KFR(1), qf, negm); asm volatile("" : "+v"(N1)); } L0_SB(); \
        L0_PV(); \
        if (HASN) { L0_MASK((t) + 1, N0, N1); float rm_ = fmaxf(N0[0], N1[0]); \
            _Pragma("unroll") for (int i_ = 1; i_ < 16; ++i_) rm_ = fmaxf(fmaxf(rm_, N0[i_]), N1[i_]); \
            rm_ = xmax32(rm_); \
            if (__any(rm_ > THR)) { const float dl_ = fmaxf(rm_ - F8_OFF, 0.f); m += dl_; const float f_ = fast_exp2(-dl_); ol[0] *= f_; \
                _Pragma("unroll") for (int i_ = 0; i_ < 16; ++i_) { N0[i_] -= dl_; N1[i_] -= dl_; negm[i_] = -m; } \
                _Pragma("unroll") for (int db_ = 0; db_ < NDB; ++db_) _Pragma("unroll") for (int i_ = 0; i_ < 16; ++i_) o[db_][i_] *= f_; } } \
        ks_next = (ks_next == 2) ? 0 : ks_next + 1; vs_cur = (vs_cur == 2) ? 0 : vs_cur + 1; } while (0)
#define L0_TOP(t) do { if ((t) + 2 < nt) ATT_WAITN_BAR(1); else ATT_WAITN_BAR(0); L0_ISSUE(t); } while (0)
    L0_ISSUE(-3);
    L0_ISSUE(-2);
    ATT_WAITBAR();
    L0_ISSUE(-1);
    { const LAS unsigned char* Ks_ = lds;
      L0_LDK(0, Ks_); L0_LDK(1, Ks_); sa0 = mfma_f8q(L0_KFR(0), qf, negm); sa1 = mfma_f8q(L0_KFR(1), qf, negm);
      float rm = fmaxf(sa0[0], sa1[0]);
#pragma unroll
      for (int i = 1; i < 16; ++i) rm = fmaxf(fmaxf(rm, sa0[i]), sa1[i]);
      rm = xmax32(rm); if (has_sink) rm = fmaxf(rm, p.sink2);
      rm -= F8_OFF; m = rm;
#pragma unroll
      for (int i = 0; i < 16; ++i) { sa0[i] -= rm; sa1[i] -= rm; negm[i] = -rm; }
      if (has_sink && hi == 0) ol[0] = fast_exp2(p.sink2 - m); }
    int ks_next = 1, vs_cur = 0;
    for (int t = 0; t < nt - 2; t += 2) {
        L0_TOP(t);     L0_TILE(t, sa0, sa1, sb0, sb1, true);
        L0_TOP(t + 1); L0_TILE(t + 1, sb0, sb1, sa0, sa1, true);
    }
    L0_TOP(nt - 2); L0_TILE(nt - 2, sa0, sa1, sb0, sb1, true);
    ATT_WAITN_BAR(0); L0_TILE(nt - 1, sb0, sb1, sa0, sa1, false);
    l = hi ? 0.f : ol[0];
    const float inv = fast_rcp(xsum32(l));
#pragma unroll
    for (int db = 0; db < NDB; ++db)
#pragma unroll
        for (int g = 0; g < 4; ++g) { const f32x4 v4 = (f32x4){o[db][4 * g], o[db][4 * g + 1], o[db][4 * g + 2], o[db][4 * g + 3]} * inv;
            *(unsigned*)(p.o + (size_t)qrow * p.opitch + 32 * db + 8 * g + 4 * hi) = pg8::pk_fp8x4(v4 * 32.f); }
    ATT_WAITBAR();
#undef L0_UT
#undef L0_ISSUE
#undef L0_SB
#undef L0_LDK
#undef L0_LDV
#undef L0_KFR
#undef L0_PV
#undef L0_VALU8
#undef L0_VALU
#undef L0_MASK
#undef L0_CR
#undef L0_TILE
#undef L0_TOP
}
}

struct Ctx {
    LAS unsigned char* lds; gu32* ctl; unsigned char* ws;
    int tid, lane, wave, vcu, G;
    const float* const __attribute__((address_space(4)))* inp;
    float* out;
};
DI const float* modp(const Ctx& F, int l, int which, int chunk) { return (const float*)(F.ws + WS_MOD) + ((size_t)(l * 3 + which) * 6 + chunk) * 1024; }

DI void ld_f32(const float* p, int lane, f32x4 (&v)[4]) {
#pragma unroll
    for (int j = 0; j < 4; ++j) v[j] = *(const f32x4*)(p + 4 * lane + 256 * j); }
DI void ld_bf16(const bf16_t* p, int lane, f32x4 (&v)[4]) {
#pragma unroll
    for (int j = 0; j < 4; ++j) { const u32x2 w = *(const u32x2*)(p + 4 * lane + 256 * j); v[j] = (f32x4){bf_lo(w.x), bf_hi(w.x), bf_lo(w.y), bf_hi(w.y)}; } }
DI void st_f32(float* p, int lane, const f32x4 (&v)[4]) {
#pragma unroll
    for (int j = 0; j < 4; ++j) *(f32x4*)(p + 4 * lane + 256 * j) = v[j]; }
DI void st_bf16(bf16_t* p, int lane, const f32x4 (&v)[4]) {
#pragma unroll
    for (int j = 0; j < 4; ++j) pg8::st4(p + 4 * lane + 256 * j, v[j]); }
DI void st_fp8row(unsigned char* p, int lane, const f32x4 (&v)[4]) {
#pragma unroll
    for (int j = 0; j < 4; ++j) *(unsigned*)(p + 4 * lane + 256 * j) = pg8::pk_fp8x4(v[j]); }
DI void ld_f32_nt(const float* p, int lane, f32x4 (&v)[4]) {
#pragma unroll
    for (int j = 0; j < 4; ++j) v[j] = __builtin_nontemporal_load((const f32x4*)(p + 4 * lane + 256 * j)); }
DI void ld_bf16_nt(const bf16_t* p, int lane, f32x4 (&v)[4]) {
#pragma unroll
    for (int j = 0; j < 4; ++j) { const u32x2 w = __builtin_nontemporal_load((const u32x2*)(p + 4 * lane + 256 * j)); v[j] = (f32x4){bf_lo(w.x), bf_hi(w.x), bf_lo(w.y), bf_hi(w.y)}; } }
DI void st_f32_nt(float* p, int lane, const f32x4 (&v)[4]) {
#pragma unroll
    for (int j = 0; j < 4; ++j) __builtin_nontemporal_store(v[j], (f32x4*)(p + 4 * lane + 256 * j)); }
DI void st_bf16_nt(bf16_t* p, int lane, const f32x4 (&v)[4]) {
#pragma unroll
    for (int j = 0; j < 4; ++j) { u32x2 w; w.x = cvtpk(v[j][0], v[j][1]); w.y = cvtpk(v[j][2], v[j][3]); __builtin_nontemporal_store(w, (u32x2*)(p + 4 * lane + 256 * j)); } }
DI void layer_norm_row(f32x4 (&v)[4], const float* g, const float* b, int lane) {
    float s = 0.f;
#pragma unroll
    for (int j = 0; j < 4; ++j) s += (v[j][0] + v[j][1]) + (v[j][2] + v[j][3]);
    const float mean = wave_sum(s) * (1.f / 1024.f); float s2 = 0.f;
#pragma unroll
    for (int j = 0; j < 4; ++j) { v[j] = v[j] - mean; s2 += (v[j][0] * v[j][0] + v[j][1] * v[j][1]) + (v[j][2] * v[j][2] + v[j][3] * v[j][3]); }
    const float rstd = 1.0f / sqrtf(wave_sum(s2) * (1.f / 1024.f) + 1e-5f);
    f32x4 gg[4], bb[4]; ld_f32(g, lane, gg); ld_f32(b, lane, bb);
#pragma unroll
    for (int j = 0; j < 4; ++j) v[j] = v[j] * rstd * gg[j] + bb[j];
}
DI void modulate_row(f32x4 (&h)[4], const f32x4 (&v)[4], const float* sc, const float* sh, int lane) {
    f32x4 a[4], b[4]; ld_f32(sc, lane, a); ld_f32(sh, lane, b);
#pragma unroll
    for (int j = 0; j < 4; ++j) h[j] = v[j] * (1.0f + a[j]) + b[j];
}

DI void conv_item(const float* W, int K, int Nsrc, bf16_t* WT, int Ndst, int kind, const float* gk, LAS float* scr, int item, int lane, bool f8 = false) {
    const int nblk = Ndst / 32, kb = item / nblk, nb = item % nblk, k0 = 64 * kb, n0 = 32 * nb;
    int srcb = n0; bool perm = false;
    if (kind == 1) { if (n0 < 512) srcb = 672 + n0; else if (n0 < 1024) srcb = 1184 + (n0 - 512); else if (n0 < 1536) srcb = 1696 + (n0 - 1024); else if (n0 < 1920) srcb = n0 - 1536;
                     else if (n0 < 2176) srcb = 384 + (n0 - 1920); else if (n0 == 2176) { srcb = 640; perm = true; } else srcb = -1; }
    else if (kind == 2) { if (n0 < 512) srcb = (n0 >> 6) * 96 + (n0 & 63); else { srcb = ((n0 - 512) >> 5) * 96 + 64; perm = true; } }
    else if (kind == 3) { if (n0 < 512) srcb = (n0 >> 6) * 128 + (n0 & 63); else srcb = ((n0 - 512) >> 6) * 128 + 64 + ((n0 - 512) & 63); }
    else if (kind == 4) { const int pn = n0 >> 8, w = n0 & 255; srcb = (w < 128) ? (128 * pn + w) : (512 + 128 * pn + (w - 128)); }
    const int nl = lane & 31; int sc = nl; if (perm) sc = (nl < 8) ? nl : (nl < 16 ? nl + 8 : (nl < 24 ? nl - 8 : nl));
    float vv[32];
#pragma unroll
    for (int i = 0; i < 32; ++i) { const int kk = 2 * i + (lane >> 5); vv[i] = (srcb >= 0) ? __builtin_nontemporal_load(W + (size_t)(k0 + kk) * Nsrc + srcb + sc) : 0.f; }
    if (gk) {
#pragma unroll
        for (int i = 0; i < 32; ++i) vv[i] *= gk[k0 + 2 * i + (lane >> 5)]; }
#pragma unroll
    for (int i = 0; i < 32; ++i) scr[(2 * i + (lane >> 5)) * 33 + nl] = vv[i];
    asm volatile("s_waitcnt lgkmcnt(0)" ::: "memory");
    const int c = lane & 7;
#pragma unroll
    for (int j = 0; j < 4; ++j) { const int n = (lane >> 3) + 8 * j; const LAS float* s = scr + (8 * c) * 33 + n;
        u32x4 o; o.x = cvtpk(s[0 * 33], s[1 * 33]); o.y = cvtpk(s[2 * 33], s[3 * 33]); o.z = cvtpk(s[4 * 33], s[5 * 33]); o.w = cvtpk(s[6 * 33], s[7 * 33]);
        if (f8) { u32x2 o8; o8.x = pg8::pk_fp8x4((f32x4){s[0 * 33], s[1 * 33], s[2 * 33], s[3 * 33]} * 64.f); o8.y = pg8::pk_fp8x4((f32x4){s[4 * 33], s[5 * 33], s[6 * 33], s[7 * 33]} * 64.f);
            *(u32x2*)((unsigned char*)WT + (size_t)(n0 + n) * K + k0 + 8 * c) = o8; }
        else __builtin_nontemporal_store(o, (u32x4*)(WT + (size_t)(n0 + n) * K + k0 + 8 * c)); }
    asm volatile("s_waitcnt lgkmcnt(0)" ::: "memory");
}

DI void phase_prologue(const Ctx& F) {
    LAS float* sl = (LAS float*)F.lds;
    LAS float* red = sl + 3072;
    for (int u = blockIdx.x; u < 193; u += F.G) {
        if (u < 192) {
            const int l = u / 96, n0 = (u % 96) * 64;
            for (int idx = F.tid; idx < 3072; idx += 512) { const int which = idx >> 10, k = idx & 1023; const float v = which < 2 ? F.inp[1][which * 1024 + k] : F.inp[3][k]; sl[idx] = v * fast_rcp(1.f + fast_exp2(-v * LOG2E)); }
            __syncthreads();
            float a0 = 0.f, a1 = 0.f, a2 = 0.f; const float* wp = F.inp[4] + ((size_t)l * 1024 + F.wave * 128) * 6144 + n0 + F.lane;
#pragma unroll 8
            for (int k = 0; k < 128; ++k) { const float w = __builtin_nontemporal_load(wp + (size_t)k * 6144); const int kk = F.wave * 128 + k; a0 += sl[kk] * w; a1 += sl[1024 + kk] * w; a2 += sl[2048 + kk] * w; }
            red[(F.wave * 3 + 0) * 64 + F.lane] = a0; red[(F.wave * 3 + 1) * 64 + F.lane] = a1; red[(F.wave * 3 + 2) * 64 + F.lane] = a2;
            __syncthreads();
            if (F.wave < 3) { float s = F.inp[5][l * 6144 + n0 + F.lane];
#pragma unroll
                for (int w = 0; w < 8; ++w) s += red[(w * 3 + F.wave) * 64 + F.lane];
                ((float*)(F.ws + WS_MOD))[(size_t)(l * 3 + F.wave) * 6144 + n0 + F.lane] = s; }
            __syncthreads();
        } else {
            float* r64c = (float*)(F.ws + WS_ROPE); float* r64s = r64c + 4096; float* r32c = r64s + 4096; float* r32s = r32c + 2048;
            for (int idx = F.tid; idx < 4096 + 2048; idx += 512) {
                const bool big = idx < 4096; const int id = big ? idx : idx - 4096; const int pos = big ? (id >> 4) : (id >> 3), i = big ? (id & 15) : (id & 7);
                const float inv = exp2f(-(float)i * (big ? (13.287712379549449f / 16.f) : (13.287712379549449f / 8.f)));
                const float ang = (float)pos * inv;
                const float kq = rintf(ang * 0.15915494309189535f);
                float r = fmaf(-kq, 6.2831854820251465f, ang); r = fmaf(-kq, -1.7484555314695172e-07f, r);
                const float cs = __cosf(r), sn = __sinf(r);
                if (big) { r64c[id] = cs; r64s[id] = sn; } else { r32c[id] = cs; r32s[id] = sn; }
            }
        }
    }
    __syncthreads();
    LAS float* scr = (LAS float*)(F.lds + F.wave * 8448);
    const int gw = F.vcu * 8 + F.wave, NGW = F.G * 8;
    constexpr int I_IN = 16 * 72, I_SQ = 16 * 32, I_UQ = 6 * 24, I_UKV = 4 * 32;
    constexpr int NITEMS = 2 * I_IN + 2 * I_SQ + I_UQ + I_UKV;
    for (int it = gw; it < NITEMS; it += NGW) {
        int r = it;
        if (r < I_IN) { conv_item(F.inp[8], 1024, 2304, (bf16_t*)(F.ws + WS_WAB_IN), 2304, 0, nullptr, scr, r, F.lane, true); continue; } r -= I_IN;
        if (r < I_IN) { conv_item(F.inp[12], 1024, 2208, (bf16_t*)(F.ws + WS_WCD_IN), 2304, 1, nullptr, scr, r, F.lane, true); continue; } r -= I_IN;
        if (r < I_SQ) { conv_item(F.inp[11], 1024, 1024, (bf16_t*)(F.ws + WS_WAB_OUT), 1024, 0, nullptr, scr, r, F.lane, true); continue; } r -= I_SQ;
        if (r < I_SQ) { conv_item(F.inp[19], 1024, 1024, (bf16_t*)(F.ws + WS_WCD_OUT), 1024, 0, nullptr, scr, r, F.lane, true); continue; } r -= I_SQ;
        if (r < I_UQ) { conv_item(F.inp[14], 384, 768, (bf16_t*)(F.ws + WS_WUQ), 768, 2, F.inp[13], scr, r, F.lane); continue; } r -= I_UQ;
        conv_item(F.inp[16], 256, 1024, (bf16_t*)(F.ws + WS_WUKV), 1024, 3, F.inp[15], scr, r, F.lane);
    }
}

DI void conv_moe_slice(const Ctx& F, int l, int step) {
    constexpr int I_GU = 16 * 32, I_DN = 8 * 32, PER_L = 32 * I_GU + 32 * I_DN;
    LAS float* scr = (LAS float*)(F.lds + F.wave * 8448);
    const int per_wg = (PER_L + F.G - 1) / F.G, per_step = (per_wg + 7) / 8;
    const int lo = (int)blockIdx.x * per_wg + step * per_step;
    int hi = lo + per_step; const int wg_hi = ((int)blockIdx.x + 1) * per_wg; hi = hi < wg_hi ? hi : wg_hi; hi = hi < PER_L ? hi : PER_L;
    for (int r = lo + F.wave; r < hi; r += 8) {
        if (r < 32 * I_GU) { const int mtx = l * 32 + r / I_GU; conv_item(F.inp[24] + (size_t)mtx * 1024 * 1024, 1024, 1024, (bf16_t*)(F.ws + WS_WGU + (size_t)mtx * 1024 * 1024), 1024, 4, nullptr, scr, r % I_GU, F.lane, true); }
        else { const int r2 = r - 32 * I_GU; const int mtx = l * 32 + r2 / I_DN; conv_item(F.inp[25] + (size_t)mtx * 512 * 1024, 512, 1024, (bf16_t*)(F.ws + WS_WDN + (size_t)mtx * 1024 * 512), 1024, 0, nullptr, scr, r2 % I_DN, F.lane, true); }
    }
}

DI const float* src_row_l0(const Ctx& F, int urow, int& which) {
    const int b = urow / RB, rr = urow - b * RB;
    if (rr < CTXL) { which = 2; return F.inp[2] + ((size_t)b * CTXL + rr) * 1024; }
    which = b; return F.inp[0] + ((size_t)b * SEQ + (rr - CTXL)) * 1024;
}

DI void phase_modulate0(const Ctx& F) {
    bf16_t* H = (bf16_t*)(F.ws + WS_H);
    for (int urow = F.vcu * 8 + F.wave; urow < MU; urow += F.G * 8) {
        int which; const float* src = src_row_l0(F, urow, which);
        f32x4 v[4], h[4]; ld_f32_nt(src, F.lane, v);
        modulate_row(h, v, modp(F, 0, which, 1), modp(F, 0, which, 0), F.lane);
        st_fp8row((unsigned char*)H + (size_t)urow * 1024, F.lane, h);
    }
}

constexpr int PASS_ROWS = 136;
template <int CTRL> DI float dpp_ror_add(float v) { return v + __builtin_bit_cast(float, __builtin_amdgcn_update_dpp(0, __builtin_bit_cast(int, v), CTRL, 0xf, 0xf, false)); }
DI float reduce4(float a, float b, float c, float d) {
    auto r1 = __builtin_amdgcn_permlane32_swap(__float_as_uint(a), __float_as_uint(b), false, false);
    auto r2 = __builtin_amdgcn_permlane32_swap(__float_as_uint(c), __float_as_uint(d), false, false);
    const float z1 = __uint_as_float(r1[0]) + __uint_as_float(r1[1]);
    const float z2 = __uint_as_float(r2[0]) + __uint_as_float(r2[1]);
    auto r3 = __builtin_amdgcn_permlane16_swap(__float_as_uint(z1), __float_as_uint(z2), false, false);
    float w = __uint_as_float(r3[0]) + __uint_as_float(r3[1]);
    w = dpp_ror_add<0x128>(w); w = dpp_ror_add<0x124>(w); w = dpp_ror_add<0x122>(w); w = dpp_ror_add<0x121>(w);
    return w;
}
DI void phase_ln1_router(const Ctx& F, const int l) {
    constexpr int RG = 2;
    constexpr int WRS = 1028;
    LAS float* Wr = (LAS float*)F.lds;
    LAS unsigned* rinfo = (LAS unsigned*)(F.lds + 148480);
    LAS int* lcnt = (LAS int*)(F.lds + 148480 + PASS_ROWS * 32);
    LAS int* lbase = lcnt + 32;
    LAS float* lgs = (LAS float*)(F.lds + 148480 + PASS_ROWS * 32 + 256) + F.wave * (RG * 36);
    const float* wg = F.inp[20] + (size_t)l * 4096; const float* we = F.inp[22] + (size_t)l * 32768;
    for (int idx = F.tid; idx < 4096; idx += 512) Wr[(idx & 3) * WRS + (idx >> 2)] = wg[idx];
    for (int idx = F.tid; idx < 32768; idx += 512) Wr[(4 + (idx & 31)) * WRS + (idx >> 5)] = we[idx];
    if (F.tid < 32) lcnt[F.tid] = 0;
    __syncthreads();
    const int nrows = (l == 0) ? MU : NB * SEQ;
    const int rpw = (nrows + F.G - 1) / F.G, r_begin = (int)blockIdx.x * rpw, r_end = (r_begin + rpw < nrows) ? r_begin + rpw : nrows;
    const bf16_t* YP = (const bf16_t*)(F.ws + WS_YP); bf16_t* XA = (bf16_t*)(F.ws + WS_XA); const bf16_t* XB = (const bf16_t*)(F.ws + WS_XB); bf16_t* H = (bf16_t*)(F.ws + WS_H);
    int* list = (int*)(F.ws + WS_LIST); unsigned* tokinfo = (unsigned*)(F.ws + WS_TOKINFO); unsigned* gcnt = (unsigned*)(F.ctl + CW_CNT + l * 32);
    const float* lng = F.inp[6] + (size_t)(l * 2 + 0) * 1024; const float* lnb = F.inp[7] + (size_t)(l * 2 + 0) * 1024;
    const float* bgp = F.inp[21] + l * 4; const float* bep = F.inp[23] + l * 32;
    for (int pb = r_begin; pb < r_end; pb += PASS_ROWS) {
        const int npass = (r_end - pb < PASS_ROWS) ? (r_end - pb) : PASS_ROWS;
        for (int g4 = F.wave; RG * g4 < npass; g4 += 8) {
            f32x4 hm[RG][4]; int urows[RG];
#pragma unroll
            for (int r = 0; r < RG; ++r) {
                const int lr = RG * g4 + r;
                if (lr < npass) {
                    const int j = pb + lr; int urow, which; const float* src = nullptr;
                    if (l == 0) { urow = j; src = src_row_l0(F, urow, which); }
                    else { const int b = j >> 14; urow = b * RB + CTXL + (j & 16383); which = b; }
                    urows[r] = urow;
                    f32x4 v[4], y[4], g1[4]; if (l == 0) ld_f32_nt(src, F.lane, v); else ld_bf16_nt(XB + (size_t)urow * 1024, F.lane, v); ld_bf16_nt(YP + (size_t)urow * 1024, F.lane, y); ld_f32(modp(F, l, which, 2), F.lane, g1);
#pragma unroll
                    for (int jj = 0; jj < 4; ++jj) v[jj] = v[jj] * DN_ALPHA + g1[jj] * y[jj];
                    layer_norm_row(v, lng, lnb, F.lane);
                    st_bf16_nt(XA + (size_t)urow * 1024, F.lane, v);
                    modulate_row(hm[r], v, modp(F, l, which, 4), modp(F, l, which, 3), F.lane);
                    st_fp8row((unsigned char*)H + (size_t)urow * 1024, F.lane, hm[r]);
                } else { urows[r] = 0;
#pragma unroll
                    for (int jj = 0; jj < 4; ++jj) hm[r][jj] = (f32x4){0.f, 0.f, 0.f, 0.f}; }
            }
#pragma unroll 3
            for (int c4 = 0; c4 < 9; ++c4) {
                float pr[RG][4];
#pragma unroll
                for (int cc = 0; cc < 4; ++cc) {
                    f32x4 w[4];
#pragma unroll
                    for (int jj = 0; jj < 4; ++jj) w[jj] = *(const LAS f32x4*)(Wr + (c4 * 4 + cc) * WRS + 256 * jj + 4 * F.lane);
#pragma unroll
                    for (int r = 0; r < RG; ++r) { f32x2 a2 = (f32x2){0.f, 0.f};
#pragma unroll
                        for (int jj = 0; jj < 4; ++jj) { a2 += (f32x2){hm[r][jj][0], hm[r][jj][1]} * (f32x2){w[jj][0], w[jj][1]}; a2 += (f32x2){hm[r][jj][2], hm[r][jj][3]} * (f32x2){w[jj][2], w[jj][3]}; }
                        pr[r][cc] = a2[0] + a2[1]; }
                }
#pragma unroll
                for (int r = 0; r < RG; ++r) {
                    const float wv = reduce4(pr[r][0], pr[r][1], pr[r][2], pr[r][3]);
                    const int q = F.lane >> 4; const int cmap = (q == 1) ? 2 : (q == 2 ? 1 : q);
                    if ((F.lane & 15) == 0) lgs[r * 36 + c4 * 4 + cmap] = wv;
                }
            }
            asm volatile("s_waitcnt lgkmcnt(0)" ::: "memory");
            if (F.lane < RG && RG * g4 + F.lane < npass) {
                const int r = F.lane, lr = RG * g4 + r; const LAS float* lg = lgs + r * 36;
                float gv[4];
#pragma unroll
                for (int i = 0; i < 4; ++i) gv[i] = lg[i] + bgp[i];
                int gi = 0; float gm = gv[0];
#pragma unroll
                for (int i = 1; i < 4; ++i) if (gv[i] > gm) { gm = gv[i]; gi = i; }
                float gs = 0.f;
#pragma unroll
                for (int i = 0; i < 4; ++i) gs += fast_exp2((gv[i] - gm) * LOG2E);
                const float gval = 1.0f / gs;
                float ev[8];
#pragma unroll
                for (int i = 0; i < 8; ++i) ev[i] = lg[4 + 8 * gi + i] + bep[8 * gi + i];
                int i1 = 0; float m1 = ev[0];
#pragma unroll
                for (int i = 1; i < 8; ++i) if (ev[i] > m1) { m1 = ev[i]; i1 = i; }
                int i2 = -1; float m2 = -INFINITY;
#pragma unroll
                for (int i = 0; i < 8; ++i) if (i != i1 && ev[i] > m2) { m2 = ev[i]; i2 = i; }
                const float tt = fast_exp2((m2 - m1) * LOG2E); const float w0 = gval / (1.f + tt), w1 = gval * tt / (1.f + tt);
                const int E0 = gi * 8 + i1, E1 = gi * 8 + i2;
                const int ls0 = __hip_atomic_fetch_add(lcnt + E0, 1, __ATOMIC_RELAXED, __HIP_MEMORY_SCOPE_WORKGROUP);
                const int ls1 = __hip_atomic_fetch_add(lcnt + E1, 1, __ATOMIC_RELAXED, __HIP_MEMORY_SCOPE_WORKGROUP);
                LAS unsigned* ri = rinfo + lr * 8;
                ri[0] = (unsigned)E0; ri[1] = (unsigned)ls0; ri[2] = __float_as_uint(w0); ri[3] = (unsigned)E1; ri[4] = (unsigned)ls1; ri[5] = __float_as_uint(w1);
                ri[6] = (unsigned)(r == 0 ? urows[0] : urows[RG - 1]);
            }
            asm volatile("s_waitcnt lgkmcnt(0)" ::: "memory");
        }
        __syncthreads();
        if (F.tid < 32) { const int n = lcnt[F.tid]; lbase[F.tid] = n > 0 ? (int)__hip_atomic_fetch_add(gcnt + F.tid, (unsigned)n, __ATOMIC_RELAXED, __HIP_MEMORY_SCOPE_AGENT) : 0; }
        __syncthreads();
        for (int lr = F.tid; lr < npass; lr += 512) {
            const LAS unsigned* ri = rinfo + lr * 8;
            const int E0 = (int)ri[0], E1 = (int)ri[3]; const int s0 = lbase[E0] + (int)ri[1], s1 = lbase[E1] + (int)ri[4]; const int urow = (int)ri[6];
            list[(size_t)E0 * LIST_CAP + s0] = urow; list[(size_t)E1 * LIST_CAP + s1] = urow;
            u32x4 a; a.x = (unsigned)E0; a.y = (unsigned)s0; a.z = ri[2]; a.w = (unsigned)E1; u32x4 b; b.x = (unsigned)s1; b.y = ri[5]; b.z = 0u; b.w = 0u;
            *(u32x4*)(tokinfo + (size_t)urow * 8) = a; *(u32x4*)(tokinfo + (size_t)urow * 8 + 4) = b;
        }
        __syncthreads();
        if (F.tid < 32) lcnt[F.tid] = 0;
        __syncthreads();
    }
}

DI void moe_tables(const Ctx& F, int l) {
    LAS int* tb = (LAS int*)(F.lds + LDS_AUX);
    if (F.tid < 32) tb[64 + F.tid] = (int)__hip_atomic_load(F.ctl + CW_CNT + l * 32 + F.tid, RLX_AGENT);
    __syncthreads();
    if (F.tid == 0) { int a = 0; for (int e = 0; e < 32; ++e) { tb[e] = a; a += (tb[64 + e] + 255) >> 8; } tb[32] = a; }
    __syncthreads();
}
struct MoeOrder {
    const LAS int* tb; int G, c; const char* A; const char* W; size_t wstride, tstepB, tstepA; const int* list; unsigned lda2; bool gatherA;
    DI bool next(int i, pg8::Unit& u) const {
        const int ntot = tb[32]; const long L = (long)i * G + c; if (L >= (long)ntot * 4) return false;
        const int rt = (int)(L >> 2), pn = (int)(L & 3); int e = 0;
        for (int j = 1; j < 32; ++j) e += (tb[j] <= rt) ? 1 : 0;
        e = __builtin_amdgcn_readfirstlane(e);
        u.pm = rt; u.pn = pn; u.aux0 = e; u.aux1 = __builtin_amdgcn_readfirstlane((rt - tb[e]) * 256);
        u.A = gatherA ? A : A + (size_t)rt * tstepA; u.B = W + (size_t)e * wstride + (size_t)pn * tstepB; return true;
    }
    DI unsigned gather(const pg8::Unit& u, int r) const {
        const int slot = u.aux1 + r, n = tb[64 + u.aux0];
        const int tok = list[(size_t)u.aux0 * LIST_CAP + (slot < n ? slot : 0)];
        return (unsigned)tok * lda2;
    }
};

DI void phase_ln2(const Ctx& F, const int l) {
    moe_tables(F, l);
    const LAS int* tb = (const LAS int*)(F.lds + LDS_AUX);
    const bf16_t* YS = (const bf16_t*)(F.ws + WS_YS); const bf16_t* XA = (const bf16_t*)(F.ws + WS_XA); bf16_t* XB = (bf16_t*)(F.ws + WS_XB); bf16_t* H = (bf16_t*)(F.ws + WS_H);
    const unsigned* tokinfo = (const unsigned*)(F.ws + WS_TOKINFO);
    const float* lng = F.inp[6] + (size_t)(l * 2 + 1) * 1024; const float* lnb = F.inp[7] + (size_t)(l * 2 + 1) * 1024;
    const int nrows = (l == 0) ? MU : NB * SEQ;
    const int stride = F.G * 8;
    for (int j0 = F.vcu * 8 + F.wave; j0 < nrows; j0 += 2 * stride) {
        int urow[2], which[2], bb[2], ss[2]; bool ok[2]; u32x4 ia[2]; u32x2 ib[2]; f32x4 v[2][4], ya[2][4], yb[2][4];
#pragma unroll
        for (int r = 0; r < 2; ++r) { const int j = j0 + r * stride; ok[r] = j < nrows; const int jj = ok[r] ? j : j0;
            if (l == 0) { urow[r] = jj; bb[r] = jj / RB; which[r] = (jj - bb[r] * RB) < CTXL ? 2 : bb[r]; ss[r] = 0; }
            else { bb[r] = jj >> 14; ss[r] = jj & 16383; urow[r] = bb[r] * RB + CTXL + ss[r]; which[r] = bb[r]; }
            ia[r] = *(const u32x4*)(tokinfo + (size_t)urow[r] * 8); ib[r] = *(const u32x2*)(tokinfo + (size_t)urow[r] * 8 + 4);
            ld_bf16_nt(XA + (size_t)urow[r] * 1024, F.lane, v[r]); }
#pragma unroll
        for (int r = 0; r < 2; ++r) { const int p0 = tb[ia[r].x] * 256 + (int)ia[r].y, p1 = tb[ia[r].w] * 256 + (int)ib[r].x;
            ld_bf16_nt(YS + (size_t)p0 * 1024, F.lane, ya[r]); ld_bf16_nt(YS + (size_t)p1 * 1024, F.lane, yb[r]); }
#pragma unroll
        for (int r = 0; r < 2; ++r) {
            if (!ok[r]) continue;
            const float w0 = __uint_as_float(ia[r].z), w1 = __uint_as_float(ib[r].y);
            f32x4 g2[4]; ld_f32(modp(F, l, which[r], 5), F.lane, g2);
#pragma unroll
            for (int jj = 0; jj < 4; ++jj) v[r][jj] = v[r][jj] * DN_ALPHA + g2[jj] * (ya[r][jj] * w0 + yb[r][jj] * w1);
            layer_norm_row(v[r], lng, lnb, F.lane);
            if (l == 0) {
                st_bf16_nt(XB + (size_t)urow[r] * 1024, F.lane, v[r]);
                f32x4 h[4]; modulate_row(h, v[r], modp(F, 1, which[r], 1), modp(F, 1, which[r], 0), F.lane);
                st_fp8row((unsigned char*)H + (size_t)urow[r] * 1024, F.lane, h);
            } else st_f32_nt(F.out + ((size_t)bb[r] * SEQ + ss[r]) * 1024, F.lane, v[r]);
        }
    }
}

template <class Sched> DI void rms_tables(const Ctx& F, const Sched& S, const bf16_t* base, int col0, int ncols, LAS float* rs) {
    pg8::Unit u;
    for (int i = 0; i < 16 && S.next(i, u); ++i) {
        const int r = F.tid >> 1, hsel = F.tid & 1; const int half = ncols / 2;
        const bf16_t* p = base + (size_t)(u.pm * 256 + r) * NQKV + col0 + hsel * half; float ss = 0.f;
        for (int k = 0; k < half; k += 8) { const u32x4 w = *(const u32x4*)(p + k);
            ss += bf_lo(w.x) * bf_lo(w.x) + bf_hi(w.x) * bf_hi(w.x) + bf_lo(w.y) * bf_lo(w.y) + bf_hi(w.y) * bf_hi(w.y) + bf_lo(w.z) * bf_lo(w.z) + bf_hi(w.z) * bf_hi(w.z) + bf_lo(w.w) * bf_lo(w.w) + bf_hi(w.w) * bf_hi(w.w); }
        ss += __shfl_xor(ss, 1);
        if (hsel == 0) rs[i * 256 + r] = 1.0f / sqrtf(ss / (float)ncols + 1e-6f);
    }
    __syncthreads();
}

#ifndef MK_PER_PHASE
#define MK_PER_PHASE 0
#endif
constexpr int N_PHASES = 17;
struct Args { const float* in[26]; float* out; unsigned char* ws; int ph_lo, ph_hi; };

__global__ void __launch_bounds__(512, 2) mk_fwd(Args args) {
    extern __shared__ __attribute__((aligned(16))) unsigned char lds_raw[];
    Ctx F;
    F.lds = (LAS unsigned char*)lds_raw; F.ws = args.ws; F.ctl = (gu32*)(args.ws + WS_CTL);
    F.tid = threadIdx.x; F.lane = F.tid & 63; F.wave = __builtin_amdgcn_readfirstlane(F.tid >> 6);
    F.G = gridDim.x; { const int bx = blockIdx.x; F.vcu = (F.G % 8 == 0) ? (bx % 8) * (F.G / 8) + bx / 8 : bx; }
    F.inp = (const float* const __attribute__((address_space(4)))*)__builtin_amdgcn_kernarg_segment_ptr();
    F.out = args.out;
    volatile LAS unsigned* MISC = (volatile LAS unsigned*)(F.lds + LDS_MISC);
    if (F.tid < 16) MISC[F.tid] = 0u;
    __syncthreads();
    XcdBarrier bar; bar.bar = (unsigned*)(F.ctl + CW_BAR); bar.x = 0; bar.st = nullptr;
    if (!MK_PER_PHASE) bar = xcd_barrier_post((unsigned*)(F.ctl + CW_BAR), MISC);
    const int lo = args.ph_lo, hi = args.ph_hi;
#define IN(k) (lo <= (k) && (k) < hi)
#define SEAM(k) do { if (IN(k) && IN((k) + 1)) xcd_barrier(bar); } while (0)
#define H ((bf16_t*)(F.ws + WS_H))
#define AO ((bf16_t*)(F.ws + WS_AO))
#define QKV ((bf16_t*)(F.ws + WS_QKV))
#define YP ((bf16_t*)(F.ws + WS_YP))
#define ACT ((bf16_t*)(F.ws + WS_ACT))
#define YS ((bf16_t*)(F.ws + WS_YS))
#define QM ((bf16_t*)(F.ws + WS_QM))
#define KVM ((bf16_t*)(F.ws + WS_KVM))
#define r32c ((const float*)(F.ws + WS_ROPE) + 8192)
#define r32s ((const float*)(F.ws + WS_ROPE) + 8192 + 2048)
    LAS unsigned char* ring = F.lds;

    if (IN(0)) { phase_prologue(F); } SEAM(0);
    if (IN(1)) { phase_modulate0(F); } SEAM(1);

    if (IN(2)) {
        pg8::DenseOrder S; S.init(130, 9, F.G, (int)blockIdx.x, false, H, 512, F.ws + WS_WAB_IN, 512);
        pg8::EpiInProj<0> E{F.ws};
        pg8::gemm_phase<pg8::EpiInProj<0>, pg8::DenseOrder, false, true>(ring, 512, 512, S, E);
    } SEAM(2);
    if (IN(3)) {
        LAS float* rpbL = (LAS float*)(F.lds + LDS_AUX); int nconv = 0;
        for (int i = 0;; ++i) {
            const int L = i * F.G + F.vcu; if (L >= 2048 + 32) break;
            att::P p; p.opitch = 1024; p.qpitch = 512; p.k8r = nullptr; p.lam = 0.f; p.subln = nullptr; p.sink2 = 0.f; p.t_lo = 4; p.s0 = 0;
            int b, head, mixer; size_t qr0;
            if (L >= 2048) { const int Lc = L - 2048, j = Lc & 15; mixer = Lc >> 4; b = j >> 3; head = j & 7; p.kind = 2 + mixer; p.nt = 4; qr0 = (size_t)(b * RB); }
            else { const int j = L & 1023; mixer = L >> 10; const int qb = j & 63; head = (j >> 6) & 7; b = j >> 9; p.kind = mixer; p.s0 = qb * 256; qr0 = (size_t)(b * RB + CTXL + p.s0);
                int tlo, thi;
                if (mixer == 0) { tlo = p.s0 / 64 - 2; thi = p.s0 / 64 + 5; tlo = tlo < 0 ? 0 : tlo; thi = thi > 255 ? 255 : thi; }
                else { const int R0 = p.s0 >> 6; tlo = R0 - 4; tlo = tlo < 0 ? 0 : (tlo > 248 ? 248 : tlo); thi = R0 - 1; thi = thi < 0 ? 0 : (thi > 248 ? 248 : thi); thi += 7; }
                p.t_lo = 4 + tlo; p.nt = 4 + (thi - tlo + 1); }
            p.o = (unsigned char*)AO + qr0 * 1024;
            if (mixer == 0) { p.o += head * 64; p.sink2 = F.inp[9][head] * LOG2E;
                p.k8 = F.ws + WS_K8A + (size_t)(b * 2 + (head >> 2)) * 260 * 4096; p.v8 = F.ws + WS_VT8A + (size_t)(b * 2 + (head >> 2)) * 260 * 4096; p.q8 = F.ws + WS_Q8A + qr0 * 512 + head * 64; }
            else { p.o += 512 + head * 64;
                p.k8 = F.ws + WS_K8B + (size_t)(b * 8 + head) * 260 * 4096; p.v8 = F.ws + WS_VT8B + (size_t)(b * 8 + head) * 260 * 4096; p.q8 = F.ws + WS_Q8B + qr0 * 512 + head * 64;
                if (p.kind == 1) for (int idx = F.tid; idx < 465; idx += 512) rpbL[idx] = F.inp[10][head * 465 + idx] * LOG2E; }
            p.nt += (p.nt & 1);
            att::attn_unit_f8l0(p, ring, rpbL);
            if (i < 8) { conv_moe_slice(F, 0, i); __syncthreads(); }
            nconv = i + 1;
        }
        for (int s = nconv; s < 8; ++s) { conv_moe_slice(F, 0, s); __syncthreads(); }
    } SEAM(3);

#define LAYER_TAIL(l) do {\
        const int pb = (l == 0) ? 4 : 12;\
        if (IN(pb)) {\
            pg8::DenseOrder S; S.init(l == 0 ? 130 : 128, 4, F.G, (int)blockIdx.x, l == 1, AO, 512, F.ws + (l == 0 ? WS_WAB_OUT : WS_WCD_OUT), 512);\
            pg8::EpiPlain E{YP, 1024};\
            pg8::gemm_phase<pg8::EpiPlain, pg8::DenseOrder, false, true>(ring, 512, 512, S, E, 0x7a7a7a7a);    \
        } SEAM(pb);\
        if (IN(pb + 1)) { phase_ln1_router(F, l); } SEAM(pb + 1);\
        if (IN(pb + 2)) {\
            moe_tables(F, l);\
            MoeOrder S{(const LAS int*)(F.lds + LDS_AUX), F.G, (int)blockIdx.x, (const char*)H, (const char*)(F.ws + WS_WGU) + (size_t)l * 32 * 1024 * 1024, (size_t)1024 * 1024, (size_t)256 * 1024, 0,\
                       (const int*)(F.ws + WS_LIST), 1024u, true};\
            pg8::EpiGU E{(unsigned char*)ACT};\
            pg8::gemm_phase<pg8::EpiGU, MoeOrder, true, true>(ring, 512, 512, S, E);                     \
        } SEAM(pb + 2);\
        if (IN(pb + 3)) {\
            moe_tables(F, l);\
            MoeOrder S{(const LAS int*)(F.lds + LDS_AUX), F.G, (int)blockIdx.x, (const char*)ACT, (const char*)(F.ws + WS_WDN) + (size_t)l * 32 * 1024 * 512, (size_t)1024 * 512, (size_t)256 * 512, (size_t)256 * 512,\
                       (const int*)(F.ws + WS_LIST), 0u, false};\
            pg8::EpiPlain E{YS, 1024};\
            pg8::gemm_phase<pg8::EpiPlain, MoeOrder, false, true>(ring, 256, 256, S, E);                \
        } SEAM(pb + 3);\
        if (IN(pb + 4)) { phase_ln2(F, l); }\
    } while (0)
    LAYER_TAIL(0); SEAM(8);

    if (IN(9)) {
        pg8::DenseOrder S; S.init(130, 9, F.G, (int)blockIdx.x, false, H, 512, F.ws + WS_WCD_IN, 512);
        pg8::EpiInProj<1> E{F.ws};
        pg8::gemm_phase<pg8::EpiInProj<1>, pg8::DenseOrder, false, true>(ring, 512, 512, S, E);
    } SEAM(9);
    if (IN(10)) {
        LAS float* rsq = (LAS float*)(F.lds + LDS_AUX); LAS float* rskv = rsq + 1024;
        pg8::DenseOrder Sq; Sq.init(128, 3, F.G, (int)blockIdx.x, true, QKV + 1536, NQKV, F.ws + WS_WUQ, 384);
        pg8::DenseOrder Skv; Skv.init(130, 4, F.G, (int)blockIdx.x, false, QKV + 1920, NQKV, F.ws + WS_WUKV, 256);
        rms_tables(F, Sq, QKV, 1536, 384, rsq);
        rms_tables(F, Skv, QKV, 1920, 256, rskv);
        pg8::EpiUQ Eq{F.ws + WS_Q8M, rsq, r32c, r32s};
        pg8::gemm_phase<pg8::EpiUQ, pg8::DenseOrder, false>(ring, NQKV, 384, Sq, Eq);
        pg8::EpiUKV Ekv{F.ws + WS_K8M, rskv, F.ws + WS_VT8M};
        pg8::gemm_phase<pg8::EpiUKV, pg8::DenseOrder, false>(ring, NQKV, 256, Skv, Ekv);
    } SEAM(10);
    if (IN(11)) {
        float lam; { const float* lp = F.inp[17]; float s01 = 0.f, s23 = 0.f; for (int i = 0; i < 64; ++i) { s01 += lp[i] * lp[64 + i]; s23 += lp[128 + i] * lp[192 + i]; }
            lam = fast_exp2(s01 * LOG2E) - fast_exp2(s23 * LOG2E) + LAM_INIT; }
        int nconv = 0;
        for (int i = 0;; ++i) {
            const int L = i * F.G + F.vcu; if (L >= 2048) break;
            att::P p; p.kind = 0; p.t_lo = 0; p.s0 = 0; p.sink2 = 0.f; p.nt = RB / 64; p.opitch = 1024; p.lam = lam; p.subln = F.inp[18];
            if (L < 1024) { const int qb = L & 63, head = (L >> 6) & 7, b = L >> 9; const size_t qrow0 = (size_t)(b * RB + CTXL + qb * 256);
                p.o = (unsigned char*)AO + qrow0 * 1024 + head * 64; p.v8 = F.ws + WS_VT8M + (size_t)(b * 8 + head) * 260 * 4096; p.k8 = F.ws + WS_K8M + (size_t)(b * 8 + head) * 260 * 4096; p.k8r = F.ws + WS_K8R + (size_t)b * 260 * 2048;
                p.q8 = F.ws + WS_Q8M + qrow0 * 768 + head * 96; p.qpitch = 768;
                att::attn_unit_f8q<1>(p, ring);
            } else { const int j = L - 1024; const int qb = j & 127, head = (j >> 7) & 3, b = j >> 9; const size_t qrow0 = (size_t)(b * RB + CTXL + qb * 128);
                p.o = (unsigned char*)AO + qrow0 * 1024 + 512 + head * 128; p.v8 = F.ws + WS_VT8D + (size_t)(b * 4 + head) * 260 * 8192; p.k8 = F.ws + WS_K8D + (size_t)(b * 4 + head) * 260 * 8192; p.k8r = nullptr;
                p.q8 = F.ws + WS_Q8D + qrow0 * 512 + head * 128; p.qpitch = 512;
                att::attn_unit_f8q<2>(p, ring);
            }
            if (i < 8) { conv_moe_slice(F, 1, i); __syncthreads(); }
            nconv = i + 1;
        }
        for (int s = nconv; s < 8; ++s) { conv_moe_slice(F, 1, s); __syncthreads(); }
    } SEAM(11);

    LAYER_TAIL(1);
#undef LAYER_TAIL
#undef IN
#undef SEAM
#undef H
#undef AO
#undef QKV
#undef YP
#undef ACT
#undef YS
#undef QM
#undef KVM
#undef r32c
#undef r32s
}

extern "C" void kernel_launch(void* const* d_in, const int* in_sizes, int n_in, void* d_out, int out_size, void* d_ws, size_t ws_size, hipStream_t stream) {
    static int grid = 0;
    if (grid == 0) {
        if (n_in != 26 || out_size != NB * SEQ * DM || ws_size < WS_END) { fprintf(stderr, "kernel_launch: unexpected shapes (n_in %d, out %d, ws %zu < %zu)\n", n_in, out_size, ws_size, (size_t)WS_END); grid = -1; return; }
        int dev = 0, cus = 0, per_cu = 0;
        if (hipGetDevice(&dev) != hipSuccess || hipDeviceGetAttribute(&cus, hipDeviceAttributeMultiprocessorCount, dev) != hipSuccess) { grid = -1; return; }
        if (hipFuncSetAttribute((const void*)mk_fwd, hipFuncAttributeMaxDynamicSharedMemorySize, LDS_BYTES) != hipSuccess) { fprintf(stderr, "kernel_launch: hipFuncSetAttribute failed\n"); grid = -1; return; }
        if (hipOccupancyMaxActiveBlocksPerMultiprocessor(&per_cu, (const void*)mk_fwd, 512, LDS_BYTES) != hipSuccess || per_cu < 1) fprintf(stderr, "kernel_launch: occupancy query says %d\n", per_cu);
        (void)hipGetLastError();
        grid = cus;
    }
    if (grid < 0) return;
    (void)hipMemsetAsync((char*)d_ws + WS_CTL, 0, CTL_ZERO_BYTES, stream);
    Args a{};
    for (int i = 0; i < 26; ++i) a.in[i] = (const float*)d_in[i];
    a.out = (float*)d_out; a.ws = (unsigned char*)d_ws;
#if MK_PER_PHASE
    for (int ph = 0; ph < N_PHASES; ++ph) { a.ph_lo = ph; a.ph_hi = ph + 1; hipLaunchKernelGGL(mk_fwd, dim3(grid), dim3(512), LDS_BYTES, stream, a); }
#else
    a.ph_lo = 0; a.ph_hi = N_PHASES;
    hipLaunchKernelGGL(mk_fwd, dim3(grid), dim3(512), LDS_BYTES, stream, a);
#endif
}
```

```cpp
#include <hip/hip_runtime.h>
#include <cstdio>
#include <cstdint>

#define GAS __attribute__((address_space(1)))
#define LAS __attribute__((address_space(3)))
typedef unsigned short bf16_t;
typedef short bf16x8 __attribute__((ext_vector_type(8)));
typedef short s16x4 __attribute__((ext_vector_type(4)));
typedef float f32x4 __attribute__((ext_vector_type(4)));
typedef float f32x2 __attribute__((ext_vector_type(2)));
typedef float f32x16 __attribute__((ext_vector_type(16)));
typedef unsigned u32x4 __attribute__((ext_vector_type(4)));
typedef unsigned u32x2 __attribute__((ext_vector_type(2)));
typedef __bf16 bf16x2_t __attribute__((ext_vector_type(2)));
typedef short v4i16_t __attribute__((ext_vector_type(4)));
typedef GAS unsigned gu32;
#define RLX_AGENT __ATOMIC_RELAXED, __HIP_MEMORY_SCOPE_AGENT
#define DI __device__ __forceinline__

constexpr int DM = 1024, NB = 2, SEQ = 16384, CTXL = 256;
constexpr int RB = SEQ + CTXL;
constexpr int MU = NB * RB;
constexpr int NEXP = 32, DEXP = 512;
constexpr float LOG2E = 1.4426950408889634f;
constexpr float DN_ALPHA = 1.4142135623730951f;
constexpr float LAM_INIT = 0.8f - 0.6f * 0.7408182206817179f;
constexpr int NQKV = 2304;
constexpr int LIST_CAP = MU;
constexpr int RMAX = 74752;

constexpr size_t MiB = 1u << 20;
constexpr size_t WS_CTL = 0, CTL_ZERO_BYTES = 64 * 1024;
constexpr size_t WS_MOD = 1 * MiB;
constexpr size_t WS_ROPE = 1 * MiB + 256 * 1024;
constexpr size_t WS_TOKINFO = 2 * MiB;
constexpr size_t WS_LIST = 4 * MiB;
constexpr size_t WS_WAB_IN = 10 * MiB, WS_WAB_OUT = 15 * MiB, WS_WCD_IN = 17 * MiB, WS_WCD_OUT = 22 * MiB, WS_WUQ = 24 * MiB, WS_WUKV = 25 * MiB;
constexpr size_t WS_WGU = 26 * MiB;
constexpr size_t WS_WDN = 154 * MiB;
constexpr size_t WS_XA = 218 * MiB, WS_XB = 348 * MiB;
constexpr size_t WS_H = 478 * MiB;
constexpr size_t WS_AO = 543 * MiB;
constexpr size_t WS_S = 608 * MiB;
constexpr size_t WS_QKV = WS_S;
constexpr size_t WS_QM = WS_S + 147 * MiB;
constexpr size_t WS_KVM = WS_S + 196 * MiB;
constexpr size_t WS_YP = WS_S;
constexpr size_t WS_ACT = WS_S + 65 * MiB;
constexpr size_t WS_YS = WS_S + 138 * MiB;
constexpr size_t WS_END = WS_S + 284 * MiB;
constexpr size_t WS_VT8M = 892 * MiB, WS_VT8D = 910 * MiB;
constexpr size_t WS_K8M = 928 * MiB, WS_K8D = 946 * MiB, WS_K8R = 964 * MiB;
constexpr size_t WS_Q8M = WS_QM, WS_Q8D = WS_QM + 26 * MiB;
constexpr size_t WS_Q8A = WS_QM, WS_Q8B = WS_QM + 17 * MiB, WS_K8A = WS_K8D, WS_K8B = WS_K8M, WS_VT8A = WS_VT8D, WS_VT8B = WS_VT8M;
static_assert(WS_YS + (size_t)RMAX * 1024 * 2 <= WS_END && WS_KVM + (size_t)MU * 1024 * 2 <= WS_END && WS_QM + (size_t)MU * 768 * 2 <= WS_KVM && WS_QKV + (size_t)MU * NQKV * 2 <= WS_QM, "ws map");
static_assert(WS_ACT + (size_t)RMAX * 512 * 2 <= WS_YS && WS_YP + (size_t)MU * 1024 * 2 <= WS_ACT, "ws map 2");

constexpr int CW_TMO = 0, CW_CODE = 1;
constexpr int CW_BAR = 4096;
constexpr int CW_CNT = 8192;

constexpr int RING_BYTES = 131072;
constexpr int LDS_AUX = RING_BYTES;
constexpr int LDS_MISC = 159744 - 64;
constexpr int LDS_BYTES = 159744;

DI unsigned cvtpk(float lo, float hi) { f32x2 v = {lo, hi}; bf16x2_t b = __builtin_convertvector(v, bf16x2_t); return __builtin_bit_cast(unsigned, b); }
DI float bf_lo(unsigned u) { return __uint_as_float(u << 16); }
DI float bf_hi(unsigned u) { return __uint_as_float(u & 0xffff0000u); }
DI float wave_sum(float v) {
#pragma unroll
    for (int o = 1; o < 64; o <<= 1) v += __shfl_xor(v, o);
    return v;
}
DI float fast_exp2(float x) { return __builtin_amdgcn_exp2f(x); }
DI float fast_rcp(float x) { return __builtin_amdgcn_rcpf(x); }

#define XB_TMO      128
#define XB_XCNT(j)  (256  + 64 * (j))
#define XB_XSUB(j)  (1280 + 64 * (j))
#define XB_XGEN(j)  (2304 + 64 * (j))
#define XB_TOP      3328
#define XB_TOPGEN   3392
#define XCD_BAR_WORDS 3456
#define XB_SPIN_CAP (1u << 22)

DI unsigned xb_ld(unsigned* p)              { return __hip_atomic_load(p, __ATOMIC_RELAXED, __HIP_MEMORY_SCOPE_AGENT); }
DI unsigned xb_add(unsigned* p, unsigned v) { return __hip_atomic_fetch_add(p, v, __ATOMIC_RELAXED, __HIP_MEMORY_SCOPE_AGENT); }
DI unsigned xb_xcc_id() { return (unsigned)__builtin_amdgcn_s_getreg((3 << 11) | 20) & 0xFu; }
#define XB_SPIN(cond, bar) do { unsigned _sp = 0; while (cond) { __builtin_amdgcn_s_sleep(1); \
    if ((++_sp & 255u) == 0u) { if (xb_ld(&(bar)[XB_TMO])) break; if (_sp > XB_SPIN_CAP) { atomicAdd(&(bar)[XB_TMO], 1u); break; } } } } while (0)

struct XcdBarrier { unsigned* bar; unsigned x; volatile LAS unsigned* st; };

DI XcdBarrier xcd_barrier_post(unsigned* bar, volatile LAS unsigned* st) {
    XcdBarrier b; b.bar = bar; b.x = xb_xcc_id(); b.st = st;
    if (threadIdx.x == 0) (void)xb_add(&bar[XB_XCNT(b.x)], 1u);
    return b;
}
DI void xcd_barrier_complete(unsigned* bar, unsigned x, unsigned& nloc, unsigned& nx) {
    const unsigned G = gridDim.x * gridDim.y * gridDim.z;
    unsigned sum, cnt, mine, sp = 0u;
    for (;;) {
        sum = 0u; cnt = 0u; mine = 0u;
#pragma unroll
        for (unsigned j = 0; j < 16; ++j) { const unsigned c = xb_ld(&bar[XB_XCNT(j)]); sum += c; cnt += (c > 0u) ? 1u : 0u; mine = (j == x) ? c : mine; }
        if (sum == G) break;
        __builtin_amdgcn_s_sleep(1);
        if ((++sp & 255u) == 0u) { if (xb_ld(&bar[XB_TMO])) break; if (sp > XB_SPIN_CAP) { atomicAdd(&bar[XB_TMO], 1u); break; } }
    }
    nloc = mine > 0u ? mine : 1u; nx = cnt > 0u ? cnt : 1u;
}
DI void xcd_barrier(const XcdBarrier& b) {
    asm volatile("s_waitcnt vmcnt(0)" ::: "memory");
    __syncthreads();
    if (threadIdx.x == 0) {
        unsigned* bar = b.bar;
        __builtin_amdgcn_s_waitcnt(0);
        unsigned nloc = b.st[0], nx = b.st[1];
        if (nloc == 0u) { xcd_barrier_complete(bar, b.x, nloc, nx); b.st[0] = nloc; b.st[1] = nx; }
        const unsigned old = xb_add(&bar[XB_XSUB(b.x)], 1u);
        const unsigned gen = old / nloc;
        if (old + 1u == (gen + 1u) * nloc) {
            __builtin_amdgcn_fence(__ATOMIC_RELEASE, "agent");
            asm volatile("s_waitcnt vmcnt(0)" ::: "memory");
            const unsigned og = xb_add(&bar[XB_TOP], 1u);
            const unsigned tg = og / nx;
            if (og + 1u == (tg + 1u) * nx) xb_add(&bar[XB_TOPGEN], 1u);
            else XB_SPIN(xb_ld(&bar[XB_TOPGEN]) == tg, bar);
            __builtin_amdgcn_fence(__ATOMIC_ACQUIRE, "agent");
            xb_add(&bar[XB_XGEN(b.x)], 1u);
            asm volatile("s_waitcnt vmcnt(0)" ::: "memory");
        } else {
            XB_SPIN(xb_ld(&bar[XB_XGEN(b.x)]) == gen, bar);
            __builtin_amdgcn_fence(__ATOMIC_ACQUIRE, "agent");
            asm volatile("s_waitcnt vmcnt(0)" ::: "memory");
        }
    }
    __syncthreads();
}

namespace pg8 {
constexpr int BM = 256, BK = 64, HALF = 128, HTB = HALF * BK * 2, STAGE_BYTES = 8 * HTB, NXCD = 8, WGM = 8;
__host__ __device__ __forceinline__ int lds_byte(int r, int c) { const int st = (r >> 4) * 2 + (c >> 5), rr = r & 15, cc = c & 31, ob = rr * 64 + cc * 2; return st * 1024 + (ob ^ (((ob >> 9) & 1) << 5)); }
__host__ __device__ __forceinline__ void stage_rc(int b, int& R, int& C) { const int st = b / 1024, sb = b % 1024, swz = sb ^ (((sb >> 9) & 1) << 5); R = (st >> 1) * 16 + swz / 64; C = (st & 1) * 32 + (swz % 64) / 2; }
__host__ __device__ __forceinline__ int perm32(int rho) { const int n = rho >> 4, i = rho & 15; return 8 * (i >> 2) + 4 * n + (i & 3); }

typedef int v8i_g __attribute__((ext_vector_type(8)));
struct Unit { int pm, pn; const char* A; const char* B; int aux0, aux1; };

struct DenseOrder {
    int nM, nN, nwg, G, c; bool latent_only; const char* A; const char* Bt; size_t tstepA, tstepB;
    DI void init(int nM_, int nN_, int G_, int c_, bool lat, const void* A_, int lda, const void* Bt_, int K) {
        nM = nM_; nN = nN_; nwg = nM * nN; G = G_; c = c_; latent_only = lat; A = (const char*)A_; Bt = (const char*)Bt_; tstepA = (size_t)BM * lda * 2; tstepB = (size_t)BM * K * 2; }
    DI bool next(int i, Unit& u) const {
        const long L = (long)i * G + c; if (L >= nwg) return false;
        int wgid = (int)L; { const int q = nwg / NXCD, r = nwg % NXCD, xcd = wgid % NXCD, off = wgid / NXCD; wgid = (xcd < r ? xcd * (q + 1) : r * (q + 1) + (xcd - r) * q) + off; }
        const int nig = WGM * nN, gid = wgid / nig, fm = gid * WGM, gsz = (nM - fm) < WGM ? (nM - fm) : WGM;
        int pm = fm + ((wgid % nig) % gsz); const int pn = (wgid % nig) / gsz;
        if (latent_only) pm = pm + 1 + (pm >= 64 ? 1 : 0);
        u.pm = pm; u.pn = pn; u.A = A + (size_t)pm * tstepA; u.B = Bt + (size_t)pn * tstepB; u.aux0 = 0; u.aux1 = 0; return true;
    }
    DI unsigned gather(const Unit&, int) const { return 0u; }
};

template <class Epi, class Sched, bool GATHER, bool F8 = false>
DI void gemm_phase(LAS unsigned char* lds, const int lda, const int K, const Sched& S, const Epi& E, const int sc_x8 = 0x7f7f7f7f) {
    const int tid = threadIdx.x, wid = __builtin_amdgcn_readfirstlane(tid >> 6), lane = tid & 63, wr = wid >> 2, wc = wid & 3, fr = lane & 15, fq = lane >> 4;
    const int nt = K / BK;
    int RR[2], CC[2]; unsigned voffB[2];
#pragma unroll
    for (int i = 0; i < 2; ++i) { stage_rc(tid * 16 + i * 8192, RR[i], CC[i]); const int Rb = Epi::PERM ? ((RR[i] & ~31) + perm32(RR[i] & 31)) : RR[i]; voffB[i] = (unsigned)(Rb * K + CC[i]) * 2u; }
    unsigned cv0[2], cv1[2], nv0[2], nv1[2];
    const size_t kstep = (size_t)(BK * 2);
    const size_t hstepB = (size_t)HALF * K * 2;
    const unsigned ldsw = (unsigned)wid * 1024u;
    const int aoff = lds_byte(wr * 64 + fr, fq * 8), boff = lds_byte(wc * 32 + fr, fq * 8);
#define PG8_SA(b, h) (((b) * 2 + (h)) * HTB)
#define PG8_SB(b, h) ((4 + (b) * 2 + (h)) * HTB)
#define PG8_STAGE(bufoff, gbase, voff) do { _Pragma("unroll") for (int _i = 0; _i < 2; ++_i) \
        __builtin_amdgcn_global_load_lds((const unsigned*)((const char*)(gbase) + (voff)[_i]), (LAS unsigned*)(lds + (bufoff) + ldsw + _i * 8192), 16, 0, 0); } while (0)
#define PG8_LDA(dst, b, h) do { _Pragma("unroll") for (int m = 0; m < 4; ++m) _Pragma("unroll") for (int k = 0; k < 2; ++k) dst[m][k] = *(const LAS bf16x8*)(lds + PG8_SA(b, h) + aoff + m * 2048 + k * 1024); } while (0)
#define PG8_LDB(dst, b, h) do { _Pragma("unroll") for (int n = 0; n < 2; ++n) _Pragma("unroll") for (int k = 0; k < 2; ++k) dst[n][k] = *(const LAS bf16x8*)(lds + PG8_SB(b, h) + boff + n * 2048 + k * 1024); } while (0)
#define PG8_MMA(ai, bj, At, Bt) do { __builtin_amdgcn_s_setprio(1); _Pragma("unroll") for (int m = 0; m < 4; ++m) _Pragma("unroll") for (int n = 0; n < 2; ++n) { \
        if (F8) { const u32x4 b0_ = __builtin_bit_cast(u32x4, Bt[n][0]), b1_ = __builtin_bit_cast(u32x4, Bt[n][1]), a0_ = __builtin_bit_cast(u32x4, At[m][0]), a1_ = __builtin_bit_cast(u32x4, At[m][1]); \
            const v8i_g wf_ = (v8i_g){(int)b0_[0], (int)b0_[1], (int)b0_[2], (int)b0_[3], (int)b1_[0], (int)b1_[1], (int)b1_[2], (int)b1_[3]}; \
            const v8i_g xf_ = (v8i_g){(int)a0_[0], (int)a0_[1], (int)a0_[2], (int)a0_[3], (int)a1_[0], (int)a1_[1], (int)a1_[2], (int)a1_[3]}; \
            asm volatile("v_mfma_scale_f32_16x16x128_f8f6f4 %0, %1, %2, %0, %3, %4 op_sel_hi:[0,0,0]" : "+v"(acc[ai][bj][m][n]) : "v"(wf_), "v"(xf_), "v"(sc_w8), "v"(sc_x8)); } \
        else { _Pragma("unroll") for (int k = 0; k < 2; ++k) acc[ai][bj][m][n] = __builtin_amdgcn_mfma_f32_16x16x32_bf16(Bt[n][k], At[m][k], acc[ai][bj][m][n], 0, 0, 0); } } \
        __builtin_amdgcn_s_setprio(0); } while (0)
#define PG8_WAIT_V(n) asm volatile("s_waitcnt vmcnt(" #n ")" ::: "memory")
#define PG8_WAIT_L(n) asm volatile("s_waitcnt lgkmcnt(" #n ")" ::: "memory")
#define PG8_BAR __builtin_amdgcn_s_barrier()
#define PG8_SCHED __builtin_amdgcn_sched_barrier(0)
#define PG8_SETV(v0, v1, u) do { _Pragma("unroll") for (int _i = 0; _i < 2; ++_i) { \
        if (GATHER) { v0[_i] = S.gather(u, RR[_i]) + (unsigned)CC[_i] * 2u; v1[_i] = S.gather(u, HALF + RR[_i]) + (unsigned)CC[_i] * 2u; } \
        else { v0[_i] = (unsigned)(RR[_i] * lda + CC[_i]) * 2u; v1[_i] = (unsigned)((HALF + RR[_i]) * lda + CC[_i]) * 2u; } } } while (0)
    const int sc_w8 = 0x79797979;
    Unit cur, nxt; int ui = 0;
    if (!S.next(0, cur)) return;
    PG8_SETV(cv0, cv1, cur);
    f32x4 acc[2][2][4][2];
#pragma unroll
    for (int a = 0; a < 2; ++a)
#pragma unroll
        for (int b = 0; b < 2; ++b)
#pragma unroll
            for (int m = 0; m < 4; ++m)
#pragma unroll
                for (int n = 0; n < 2; ++n) acc[a][b][m][n] = (f32x4){0.f, 0.f, 0.f, 0.f};
    bf16x8 At[4][2], B0[2][2], B1[2][2];
    const char* cA = cur.A; const char* cB = cur.B;
    PG8_STAGE(PG8_SB(0, 0), cB, voffB); PG8_STAGE(PG8_SB(0, 1), cB + hstepB, voffB); PG8_STAGE(PG8_SA(0, 0), cA, cv0); PG8_STAGE(PG8_SA(0, 1), cA, cv1);
    if (wr == 1) PG8_BAR;
    PG8_WAIT_V(2); PG8_BAR;
    PG8_STAGE(PG8_SB(1, 0), cB + kstep, voffB); PG8_STAGE(PG8_SA(1, 0), cA + kstep, cv0); PG8_STAGE(PG8_SB(1, 1), cB + hstepB + kstep, voffB);
    PG8_WAIT_V(6); PG8_BAR;
    for (;;) {
        const bool has_next = S.next(ui + 1, nxt);
        const char* nA = has_next ? nxt.A : cA; const char* nB = has_next ? nxt.B : cB;
        if (GATHER) { if (has_next) { PG8_SETV(nv0, nv1, nxt); } else {
#pragma unroll
            for (int i = 0; i < 2; ++i) { nv0[i] = cv0[i]; nv1[i] = cv1[i]; } } }
#pragma nounroll
        for (int t = 0; t < nt; t += 2) {
            const bool last = (t == nt - 2);
            const char* a1 = cA + (size_t)(t + 1) * kstep;
            const char* a2 = last ? nA : cA + (size_t)(t + 2) * kstep; const char* b2 = last ? nB : cB + (size_t)(t + 2) * kstep;
            const char* a3 = a2 + kstep; const char* b3 = b2 + kstep;
            unsigned s0[2], s1[2];
#pragma unroll
            for (int i = 0; i < 2; ++i) { s0[i] = (GATHER && last) ? nv0[i] : cv0[i]; s1[i] = (GATHER && last) ? nv1[i] : cv1[i]; }
            PG8_LDB(B0, 0, 0); PG8_LDB(B1, 0, 1); PG8_SCHED; PG8_LDA(At, 0, 0); PG8_STAGE(PG8_SA(1, 1), a1, cv1);
            PG8_WAIT_V(8); PG8_WAIT_L(0); PG8_BAR; PG8_MMA(0, 0, At, B0); PG8_MMA(0, 1, At, B1); PG8_BAR; PG8_SCHED;
            PG8_LDA(At, 0, 1); PG8_STAGE(PG8_SB(0, 0), b2, voffB); PG8_STAGE(PG8_SB(0, 1), b2 + hstepB, voffB); PG8_STAGE(PG8_SA(0, 0), a2, s0);
            PG8_WAIT_V(8); PG8_WAIT_L(0); PG8_BAR; PG8_MMA(1, 0, At, B0); PG8_MMA(1, 1, At, B1); PG8_BAR; PG8_SCHED;
            PG8_LDB(B0, 1, 0); PG8_LDB(B1, 1, 1); PG8_SCHED; PG8_LDA(At, 1, 0); PG8_STAGE(PG8_SA(0, 1), a2, s1);
            PG8_WAIT_V(8); PG8_WAIT_L(0); PG8_BAR; PG8_MMA(0, 0, At, B0); PG8_MMA(0, 1, At, B1); PG8_BAR; PG8_SCHED;
            PG8_LDA(At, 1, 1); PG8_STAGE(PG8_SB(1, 0), b3, voffB); PG8_STAGE(PG8_SB(1, 1), b3 + hstepB, voffB); PG8_STAGE(PG8_SA(1, 0), a3, s0);
            PG8_WAIT_V(8); PG8_WAIT_L(0); PG8_BAR; PG8_MMA(1, 0, At, B0); PG8_MMA(1, 1, At, B1); PG8_BAR; PG8_SCHED;
        }
        if (wr == 0) PG8_BAR;
        if (F8) asm volatile("s_nop 15\n\ts_nop 7" ::: "memory");
        E(acc, cur, ui, wr, wc, fr, fq);
        if (!has_next) break;
#pragma unroll
        for (int a = 0; a < 2; ++a)
#pragma unroll
            for (int b = 0; b < 2; ++b)
#pragma unroll
                for (int m = 0; m < 4; ++m)
#pragma unroll
                    for (int n = 0; n < 2; ++n) acc[a][b][m][n] = (f32x4){0.f, 0.f, 0.f, 0.f};
        cur = nxt; cA = nA; cB = nB; ++ui;
        if (GATHER) {
#pragma unroll
            for (int i = 0; i < 2; ++i) { cv0[i] = nv0[i]; cv1[i] = nv1[i]; } }
        if (wr == 1) PG8_BAR;
    }
    PG8_WAIT_V(0);
    PG8_BAR;
#undef PG8_SA
#undef PG8_SB
#undef PG8_STAGE
#undef PG8_LDA
#undef PG8_LDB
#undef PG8_MMA
#undef PG8_WAIT_V
#undef PG8_WAIT_L
#undef PG8_BAR
#undef PG8_SCHED
#undef PG8_SETV
}

DI void st4(bf16_t* p, f32x4 v) { u32x2 w; w.x = cvtpk(v[0], v[1]); w.y = cvtpk(v[2], v[3]); *(u32x2*)p = w; }
DI void st8(bf16_t* p, f32x4 a, f32x4 b) { u32x4 w; w.x = cvtpk(a[0], a[1]); w.y = cvtpk(a[2], a[3]); w.z = cvtpk(b[0], b[1]); w.w = cvtpk(b[2], b[3]); *(u32x4*)p = w; }

DI unsigned pk_fp8x4(f32x4 v) { int w = __builtin_amdgcn_cvt_pk_fp8_f32(v[0], v[1], 0, false); w = __builtin_amdgcn_cvt_pk_fp8_f32(v[2], v[3], w, true); return (unsigned)w; }
DI unsigned vt8_keyoff(int kap) { const int a = kap >> 5, c = kap & 31, h = (c >> 2) & 1, i = (c & 3) | ((c >> 3) << 2); return (unsigned)((h * 2 + a) * 512 + i); }
DI void st_fp8x4_strided(unsigned char* p, f32x4 v) {
    int w = __builtin_amdgcn_cvt_pk_fp8_f32(v[0], v[1], 0, false); w = __builtin_amdgcn_cvt_pk_fp8_f32(v[2], v[3], w, true);
    p[0] = (unsigned char)(w & 0xff); p[16] = (unsigned char)((w >> 8) & 0xff); p[32] = (unsigned char)((w >> 16) & 0xff); p[48] = (unsigned char)((unsigned)w >> 24);
}
struct EpiPlain {
    static constexpr bool PERM = true;
    bf16_t* O; int ldc;
    DI void operator()(const f32x4 (&acc)[2][2][4][2], const Unit& u, int ui, int wr, int wc, int fr, int fq) const {
        const int row0 = u.pm * BM + wr * 64 + fr, col0 = u.pn * BM + wc * 32 + 8 * fq;
#pragma unroll
        for (int ai = 0; ai < 2; ++ai)
#pragma unroll
            for (int m = 0; m < 4; ++m) { bf16_t* rowp = O + (size_t)(row0 + ai * HALF + m * 16) * ldc + col0;
#pragma unroll
                for (int bj = 0; bj < 2; ++bj) st8(rowp + bj * HALF, acc[ai][bj][m][0], acc[ai][bj][m][1]); }
    }
};
struct EpiGU {
    static constexpr bool PERM = true;
    unsigned char* O;
    DI static f32x4 silu_mul(f32x4 g, f32x4 u) { f32x4 r;
#pragma unroll
        for (int e = 0; e < 4; ++e) r[e] = g[e] * fast_rcp(1.f + fast_exp2(-g[e] * LOG2E)) * u[e];
        return r; }
    DI void operator()(const f32x4 (&acc)[2][2][4][2], const Unit& u, int ui, int wr, int wc, int fr, int fq) const {
        const int row0 = u.pm * BM + wr * 64 + fr, col0 = u.pn * HALF + wc * 32 + 8 * fq;
#pragma unroll
        for (int ai = 0; ai < 2; ++ai)
#pragma unroll
            for (int m = 0; m < 4; ++m) { unsigned char* rowp = O + (size_t)(row0 + ai * HALF + m * 16) * DEXP + col0;
                u32x2 w; w.x = pk_fp8x4(silu_mul(acc[ai][0][m][0], acc[ai][1][m][0])); w.y = pk_fp8x4(silu_mul(acc[ai][0][m][1], acc[ai][1][m][1])); *(u32x2*)rowp = w; }
    }
};
template <int LAYER> struct EpiInProj {
    static constexpr bool PERM = false;
    unsigned char* ws;
    DI void operator()(const f32x4 (&acc)[2][2][4][2], const Unit& u, int ui, int wr, int wc, int fr_in, int fq) const {
        int fr = fr_in; asm volatile("" : "+v"(fr));
        bf16_t* const O = (bf16_t*)(ws + WS_QKV); const float* const r64c = (const float*)(ws + WS_ROPE); const float* const r64s = r64c + 4096; const float* const r32c = r64s + 4096; const float* const r32s = r32c + 2048;
        unsigned char* const vt8 = ws + WS_VT8D; unsigned char* const q8d = ws + WS_Q8D; unsigned char* const k8d = ws + WS_K8D; unsigned char* const k8r = ws + WS_K8R;
        const int bidx = u.pm / 65; const bool ctx = (u.pm - bidx * 65) == 0;
        const float C2 = 0.125f * LOG2E;
#pragma unroll
        for (int bj = 0; bj < 2; ++bj) {
            const int g = 2 * u.pn + bj;
            bool rope64, scale, rope32 = false, skip = false;
            if (LAYER == 0) { rope64 = !ctx && g <= 4; scale = (g <= 3) || (g >= 6 && g <= 9); }
            else { rope64 = !ctx && g <= 7; scale = g <= 3; rope32 = !ctx && g == 17 && wc == 0; skip = (g == 17 && wc != 0); }
            if (skip) continue;
            const int col0 = g * HALF + wc * 32 + 4 * fq;
#pragma unroll
            for (int ai = 0; ai < 2; ++ai)
#pragma unroll
                for (int m = 0; m < 4; ++m) {
                    const int row = u.pm * BM + ai * HALF + wr * 64 + m * 16 + fr;
                    const int s = row - (bidx * RB + CTXL);
                    f32x4 v0 = acc[ai][bj][m][0], v1 = acc[ai][bj][m][1];
                    if (rope64) { const int pos = (wc & 1) ? (s & 63) : (s >> 6);
                        const f32x4 c4 = *(const f32x4*)(r64c + pos * 16 + 4 * fq), s4 = *(const f32x4*)(r64s + pos * 16 + 4 * fq);
                        const f32x4 y0 = v0 * c4 - v1 * s4, y1 = v1 * c4 + v0 * s4; v0 = y0; v1 = y1; }
                    if (rope32) { const int pos = (fq >= 2) ? (s & 63) : (s >> 6);
                        const f32x4 c4 = *(const f32x4*)(r32c + pos * 8 + 4 * (fq & 1)), s4 = *(const f32x4*)(r32s + pos * 8 + 4 * (fq & 1));
                        const f32x4 y0 = v0 * c4 - v1 * s4, y1 = v1 * c4 + v0 * s4; v0 = y0; v1 = y1; }
                    if (scale) { v0 = v0 * C2; v1 = v1 * C2; }
                    if (LAYER == 0) {
                        const int hsel = wc >> 1, dim0 = (wc & 1) * 32 + 4 * fq;
                        const int rr = row - bidx * RB, kt = rr >> 6, kap = rr & 63;
                        if (g <= 3 || (g >= 6 && g <= 9)) {
                            const int head = (g <= 3) ? (2 * g + hsel) : (2 * (g - 6) + hsel);
                            unsigned char* p8 = ws + (g <= 3 ? WS_Q8A : WS_Q8B) + (size_t)row * 512 + head * 64 + dim0;
                            *(unsigned*)p8 = pk_fp8x4(v0 * 8.f); *(unsigned*)(p8 + 16) = pk_fp8x4(v1 * 8.f);
                        } else if (g == 4 || (g >= 10 && g <= 13)) {
                            const size_t img = (g == 4) ? ((size_t)(bidx * 2 + hsel) * 260 + kt) : ((size_t)(bidx * 8 + 2 * (g - 10) + hsel) * 260 + kt);
                            unsigned char* p8 = ws + (g == 4 ? WS_K8A : WS_K8B) + img * 4096 + ((wc & 1) * 2) * 1024 + kap * 16 + 4 * fq;
                            *(unsigned*)p8 = pk_fp8x4(v0); *(unsigned*)(p8 + 1024) = pk_fp8x4(v1);
                        } else {
                            const size_t img = (g == 5) ? ((size_t)(bidx * 2 + hsel) * 260 + kt) : ((size_t)(bidx * 8 + 2 * (g - 14) + hsel) * 260 + kt);
                            unsigned char* p8 = ws + (g == 5 ? WS_VT8A : WS_VT8B) + img * 4096 + (wc & 1) * 2048 + vt8_keyoff(kap) + (4 * fq) * 16;
                            st_fp8x4_strided(p8, v0); st_fp8x4_strided(p8 + 256, v1);
                        }
                        if (m & 1) asm volatile("" ::: "memory"); continue;
                    }
                    if (LAYER == 1 && g <= 3) {
                        unsigned char* p8 = q8d + (size_t)row * 512 + g * HALF + wc * 32 + 4 * fq;
                        *(unsigned*)p8 = pk_fp8x4(v0 * 8.f); *(unsigned*)(p8 + 16) = pk_fp8x4(v1 * 8.f);
                        if (m & 1) asm volatile("" ::: "memory"); continue;
                    }
                    if (LAYER == 1 && g >= 4 && g <= 7) {
                        const int rr = row - bidx * RB, kt = rr >> 6, kap = rr & 63;
                        unsigned char* p8 = k8d + ((size_t)(bidx * 4 + (g - 4)) * 260 + kt) * 8192 + (wc >> 1) * 4096 + ((wc & 1) * 2) * 1024 + kap * 16 + 4 * fq;
                        *(unsigned*)p8 = pk_fp8x4(v0); *(unsigned*)(p8 + 1024) = pk_fp8x4(v1);
                        if (m & 1) asm volatile("" ::: "memory"); continue;
                    }
                    if (LAYER == 1 && g == 17) {
                        const int rr = row - bidx * RB, kt = rr >> 6, kap = rr & 63;
                        unsigned char* p8 = k8r + ((size_t)bidx * 260 + kt) * 2048 + kap * 16 + 4 * fq;
                        *(unsigned*)p8 = pk_fp8x4(v0); *(unsigned*)(p8 + 1024) = pk_fp8x4(v1);
                        if (m & 1) asm volatile("" ::: "memory"); continue;
                    }
                    if (LAYER == 1 && g >= 8 && g <= 11) {
                        const int rr = row - bidx * RB, kt = rr >> 6;
                        unsigned char* p8 = vt8 + ((size_t)(bidx * 4 + (g - 8)) * 260 + kt) * 8192 + wc * 2048 + vt8_keyoff(rr & 63) + (4 * fq) * 16;
                        st_fp8x4_strided(p8, v0); st_fp8x4_strided(p8 + 256, v1);
                        if (m & 1) asm volatile("" ::: "memory"); continue;
                    }
                    bf16_t* p = O + (size_t)row * NQKV + col0;
                    st4(p, v0); st4(p + 16, v1);
                    if (m & 1) asm volatile("" ::: "memory");
                }
        }
    }
};

struct EpiUKV {
    static constexpr bool PERM = true;
    unsigned char* k8; const LAS float* rs; unsigned char* vt8;
    DI void operator()(const f32x4 (&acc)[2][2][4][2], const Unit& u, int ui, int wr, int wc, int fr_in, int fq) const {
        int fr = fr_in;
        asm volatile("" : "+v"(fr));
        const int lr0 = wr * 64 + fr, bidx = u.pm / 65;
#pragma unroll
        for (int ai = 0; ai < 2; ++ai)
#pragma unroll
            for (int m = 0; m < 4; ++m) { const int lr = lr0 + ai * HALF + m * 16; const float s = rs[ui * 256 + lr]; const int row = u.pm * BM + lr;
                if (u.pn < 2) { const int rr = row - bidx * RB, kt = rr >> 6, kap = rr & 63;
#pragma unroll
                    for (int bj = 0; bj < 2; ++bj) { const int col = u.pn * BM + bj * HALF + wc * 32 + 8 * fq, head = col >> 6, dim = col & 63;
                        unsigned char* p = k8 + ((size_t)(bidx * 8 + head) * 260 + kt) * 4096 + (dim >> 4) * 1024 + kap * 16 + (dim & 15);
                        u32x2 w; w.x = pk_fp8x4(acc[ai][bj][m][0] * s); w.y = pk_fp8x4(acc[ai][bj][m][1] * s); *(u32x2*)p = w; }
                } else { const int rr = row - bidx * RB, kt = rr >> 6;
#pragma unroll
                    for (int bj = 0; bj < 2; ++bj) { const int col = (u.pn - 2) * BM + bj * HALF + wc * 32 + 8 * fq, head = col >> 6, d = col & 63;
                        unsigned char* p = vt8 + ((size_t)(bidx * 8 + head) * 260 + kt) * 4096 + (d >> 5) * 2048 + vt8_keyoff(rr & 63) + (d & 31) * 16;
                        st_fp8x4_strided(p, acc[ai][bj][m][0] * s); st_fp8x4_strided(p + 64, acc[ai][bj][m][1] * s); } }
            }
    }
};
struct EpiUQ {
    static constexpr bool PERM = false;
    unsigned char* q8; const LAS float* rs; const float* r32c; const float* r32s;
    DI void operator()(const f32x4 (&acc)[2][2][4][2], const Unit& u, int ui, int wr, int wc, int fr, int fq) const {
        const int bidx = u.pm / 65;
        const float C2 = 0.10206207261596577f * LOG2E * 8.f;
#pragma unroll
        for (int bj = 0; bj < 2; ++bj) {
            int off;
            if (u.pn < 2) { const int col = u.pn * BM + bj * HALF + wc * 32 + 4 * fq; off = (col >> 6) * 96 + (col & 63); }
            else off = (bj * 4 + wc) * 96 + 64 + 4 * fq;
#pragma unroll
            for (int ai = 0; ai < 2; ++ai)
#pragma unroll
                for (int m = 0; m < 4; ++m) {
                    const int lr = ai * HALF + wr * 64 + m * 16 + fr, row = u.pm * BM + lr;
                    const int s = row - (bidx * RB + CTXL);
                    const float sc = rs[ui * 256 + lr] * C2;
                    f32x4 v0 = acc[ai][bj][m][0] * sc, v1 = acc[ai][bj][m][1] * sc;
                    if (u.pn == 2) { const int pos = (fq >= 2) ? (s & 63) : (s >> 6);
                        const f32x4 c4 = *(const f32x4*)(r32c + pos * 8 + 4 * (fq & 1)), s4 = *(const f32x4*)(r32s + pos * 8 + 4 * (fq & 1));
                        const f32x4 y0 = v0 * c4 - v1 * s4, y1 = v1 * c4 + v0 * s4; v0 = y0; v1 = y1; }
                    unsigned char* p = q8 + (size_t)row * 768 + off;
                    *(unsigned*)p = pk_fp8x4(v0); *(unsigned*)(p + 16) = pk_fp8x4(v1);
                }
        }
    }
};
}

namespace att {
constexpr float THR = 8.f;
struct P {
    const unsigned char* q8; int qpitch;
    const unsigned char* k8; const unsigned char* k8r;
    const unsigned char* v8;
    unsigned char* o; int opitch;
    int nt, t_lo, kind, s0;
    float sink2, lam; const float* subln;
};
DI int crow(int r, int hi) { return (r & 3) + 8 * (r >> 2) + 4 * hi; }
DI float xsum32(float v) { auto rr = __builtin_amdgcn_permlane32_swap(__float_as_uint(v), __float_as_uint(v), false, false); return __uint_as_float(rr[0]) + __uint_as_float(rr[1]); }
DI int ximax32(int v) { auto rr = __builtin_amdgcn_permlane32_swap((unsigned)v, (unsigned)v, false, false); const int a = (int)rr[0], b = (int)rr[1]; return a > b ? a : b; }
DI float xmax32(float v) { auto rr = __builtin_amdgcn_permlane32_swap(__float_as_uint(v), __float_as_uint(v), false, false); float r; asm("v_max_f32 %0, %1, %2" : "=v"(r) : "v"(rr[0]), "v"(rr[1])); return r; }
#define ATT_WAITBAR() asm volatile("s_waitcnt vmcnt(0) lgkmcnt(0)\n\ts_barrier" ::: "memory")

DI void glds16s(unsigned voff, const void* sbase, unsigned lds_dst) { unsigned keep;
    asm volatile("s_mov_b32 %0, m0\n\ts_mov_b32 m0, %3\n\ts_nop 0\n\tglobal_load_lds_dwordx4 %1, %2\n\ts_mov_b32 m0, %0" : "=&s"(keep) : "v"(voff), "s"(sbase), "s"(lds_dst) : "memory"); }
#define ATT_WAITN_BAR(N) asm volatile("s_waitcnt vmcnt(" #N ") lgkmcnt(0)\n\ts_barrier" ::: "memory")
typedef int v8i_t __attribute__((ext_vector_type(8)));
DI f32x16 mfma_f8(v8i_t a, v8i_t b, f32x16 c) { return __builtin_amdgcn_mfma_scale_f32_32x32x64_f8f6f4(a, b, c, 0, 0, 0, 0x7f7f7f7f, 0, 0x7f7f7f7f); }
DI f32x16 mfma_f8s(v8i_t a, v8i_t b, f32x16 c, int sb) { return __builtin_amdgcn_mfma_scale_f32_32x32x64_f8f6f4(a, b, c, 0, 0, 0, 0x7f7f7f7f, 0, sb); }
typedef float f32x4v __attribute__((ext_vector_type(4)));
DI f32x4v mfma_f8s16(v8i_t a, v8i_t b, f32x4v c, int sb) { return __builtin_amdgcn_mfma_scale_f32_16x16x128_f8f6f4(a, b, c, 0, 0, 0, 0x7f7f7f7f, 0, sb); }
constexpr float F8_OFF = 4.f;
DI f32x16 mfma_f8q(v8i_t a, v8i_t b, f32x16 c) { return __builtin_amdgcn_mfma_scale_f32_32x32x64_f8f6f4(a, b, c, 0, 0, 0, 0x7f7f7f7f, 0, 0x7c7c7c7c); }
template <int MODE> DI void attn_unit_f8q(const P& p, LAS unsigned char* lds) {
    constexpr int DV = MODE == 2 ? 128 : 64;
    constexpr int NKC = MODE == 1 ? 6 : 8;
    constexpr int KSLOT = NKC * 1024, VSLOT = DV * 64, VRING = 4 * KSLOT, NDB = DV / 32;
    constexpr int NQK = MODE == 1 ? 4 : 2;
    const int tid = threadIdx.x, lane = tid & 63, r32 = lane & 31, hi = lane >> 5; const int wid = __builtin_amdgcn_readfirstlane(tid >> 6);
    const int sub = (MODE == 2) ? (wid >> 2) : 0;
    const int qrow = (MODE == 2) ? (32 * (wid & 3) + r32) : (32 * wid + r32);
    const int nt = p.nt;
    const unsigned ldsb = (unsigned)(size_t)lds;
    v8i_t qf[MODE == 1 ? 2 : 1];
    { const unsigned char* qp = p.q8 + (size_t)qrow * p.qpitch + (MODE == 2 ? sub * 64 : 0);
      const u32x4 a0 = *(const u32x4*)(qp + 32 * hi), a1 = *(const u32x4*)(qp + 32 * hi + 16);
      qf[0] = (v8i_t){(int)a0[0], (int)a0[1], (int)a0[2], (int)a0[3], (int)a1[0], (int)a1[1], (int)a1[2], (int)a1[3]};
      if (MODE == 1) { u32x4 b0 = *(const u32x4*)(qp + 64), b1 = *(const u32x4*)(qp + 80);
          if (hi) { b0 = (u32x4){0u, 0u, 0u, 0u}; b1 = b0; }
          qf[MODE == 1 ? 1 : 0] = (v8i_t){(int)b0[0], (int)b0[1], (int)b0[2], (int)b0[3], (int)b1[0], (int)b1[1], (int)b1[2], (int)b1[3]}; } }
    const int kpc = (MODE == 1) ? (wid < 6 ? wid : wid - 2) : wid;
    const int vpc = (MODE == 1) ? (wid & 3) : wid;
    const unsigned koff = (unsigned)(((MODE == 1 && kpc >= 4) ? (kpc - 4) : kpc) * 1024 + lane * 16);
    const unsigned voff = (unsigned)(vpc * 1024 + lane * 16);
    const unsigned char* kbase = (MODE == 1 && kpc >= 4) ? p.k8r : p.k8;
    const size_t kstep = (MODE == 1) ? ((kpc >= 4) ? 2048 : 4096) : 8192;
#define AQ_ISSUE_K(t) do { const int t_ = (t); if (t_ < nt) { const unsigned sb_ = ldsb + (unsigned)((t_ & 3) * KSLOT); \
        glds16s(koff, kbase + (size_t)t_ * kstep, (unsigned)__builtin_amdgcn_readfirstlane(sb_ + kpc * 1024)); } } while (0)
#define AQ_ISSUE_V(t) do { const int t_ = (t); if (t_ < nt) { const unsigned sb_ = ldsb + (unsigned)(VRING + ((t_ + 3) & 7) * VSLOT); \
        glds16s(voff, p.v8 + (size_t)t_ * VSLOT, (unsigned)__builtin_amdgcn_readfirstlane(sb_ + vpc * 1024)); } } while (0)
    float m = 0.f, l = 0.f;
    if (wid >= 4) __builtin_amdgcn_s_setprio(1);
    f32x16 o[NDB], negm, sa0, sa1, sb0, sb1;
#pragma unroll
    for (int db = 0; db < NDB; ++db)
#pragma unroll
        for (int i = 0; i < 16; ++i) o[db][i] = 0.f;
#pragma unroll
    for (int i = 0; i < 16; ++i) negm[i] = 0.f;
    const int vo = hi * 1024 + r32 * 16;
    const int ko_n = ((MODE == 2 ? sub * 4 : 0) + 2 * hi) * 1024 + r32 * 16;
    const int ko_r = 4 * 1024 + r32 * 16;
    u32x4 kfl[MODE == 1 ? 2 : 1], kfh[MODE == 1 ? 2 : 1], vfl[MODE == 1 ? 2 : 1], vfh[MODE == 1 ? 2 : 1]; v8i_t pfa, pfb;
    f32x4v ol = (f32x4v){0.f, 0.f, 0.f, 0.f};
    const int onesw = ((lane & 15) == ((lane >> 4) & 1)) ? 0x38383838 : 0;
    const v8i_t ones_fr = (v8i_t){onesw, onesw, onesw, onesw, onesw, onesw, onesw, onesw};
#define AQ_SB() __builtin_amdgcn_sched_barrier(0)
#define AQ_LDKF(s_, j, Ks_) do { const int o_ = ((MODE == 1 && ((j) >> 1)) ? ko_r : ko_n) + ((j) & 1) * 512; kfl[s_] = *(const LAS u32x4*)((Ks_) + o_); kfh[s_] = *(const LAS u32x4*)((Ks_) + o_ + 1024); } while (0)
#define AQ_LDVF(s_, db, Vs_) do { vfl[s_] = *(const LAS u32x4*)((Vs_) + (db) * 2048); vfh[s_] = *(const LAS u32x4*)((Vs_) + (db) * 2048 + 512); } while (0)
#define AQ_KF(s_) ((v8i_t){(int)kfl[s_][0], (int)kfl[s_][1], (int)kfl[s_][2], (int)kfl[s_][3], (int)kfh[s_][0], (int)kfh[s_][1], (int)kfh[s_][2], (int)kfh[s_][3]})
#define AQ_VF(s_) ((v8i_t){(int)vfl[s_][0], (int)vfl[s_][1], (int)vfl[s_][2], (int)vfl[s_][3], (int)vfh[s_][0], (int)vfh[s_][1], (int)vfh[s_][2], (int)vfh[s_][3]})
#define AQ_Q(j, s_, N0, N1) do { if ((j) & 1) { if ((j) < 2) N1 = mfma_f8q(AQ_KF(s_), qf[0], negm); else N1 = mfma_f8q(AQ_KF(s_), qf[MODE == 1 ? 1 : 0], N1); asm volatile("" : "+v"(N1)); } \
        else { if ((j) < 2) N0 = mfma_f8q(AQ_KF(s_), qf[0], negm); else N0 = mfma_f8q(AQ_KF(s_), qf[MODE == 1 ? 1 : 0], N0); asm volatile("" : "+v"(N0)); } } while (0)
#define AQ_P(db, s_, PF) do { o[db] = mfma_f8(AQ_VF(s_), PF, o[db]); asm volatile("" : "+v"(o[db])); } while (0)
#define AQ_PL(PF) do { ol = mfma_f8s16(ones_fr, PF, ol, 0x7f7f7f7f); asm volatile("" : "+v"(ol)); } while (0)
#define AQ_EXP8(g, C) do { const int b_ = 8 * ((g) & 1); _Pragma("unroll") for (int i_ = 0; i_ < 8; ++i_) { C[b_ + i_] = fast_exp2(C[b_ + i_]); asm volatile("" : "+v"(C[b_ + i_])); } } while (0)
#define AQ_CVT4(g, C, PF) do { const int b_ = 8 * ((g) & 1); \
        int w0_, w1_; asm volatile("" : "=v"(w0_), "=v"(w1_));                                                    \
        w0_ = __builtin_amdgcn_cvt_pk_fp8_f32(C[b_ + 0], C[b_ + 1], w0_, false); w0_ = __builtin_amdgcn_cvt_pk_fp8_f32(C[b_ + 2], C[b_ + 3], w0_, true); \
        w1_ = __builtin_amdgcn_cvt_pk_fp8_f32(C[b_ + 4], C[b_ + 5], w1_, false); w1_ = __builtin_amdgcn_cvt_pk_fp8_f32(C[b_ + 6], C[b_ + 7], w1_, true); \
        asm volatile("" : "+v"(w0_), "+v"(w1_)); PF[2 * (g)] = w0_; PF[2 * (g) + 1] = w1_; } while (0)
#define AQ_EXP(g, C0, C1) do { if ((g) < 2) AQ_EXP8(g, C0); else AQ_EXP8(g, C1); } while (0)
#define AQ_CVT(g, C0, C1, PF) do { if ((g) < 2) AQ_CVT4(g, C0, PF); else AQ_CVT4(g, C1, PF); } while (0)
#define AQ_IMAX(a_, b_) ((a_) > (b_) ? (a_) : (b_))
#define AQ_TILE(C0, C1, N0, N1, PFC, PFP, HASN, HASP, MID, tm, KSC, VSC) do { \
        const LAS unsigned char* Ks_ = ((KSC) >= 0) ? lds + (KSC) * KSLOT : lds + ks_next * KSLOT;                   \
        const LAS unsigned char* Vs_ = ((VSC) >= 0) ? vqb + (VSC) * VSLOT : lds + VRING + vs_prev * VSLOT + vo; \
        if (HASN) { AQ_LDKF(0, 0, Ks_); if (MODE == 1) AQ_LDKF(1, 1, Ks_); } if (HASP) { AQ_LDVF(0, 0, Vs_); if (MODE == 1) AQ_LDVF(1, 1, Vs_); } \
        AQ_EXP(0, C0, C1); AQ_SB(); \
        if (MODE == 1) { if (HASN) { AQ_Q(0, 0, N0, N1); AQ_Q(1, 1, N0, N1); AQ_LDKF(0, 2, Ks_); AQ_LDKF(1, 3, Ks_); } } \
        else { if (HASN) { AQ_Q(0, 0, N0, N1); AQ_LDKF(0, 1, Ks_); } if (HASP) { AQ_P(0, 0, PFP); AQ_LDVF(0, 1, Vs_); } } AQ_SB(); \
        AQ_CVT(0, C0, C1, PFC); AQ_EXP(1, C0, C1); AQ_SB(); \
        if (MODE == 1) { if (HASN) { AQ_Q(2, 0, N0, N1); AQ_Q(3, 1, N0, N1); } } \
        else { if (HASN) AQ_Q(1, 0, N0, N1); if (HASP) { AQ_P(1, 0, PFP); AQ_LDVF(0, 2, Vs_); } } AQ_SB(); \
        AQ_CVT(1, C0, C1, PFC); AQ_SB(); \
        if (MID) ATT_WAITN_BAR(0);                                         \
        if (HASP) { if (MODE == 1) { AQ_P(0, 0, PFP); AQ_P(1, 1, PFP); } else { AQ_P(2, 0, PFP); AQ_LDVF(0, 3, Vs_); AQ_PL(PFP); } } \
        if (MID) { AQ_ISSUE_K((tm) + 4); AQ_ISSUE_K((tm) + 5); AQ_ISSUE_V((tm) + 2); AQ_ISSUE_V((tm) + 3); } AQ_SB(); \
        AQ_EXP(2, C0, C1); AQ_CVT(2, C0, C1, PFC); AQ_EXP(3, C0, C1); AQ_SB(); \
        if (HASP) { if (MODE == 1) AQ_PL(PFP); else AQ_P(3, 0, PFP); } AQ_SB(); \
        AQ_CVT(3, C0, C1, PFC); \
        if (HASN) { int ri_ = AQ_IMAX(AQ_IMAX(__float_as_int(N0[0]), __float_as_int(N1[0])), __float_as_int(N0[1]));     \
            _Pragma("unroll") for (int i_ = 1; i_ < 15; ++i_) ri_ = AQ_IMAX(AQ_IMAX(ri_, __float_as_int(N1[i_])), __float_as_int(N0[i_ + 1])); \
            ri_ = AQ_IMAX(ri_, __float_as_int(N1[15])); \
            const float rm_ = __int_as_float(ximax32(ri_)); \
            if (__any(rm_ > THR)) { \
                { const LAS unsigned char* Vn_ = lds + VRING + ((vs_prev + 1) & 7) * VSLOT + vo;                    \
                  _Pragma("unroll") for (int db_ = 0; db_ < NDB; ++db_) { AQ_LDVF(0, db_, Vn_); AQ_P(db_, 0, PFC); } AQ_PL(PFC); \
                  _Pragma("unroll") for (int i_ = 0; i_ < 8; ++i_) PFC[i_] = 0; } \
                const float dl_ = fmaxf(rm_ - F8_OFF, 0.f); m += dl_; const float f_ = fast_exp2(-dl_); ol[0] *= __shfl(f_, lane & 15); ol[1] *= __shfl(f_, (lane & 15) + 16); \
                _Pragma("unroll") for (int i_ = 0; i_ < 16; ++i_) { N0[i_] -= dl_; N1[i_] -= dl_; negm[i_] = -m; } \
                _Pragma("unroll") for (int db_ = 0; db_ < NDB; ++db_) _Pragma("unroll") for (int i_ = 0; i_ < 16; ++i_) o[db_][i_] *= f_; } } \
        ks_next = (ks_next + 1) & 3; vs_prev = (vs_prev + 1) & 7; } while (0)
    AQ_ISSUE_K(0); AQ_ISSUE_K(1); AQ_ISSUE_K(2); AQ_ISSUE_V(0);
    ATT_WAITN_BAR(0);
    { const LAS unsigned char* Ks_ = lds;
#pragma unroll
      for (int j = 0; j < NQK; ++j) { AQ_LDKF(MODE == 1 ? (j & 1) : 0, j, Ks_); AQ_Q(j, MODE == 1 ? (j & 1) : 0, sa0, sa1); }
      float rm = fmaxf(sa0[0], sa1[0]);
#pragma unroll
      for (int i = 1; i < 16; ++i) rm = fmaxf(fmaxf(rm, sa0[i]), sa1[i]);
      rm = xmax32(rm) - F8_OFF; m = rm;
#pragma unroll
      for (int i = 0; i < 16; ++i) { sa0[i] -= rm; sa1[i] -= rm; negm[i] = -rm; } }
    const LAS unsigned char* vqb = lds;
    int ks_next = 1, vs_prev = 2;
    ATT_WAITN_BAR(0); AQ_ISSUE_K(3); AQ_ISSUE_K(4); AQ_ISSUE_V(1); AQ_ISSUE_V(2);
    AQ_TILE(sa0, sa1, sb0, sb1, pfa, pfb, true, false, false, 0, -1, -1); AQ_TILE(sb0, sb1, sa0, sa1, pfb, pfa, true, true, true, 1, -1, -1);
    int t = 2;
    for (; t + 4 <= nt - 2; t += 4) {
        vqb = lds + VRING + ((t + 2) & 7) * VSLOT + vo;
        AQ_TILE(sa0, sa1, sb0, sb1, pfa, pfb, true, true, false, 0, 3, 0); AQ_TILE(sb0, sb1, sa0, sa1, pfb, pfa, true, true, true, t + 1, 0, 1);
        AQ_TILE(sa0, sa1, sb0, sb1, pfa, pfb, true, true, false, 0, 1, 2); AQ_TILE(sb0, sb1, sa0, sa1, pfb, pfa, true, true, true, t + 3, 2, 3);
    }
    for (; t < nt - 2; t += 2) {
        AQ_TILE(sa0, sa1, sb0, sb1, pfa, pfb, true, true, false, 0, -1, -1); AQ_TILE(sb0, sb1, sa0, sa1, pfb, pfa, true, true, true, t + 1, -1, -1);
    }
    AQ_TILE(sa0, sa1, sb0, sb1, pfa, pfb, true, true, false, 0, -1, -1); AQ_TILE(sb0, sb1, sa0, sa1, pfb, pfa, false, true, true, nt - 1, -1, -1);
    { const LAS unsigned char* Vs_ = lds + VRING + vs_prev * VSLOT + vo;
      if (MODE == 1) { AQ_LDVF(0, 0, Vs_); AQ_LDVF(1, 1, Vs_); AQ_P(0, 0, pfb); AQ_P(1, 1, pfb); }
      else {
#pragma unroll
          for (int db = 0; db < NDB; ++db) { AQ_LDVF(0, db, Vs_); AQ_P(db, 0, pfb); } }
      AQ_PL(pfb); }
    { const float l0 = __shfl(ol[0], lane & 15), l1 = __shfl(ol[1], lane & 15); l = (lane & 16) ? l1 : l0; }
    const float inv = fast_rcp(l);
    if (MODE != 2) {
#pragma unroll
        for (int db = 0; db < NDB; ++db)
#pragma unroll
            for (int g = 0; g < 4; ++g) { const f32x4 v4 = (f32x4){o[db][4 * g], o[db][4 * g + 1], o[db][4 * g + 2], o[db][4 * g + 3]} * inv;
                *(unsigned*)(p.o + (size_t)qrow * p.opitch + 32 * db + 8 * g + 4 * hi) = pg8::pk_fp8x4(v4 * 32.f); }
    } else {
        LAS float* X = (LAS float*)lds;
        ATT_WAITBAR();
        if (sub == 1) {
#pragma unroll
            for (int db = 0; db < NDB; ++db)
#pragma unroll
                for (int i = 0; i < 16; ++i) X[((wid - 4) * 64 + db * 16 + i) * 64 + lane] = o[db][i] * inv;
        }
        ATT_WAITBAR();
        if (sub == 0) {
            float ss = 0.f;
#pragma unroll
            for (int db = 0; db < NDB; ++db)
#pragma unroll
                for (int i = 0; i < 16; ++i) { const float val = o[db][i] * inv - p.lam * X[(wid * 64 + db * 16 + i) * 64 + lane]; o[db][i] = val; ss += val * val; }
            ss = xsum32(ss);
            const float rstd = (1.0f - LAM_INIT) / sqrtf(ss * (1.0f / 128.0f) + 1e-6f);
#pragma unroll
            for (int db = 0; db < NDB; ++db)
#pragma unroll
                for (int g = 0; g < 4; ++g) { const int d = 32 * db + 8 * g + 4 * hi; const f32x4 w4 = *(const f32x4*)(p.subln + d);
                    const f32x4 v4 = (f32x4){o[db][4 * g], o[db][4 * g + 1], o[db][4 * g + 2], o[db][4 * g + 3]} * rstd * w4;
                    *(unsigned*)(p.o + (size_t)qrow * p.opitch + d) = pg8::pk_fp8x4(v4 * 32.f); }
        }
    }
    __builtin_amdgcn_s_setprio(0);
    ATT_WAITBAR();
#undef AQ_ISSUE_K
#undef AQ_ISSUE_V
#undef AQ_SB
#undef AQ_LDKF
#undef AQ_LDVF
#undef AQ_KF
#undef AQ_VF
#undef AQ_Q
#undef AQ_P
#undef AQ_PL
#undef AQ_EXP8
#undef AQ_CVT4
#undef AQ_EXP
#undef AQ_CVT
#undef AQ_IMAX
#undef AQ_TILE
}

DI void attn_unit_f8l0(const P& p, LAS unsigned char* lds, const LAS float* rpbL) {
    constexpr int KSLOT = 4096, VSLOT = 4096, VRING = 3 * KSLOT, NDB = 2;
    const int tid = threadIdx.x, lane = tid & 63, r32 = lane & 31, hi = lane >> 5; const int wid = __builtin_amdgcn_readfirstlane(tid >> 6);
    const int qrow = 32 * wid + r32;
    const int nt = p.nt;
    const unsigned ldsb = (unsigned)(size_t)lds;
    v8i_t qf;
    { const unsigned char* qp = p.q8 + (size_t)qrow * p.qpitch;
      const u32x4 a0 = *(const u32x4*)(qp + 32 * hi), a1 = *(const u32x4*)(qp + 32 * hi + 16);
      qf = (v8i_t){(int)a0[0], (int)a0[1], (int)a0[2], (int)a0[3], (int)a1[0], (int)a1[1], (int)a1[2], (int)a1[3]}; }
    const bool isk = wid < 4; const int pc = wid & 3;
    const unsigned doff = (unsigned)(pc * 1024 + lane * 16);
    const unsigned char* dbase = isk ? p.k8 : p.v8;
#define L0_UT(t) (((t) >= 4) ? (p.t_lo + (t) - 4) : (t))
#define L0_ISSUE(t) do { const int tt_ = isk ? (t) + 3 : (t) + 2; if (tt_ >= 0 && tt_ < nt) { const unsigned sb_ = ldsb + (unsigned)((isk ? 0 : VRING) + (tt_ % 3) * 4096); \
        glds16s(doff, dbase + (size_t)L0_UT(tt_) * 4096, (unsigned)__builtin_amdgcn_readfirstlane(sb_ + pc * 1024)); } } while (0)
    float m = 0.f, l = 0.f;
    f32x16 o[NDB], negm, sa0, sa1, sb0, sb1, ol;
#pragma unroll
    for (int db = 0; db < NDB; ++db)
#pragma unroll
        for (int i = 0; i < 16; ++i) o[db][i] = 0.f;
#pragma unroll
    for (int i = 0; i < 16; ++i) { negm[i] = 0.f; ol[i] = 0.f; }
    const int onesw = (r32 == 0) ? 0x38383838 : 0;
    const v8i_t ones_fr = (v8i_t){onesw, onesw, onesw, onesw, onesw, onesw, onesw, onesw};
    const bool has_sink = (p.kind & 1) == 0;
    const int vo = hi * 1024 + r32 * 16;
    const int ko_n = (2 * hi) * 1024 + r32 * 16;
    u32x4 klo[2], khi[2]; v8i_t pf; u32x4 vlo[NDB], vhi[NDB];
#define L0_SB() __builtin_amdgcn_sched_barrier(0)
#define L0_LDK(j, Ks_) do { klo[j] = *(const LAS u32x4*)((Ks_) + ko_n + (j) * 512); khi[j] = *(const LAS u32x4*)((Ks_) + ko_n + (j) * 512 + 1024); } while (0)
#define L0_LDV(Vs_) do { _Pragma("unroll") for (int db_ = 0; db_ < NDB; ++db_) { vlo[db_] = *(const LAS u32x4*)((Vs_) + db_ * 2048); vhi[db_] = *(const LAS u32x4*)((Vs_) + db_ * 2048 + 512); } } while (0)
#define L0_KFR(j) ((v8i_t){(int)klo[j][0], (int)klo[j][1], (int)klo[j][2], (int)klo[j][3], (int)khi[j][0], (int)khi[j][1], (int)khi[j][2], (int)khi[j][3]})
#define L0_PV() do { _Pragma("unroll") for (int db_ = 0; db_ < NDB; ++db_) { \
        const v8i_t vfr_ = (v8i_t){(int)vlo[db_][0], (int)vlo[db_][1], (int)vlo[db_][2], (int)vlo[db_][3], (int)vhi[db_][0], (int)vhi[db_][1], (int)vhi[db_][2], (int)vhi[db_][3]}; \
        o[db_] = mfma_f8(vfr_, pf, o[db_]); } ol = mfma_f8(ones_fr, pf, ol); } while (0)
#define L0_VALU8(g, C) do { const int b_ = 8 * ((g) & 1); \
        _Pragma("unroll") for (int i_ = 0; i_ < 8; ++i_) { C[b_ + i_] = fast_exp2(C[b_ + i_]); } \
        int w0_, w1_; asm volatile("" : "=v"(w0_), "=v"(w1_));                                                    \
        w0_ = __builtin_amdgcn_cvt_pk_fp8_f32(C[b_ + 0], C[b_ + 1], w0_, false); w0_ = __builtin_amdgcn_cvt_pk_fp8_f32(C[b_ + 2], C[b_ + 3], w0_, true); \
        w1_ = __builtin_amdgcn_cvt_pk_fp8_f32(C[b_ + 4], C[b_ + 5], w1_, false); w1_ = __builtin_amdgcn_cvt_pk_fp8_f32(C[b_ + 6], C[b_ + 7], w1_, true); \
        asm volatile("" : "+v"(w0_), "+v"(w1_)); pf[2 * (g)] = w0_; pf[2 * (g) + 1] = w1_; } while (0)
#define L0_VALU(g, C0, C1) do { if ((g) < 2) L0_VALU8(g, C0); else L0_VALU8(g, C1); } while (0)
#define L0_CR(i_) (((i_) & 3) + 8 * ((i_) >> 2))
#define L0_MASK(tn, N0, N1) do { if ((tn) >= 4) { const int ut_ = L0_UT(tn); \
        if (p.kind == 0) { const int kb_ = (ut_ - 4) * 64 - (p.s0 + qrow) + 4 * hi + 128;                 \
            if (!__all(kb_ >= 0 && kb_ + 59 <= 256)) { \
            _Pragma("unroll") for (int i_ = 0; i_ < 16; ++i_) { if ((unsigned)(kb_ + L0_CR(i_)) > 256u) N0[i_] = -INFINITY; if ((unsigned)(kb_ + L0_CR(i_) + 32) > 256u) N1[i_] = -INFINITY; } } \
        } else if (p.kind == 1) { const int kr_ = ut_ - 4, r_ = (p.s0 >> 6) + (wid >> 1), qc_ = 32 * (wid & 1) + r32; int rs_ = r_ - 4; rs_ = rs_ < 0 ? 0 : (rs_ > 248 ? 248 : rs_); \
            const bool rowok_ = (kr_ >= rs_) && (kr_ < rs_ + 8); int cs_ = qc_ - 8; cs_ = cs_ < 0 ? 0 : (cs_ > 48 ? 48 : cs_); \
            int bri_ = kr_ - r_ + 7; bri_ = bri_ < 0 ? 0 : (bri_ > 14 ? 14 : bri_); \
            const LAS float* bp_ = rpbL + bri_ * 31 + (4 * hi - qc_ + 15);                                  \
            const int cb_ = rowok_ ? (4 * hi - cs_) : 4096;                                                     \
            _Pragma("unroll") for (int i_ = 0; i_ < 16; ++i_) { \
                const float b0_ = bp_[L0_CR(i_)], b1_ = bp_[L0_CR(i_) + 32]; \
                N0[i_] = ((unsigned)(cb_ + L0_CR(i_)) < 16u) ? N0[i_] + b0_ : -INFINITY; N1[i_] = ((unsigned)(cb_ + L0_CR(i_) + 32) < 16u) ? N1[i_] + b1_ : -INFINITY; } } } } while (0)
#define L0_TILE(t, C0, C1, N0, N1, HASN) do { \
        const LAS unsigned char* Ks_ = lds + ks_next * KSLOT; const LAS unsigned char* Vs_ = lds + VRING + vs_cur * VSLOT + vo; \
        if (HASN) L0_LDK(0, Ks_); L0_VALU(0, C0, C1); L0_SB(); \
        L0_VALU(1, C0, C1); if (HASN) { N0 = mfma_f8q(L0_KFR(0), qf, negm); asm volatile("" : "+v"(N0)); } L0_SB(); \
        if (HASN) L0_LDK(1, Ks_); L0_VALU(2, C0, C1); L0_SB(); \
        L0_LDV(Vs_); L0_VALU(3, C0, C1); if (HASN) { N1 = mfma_f8q(L0_KFR(1), qf, negm); asm volatile("" : "+v"(N1)); } L0_SB(); \
        L0_PV(); \
        if (HASN) { L0_MASK((t) + 1, N0, N1); float rm_ = fmaxf(N0[0], N1[0]); \
            _Pragma("unroll") for (int i_ = 1; i_ < 16; ++i_) rm_ = fmaxf(fmaxf(rm_, N0[i_]), N1[i_]); \
            rm_ = xmax32(rm_); \
            if (__any(rm_ > THR)) { const float dl_ = fmaxf(rm_ - F8_OFF, 0.f); m += dl_; const float f_ = fast_exp2(-dl_); ol[0] *= f_; \
                _Pragma("unroll") for (int i_ = 0; i_ < 16; ++i_) { N0[i_] -= dl_; N1[i_] -= dl_; negm[i_] = -m; } \
                _Pragma("unroll") for (int db_ = 0; db_ < NDB; ++db_) _Pragma("unroll") for (int i_ = 0; i_ < 16; ++i_) o[db_][i_] *= f_; } } \
        ks_next = (ks_next == 2) ? 0 : ks_next + 1; vs_cur = (vs_cur == 2) ? 0 : vs_cur + 1; } while (0)
#define L0_TOP(t) do { if ((t) + 2 < nt) ATT_WAITN_BAR(1); else ATT_WAITN_BAR(0); L0_ISSUE(t); } while (0)
    L0_ISSUE(-3);
    L0_ISSUE(-2);
    ATT_WAITBAR();
    L0_ISSUE(-1);
    { const LAS unsigned char* Ks_ = lds;
      L0_LDK(0, Ks_); L0_LDK(1, Ks_); sa0 = mfma_f8q(L0_KFR(0), qf, negm); sa1 = mfma_f8q(L0_KFR(1), qf, negm);
      float rm = fmaxf(sa0[0], sa1[0]);
#pragma unroll
      for (int i = 1; i < 16; ++i) rm = fmaxf(fmaxf(rm, sa0[i]), sa1[i]);
      rm = xmax32(rm); if (has_sink) rm = fmaxf(rm, p.sink2);
      rm -= F8_OFF; m = rm;
#pragma unroll
      for (int i = 0; i < 16; ++i) { sa0[i] -= rm; sa1[i] -= rm; negm[i] = -rm; }
      if (has_sink && hi == 0) ol[0] = fast_exp2(p.sink2 - m); }
    int ks_next = 1, vs_cur = 0;
    for (int t = 0; t < nt - 2; t += 2) {
        L0_TOP(t);     L0_TILE(t, sa0, sa1, sb0, sb1, true);
        L0_TOP(t + 1); L0_TILE(t + 1, sb0, sb1, sa0, sa1, true);
    }
    L0_TOP(nt - 2); L0_TILE(nt - 2, sa0, sa1, sb0, sb1, true);
    ATT_WAITN_BAR(0); L0_TILE(nt - 1, sb0, sb1, sa0, sa1, false);
    l = hi ? 0.f : ol[0];
    const float inv = fast_rcp(xsum32(l));
#pragma unroll
    for (int db = 0; db < NDB; ++db)
#pragma unroll
        for (int g = 0; g < 4; ++g) { const f32x4 v4 = (f32x4){o[db][4 * g], o[db][4 * g + 1], o[db][4 * g + 2], o[db][4 * g + 3]} * inv;
            *(unsigned*)(p.o + (size_t)qrow * p.opitch + 32 * db + 8 * g + 4 * hi) = pg8::pk_fp8x4(v4 * 32.f); }
    ATT_WAITBAR();
#undef L0_UT
#undef L0_ISSUE
#undef L0_SB
#undef L0_LDK
#undef L0_LDV
#undef L0_KFR
#undef L0_PV
#undef L0_VALU8
#undef L0_VALU
#undef L0_MASK
#undef L0_CR
#undef L0_TILE
#undef L0_TOP
}
}

struct Ctx {
    LAS unsigned char* lds; gu32* ctl; unsigned char* ws;
    int tid, lane, wave, vcu, G;
    const float* const __attribute__((address_space(4)))* inp;
    float* out;
};
DI const float* modp(const Ctx& F, int l, int which, int chunk) { return (const float*)(F.ws + WS_MOD) + ((size_t)(l * 3 + which) * 6 + chunk) * 1024; }

DI void ld_f32(const float* p, int lane, f32x4 (&v)[4]) {
#pragma unroll
    for (int j = 0; j < 4; ++j) v[j] = *(const f32x4*)(p + 4 * lane + 256 * j); }
DI void ld_bf16(const bf16_t* p, int lane, f32x4 (&v)[4]) {
#pragma unroll
    for (int j = 0; j < 4; ++j) { const u32x2 w = *(const u32x2*)(p + 4 * lane + 256 * j); v[j] = (f32x4){bf_lo(w.x), bf_hi(w.x), bf_lo(w.y), bf_hi(w.y)}; } }
DI void st_f32(float* p, int lane, const f32x4 (&v)[4]) {
#pragma unroll
    for (int j = 0; j < 4; ++j) *(f32x4*)(p + 4 * lane + 256 * j) = v[j]; }
DI void st_bf16(bf16_t* p, int lane, const f32x4 (&v)[4]) {
#pragma unroll
    for (int j = 0; j < 4; ++j) pg8::st4(p + 4 * lane + 256 * j, v[j]); }
DI void st_fp8row(unsigned char* p, int lane, const f32x4 (&v)[4]) {
#pragma unroll
    for (int j = 0; j < 4; ++j) *(unsigned*)(p + 4 * lane + 256 * j) = pg8::pk_fp8x4(v[j]); }
DI void ld_f32_nt(const float* p, int lane, f32x4 (&v)[4]) {
#pragma unroll
    for (int j = 0; j < 4; ++j) v[j] = __builtin_nontemporal_load((const f32x4*)(p + 4 * lane + 256 * j)); }
DI void ld_bf16_nt(const bf16_t* p, int lane, f32x4 (&v)[4]) {
#pragma unroll
    for (int j = 0; j < 4; ++j) { const u32x2 w = __builtin_nontemporal_load((const u32x2*)(p + 4 * lane + 256 * j)); v[j] = (f32x4){bf_lo(w.x), bf_hi(w.x), bf_lo(w.y), bf_hi(w.y)}; } }
DI void st_f32_nt(float* p, int lane, const f32x4 (&v)[4]) {
#pragma unroll
    for (int j = 0; j < 4; ++j) __builtin_nontemporal_store(v[j], (f32x4*)(p + 4 * lane + 256 * j)); }
DI void st_bf16_nt(bf16_t* p, int lane, const f32x4 (&v)[4]) {
#pragma unroll
    for (int j = 0; j < 4; ++j) { u32x2 w; w.x = cvtpk(v[j][0], v[j][1]); w.y = cvtpk(v[j][2], v[j][3]); __builtin_nontemporal_store(w, (u32x2*)(p + 4 * lane + 256 * j)); } }
DI void layer_norm_row(f32x4 (&v)[4], const float* g, const float* b, int lane) {
    float s = 0.f;
#pragma unroll
    for (int j = 0; j < 4; ++j) s += (v[j][0] + v[j][1]) + (v[j][2] + v[j][3]);
    const float mean = wave_sum(s) * (1.f / 1024.f); float s2 = 0.f;
#pragma unroll
    for (int j = 0; j < 4; ++j) { v[j] = v[j] - mean; s2 += (v[j][0] * v[j][0] + v[j][1] * v[j][1]) + (v[j][2] * v[j][2] + v[j][3] * v[j][3]); }
    const float rstd = 1.0f / sqrtf(wave_sum(s2) * (1.f / 1024.f) + 1e-5f);
    f32x4 gg[4], bb[4]; ld_f32(g, lane, gg); ld_f32(b, lane, bb);
#pragma unroll
    for (int j = 0; j < 4; ++j) v[j] = v[j] * rstd * gg[j] + bb[j];
}
DI void modulate_row(f32x4 (&h)[4], const f32x4 (&v)[4], const float* sc, const float* sh, int lane) {
    f32x4 a[4], b[4]; ld_f32(sc, lane, a); ld_f32(sh, lane, b);
#pragma unroll
    for (int j = 0; j < 4; ++j) h[j] = v[j] * (1.0f + a[j]) + b[j];
}

DI void conv_item(const float* W, int K, int Nsrc, bf16_t* WT, int Ndst, int kind, const float* gk, LAS float* scr, int item, int lane, bool f8 = false) {
    const int nblk = Ndst / 32, kb = item / nblk, nb = item % nblk, k0 = 64 * kb, n0 = 32 * nb;
    int srcb = n0; bool perm = false;
    if (kind == 1) { if (n0 < 512) srcb = 672 + n0; else if (n0 < 1024) srcb = 1184 + (n0 - 512); else if (n0 < 1536) srcb = 1696 + (n0 - 1024); else if (n0 < 1920) srcb = n0 - 1536;
                     else if (n0 < 2176) srcb = 384 + (n0 - 1920); else if (n0 == 2176) { srcb = 640; perm = true; } else srcb = -1; }
    else if (kind == 2) { if (n0 < 512) srcb = (n0 >> 6) * 96 + (n0 & 63); else { srcb = ((n0 - 512) >> 5) * 96 + 64; perm = true; } }
    else if (kind == 3) { if (n0 < 512) srcb = (n0 >> 6) * 128 + (n0 & 63); else srcb = ((n0 - 512) >> 6) * 128 + 64 + ((n0 - 512) & 63); }
    else if (kind == 4) { const int pn = n0 >> 8, w = n0 & 255; srcb = (w < 128) ? (128 * pn + w) : (512 + 128 * pn + (w - 128)); }
    const int nl = lane & 31; int sc = nl; if (perm) sc = (nl < 8) ? nl : (nl < 16 ? nl + 8 : (nl < 24 ? nl - 8 : nl));
    float vv[32];
#pragma unroll
    for (int i = 0; i < 32; ++i) { const int kk = 2 * i + (lane >> 5); vv[i] = (srcb >= 0) ? __builtin_nontemporal_load(W + (size_t)(k0 + kk) * Nsrc + srcb + sc) : 0.f; }
    if (gk) {
#pragma unroll
        for (int i = 0; i < 32; ++i) vv[i] *= gk[k0 + 2 * i + (lane >> 5)]; }
#pragma unroll
    for (int i = 0; i < 32; ++i) scr[(2 * i + (lane >> 5)) * 33 + nl] = vv[i];
    asm volatile("s_waitcnt lgkmcnt(0)" ::: "memory");
    const int c = lane & 7;
#pragma unroll
    for (int j = 0; j < 4; ++j) { const int n = (lane >> 3) + 8 * j; const LAS float* s = scr + (8 * c) * 33 + n;
        u32x4 o; o.x = cvtpk(s[0 * 33], s[1 * 33]); o.y = cvtpk(s[2 * 33], s[3 * 33]); o.z = cvtpk(s[4 * 33], s[5 * 33]); o.w = cvtpk(s[6 * 33], s[7 * 33]);
        if (f8) { u32x2 o8; o8.x = pg8::pk_fp8x4((f32x4){s[0 * 33], s[1 * 33], s[2 * 33], s[3 * 33]} * 64.f); o8.y = pg8::pk_fp8x4((f32x4){s[4 * 33], s[5 * 33], s[6 * 33], s[7 * 33]} * 64.f);
            *(u32x2*)((unsigned char*)WT + (size_t)(n0 + n) * K + k0 + 8 * c) = o8; }
        else __builtin_nontemporal_store(o, (u32x4*)(WT + (size_t)(n0 + n) * K + k0 + 8 * c)); }
    asm volatile("s_waitcnt lgkmcnt(0)" ::: "memory");
}

DI void phase_prologue(const Ctx& F) {
    LAS float* sl = (LAS float*)F.lds;
    LAS float* red = sl + 3072;
    for (int u = blockIdx.x; u < 193; u += F.G) {
        if (u < 192) {
            const int l = u / 96, n0 = (u % 96) * 64;
            for (int idx = F.tid; idx < 3072; idx += 512) { const int which = idx >> 10, k = idx & 1023; const float v = which < 2 ? F.inp[1][which * 1024 + k] : F.inp[3][k]; sl[idx] = v * fast_rcp(1.f + fast_exp2(-v * LOG2E)); }
            __syncthreads();
            float a0 = 0.f, a1 = 0.f, a2 = 0.f; const float* wp = F.inp[4] + ((size_t)l * 1024 + F.wave * 128) * 6144 + n0 + F.lane;
#pragma unroll 8
            for (int k = 0; k < 128; ++k) { const float w = __builtin_nontemporal_load(wp + (size_t)k * 6144); const int kk = F.wave * 128 + k; a0 += sl[kk] * w; a1 += sl[1024 + kk] * w; a2 += sl[2048 + kk] * w; }
            red[(F.wave * 3 + 0) * 64 + F.lane] = a0; red[(F.wave * 3 + 1) * 64 + F.lane] = a1; red[(F.wave * 3 + 2) * 64 + F.lane] = a2;
            __syncthreads();
            if (F.wave < 3) { float s = F.inp[5][l * 6144 + n0 + F.lane];
#pragma unroll
                for (int w = 0; w < 8; ++w) s += red[(w * 3 + F.wave) * 64 + F.lane];
                ((float*)(F.ws + WS_MOD))[(size_t)(l * 3 + F.wave) * 6144 + n0 + F.lane] = s; }
            __syncthreads();
        } else {
            float* r64c = (float*)(F.ws + WS_ROPE); float* r64s = r64c + 4096; float* r32c = r64s + 4096; float* r32s = r32c + 2048;
            for (int idx = F.tid; idx < 4096 + 2048; idx += 512) {
                const bool big = idx < 4096; const int id = big ? idx : idx - 4096; const int pos = big ? (id >> 4) : (id >> 3), i = big ? (id & 15) : (id & 7);
                const float inv = exp2f(-(float)i * (big ? (13.287712379549449f / 16.f) : (13.287712379549449f / 8.f)));
                const float ang = (float)pos * inv;
                const float kq = rintf(ang * 0.15915494309189535f);
                float r = fmaf(-kq, 6.2831854820251465f, ang); r = fmaf(-kq, -1.7484555314695172e-07f, r);
                const float cs = __cosf(r), sn = __sinf(r);
                if (big) { r64c[id] = cs; r64s[id] = sn; } else { r32c[id] = cs; r32s[id] = sn; }
            }
        }
    }
    __syncthreads();
    LAS float* scr = (LAS float*)(F.lds + F.wave * 8448);
    const int gw = F.vcu * 8 + F.wave, NGW = F.G * 8;
    constexpr int I_IN = 16 * 72, I_SQ = 16 * 32, I_UQ = 6 * 24, I_UKV = 4 * 32;
    constexpr int NITEMS = 2 * I_IN + 2 * I_SQ + I_UQ + I_UKV;
    for (int it = gw; it < NITEMS; it += NGW) {
        int r = it;
        if (r < I_IN) { conv_item(F.inp[8], 1024, 2304, (bf16_t*)(F.ws + WS_WAB_IN), 2304, 0, nullptr, scr, r, F.lane, true); continue; } r -= I_IN;
        if (r < I_IN) { conv_item(F.inp[12], 1024, 2208, (bf16_t*)(F.ws + WS_WCD_IN), 2304, 1, nullptr, scr, r, F.lane, true); continue; } r -= I_IN;
        if (r < I_SQ) { conv_item(F.inp[11], 1024, 1024, (bf16_t*)(F.ws + WS_WAB_OUT), 1024, 0, nullptr, scr, r, F.lane, true); continue; } r -= I_SQ;
        if (r < I_SQ) { conv_item(F.inp[19], 1024, 1024, (bf16_t*)(F.ws + WS_WCD_OUT), 1024, 0, nullptr, scr, r, F.lane, true); continue; } r -= I_SQ;
        if (r < I_UQ) { conv_item(F.inp[14], 384, 768, (bf16_t*)(F.ws + WS_WUQ), 768, 2, F.inp[13], scr, r, F.lane); continue; } r -= I_UQ;
        conv_item(F.inp[16], 256, 1024, (bf16_t*)(F.ws + WS_WUKV), 1024, 3, F.inp[15], scr, r, F.lane);
    }
}

DI void conv_moe_slice(const Ctx& F, int l, int step) {
    constexpr int I_GU = 16 * 32, I_DN = 8 * 32, PER_L = 32 * I_GU + 32 * I_DN;
    LAS float* scr = (LAS float*)(F.lds + F.wave * 8448);
    const int per_wg = (PER_L + F.G - 1) / F.G, per_step = (per_wg + 7) / 8;
    const int lo = (int)blockIdx.x * per_wg + step * per_step;
    int hi = lo + per_step; const int wg_hi = ((int)blockIdx.x + 1) * per_wg; hi = hi < wg_hi ? hi : wg_hi; hi = hi < PER_L ? hi : PER_L;
    for (int r = lo + F.wave; r < hi; r += 8) {
        if (r < 32 * I_GU) { const int mtx = l * 32 + r / I_GU; conv_item(F.inp[24] + (size_t)mtx * 1024 * 1024, 1024, 1024, (bf16_t*)(F.ws + WS_WGU + (size_t)mtx * 1024 * 1024), 1024, 4, nullptr, scr, r % I_GU, F.lane, true); }
        else { const int r2 = r - 32 * I_GU; const int mtx = l * 32 + r2 / I_DN; conv_item(F.inp[25] + (size_t)mtx * 512 * 1024, 512, 1024, (bf16_t*)(F.ws + WS_WDN + (size_t)mtx * 1024 * 512), 1024, 0, nullptr, scr, r2 % I_DN, F.lane, true); }
    }
}

DI const float* src_row_l0(const Ctx& F, int urow, int& which) {
    const int b = urow / RB, rr = urow - b * RB;
    if (rr < CTXL) { which = 2; return F.inp[2] + ((size_t)b * CTXL + rr) * 1024; }
    which = b; return F.inp[0] + ((size_t)b * SEQ + (rr - CTXL)) * 1024;
}

DI void phase_modulate0(const Ctx& F) {
    bf16_t* H = (bf16_t*)(F.ws + WS_H);
    for (int urow = F.vcu * 8 + F.wave; urow < MU; urow += F.G * 8) {
        int which; const float* src = src_row_l0(F, urow, which);
        f32x4 v[4], h[4]; ld_f32_nt(src, F.lane, v);
        modulate_row(h, v, modp(F, 0, which, 1), modp(F, 0, which, 0), F.lane);
        st_fp8row((unsigned char*)H + (size_t)urow * 1024, F.lane, h);
    }
}

constexpr int PASS_ROWS = 136;
template <int CTRL> DI float dpp_ror_add(float v) { return v + __builtin_bit_cast(float, __builtin_amdgcn_update_dpp(0, __builtin_bit_cast(int, v), CTRL, 0xf, 0xf, false)); }
DI float reduce4(float a, float b, float c, float d) {
    auto r1 = __builtin_amdgcn_permlane32_swap(__float_as_uint(a), __float_as_uint(b), false, false);
    auto r2 = __builtin_amdgcn_permlane32_swap(__float_as_uint(c), __float_as_uint(d), false, false);
    const float z1 = __uint_as_float(r1[0]) + __uint_as_float(r1[1]);
    const float z2 = __uint_as_float(r2[0]) + __uint_as_float(r2[1]);
    auto r3 = __builtin_amdgcn_permlane16_swap(__float_as_uint(z1), __float_as_uint(z2), false, false);
    float w = __uint_as_float(r3[0]) + __uint_as_float(r3[1]);
    w = dpp_ror_add<0x128>(w); w = dpp_ror_add<0x124>(w); w = dpp_ror_add<0x122>(w); w = dpp_ror_add<0x121>(w);
    return w;
}
DI void phase_ln1_router(const Ctx& F, const int l) {
    constexpr int RG = 2;
    constexpr int WRS = 1028;
    LAS float* Wr = (LAS float*)F.lds;
    LAS unsigned* rinfo = (LAS unsigned*)(F.lds + 148480);
    LAS int* lcnt = (LAS int*)(F.lds + 148480 + PASS_ROWS * 32);
    LAS int* lbase = lcnt + 32;
    LAS float* lgs = (LAS float*)(F.lds + 148480 + PASS_ROWS * 32 + 256) + F.wave * (RG * 36);
    const float* wg = F.inp[20] + (size_t)l * 4096; const float* we = F.inp[22] + (size_t)l * 32768;
    for (int idx = F.tid; idx < 4096; idx += 512) Wr[(idx & 3) * WRS + (idx >> 2)] = wg[idx];
    for (int idx = F.tid; idx < 32768; idx += 512) Wr[(4 + (idx & 31)) * WRS + (idx >> 5)] = we[idx];
    if (F.tid < 32) lcnt[F.tid] = 0;
    __syncthreads();
    const int nrows = (l == 0) ? MU : NB * SEQ;
    const int rpw = (nrows + F.G - 1) / F.G, r_begin = (int)blockIdx.x * rpw, r_end = (r_begin + rpw < nrows) ? r_begin + rpw : nrows;
    const bf16_t* YP = (const bf16_t*)(F.ws + WS_YP); bf16_t* XA = (bf16_t*)(F.ws + WS_XA); const bf16_t* XB = (const bf16_t*)(F.ws + WS_XB); bf16_t* H = (bf16_t*)(F.ws + WS_H);
    int* list = (int*)(F.ws + WS_LIST); unsigned* tokinfo = (unsigned*)(F.ws + WS_TOKINFO); unsigned* gcnt = (unsigned*)(F.ctl + CW_CNT + l * 32);
    const float* lng = F.inp[6] + (size_t)(l * 2 + 0) * 1024; const float* lnb = F.inp[7] + (size_t)(l * 2 + 0) * 1024;
    const float* bgp = F.inp[21] + l * 4; const float* bep = F.inp[23] + l * 32;
    for (int pb = r_begin; pb < r_end; pb += PASS_ROWS) {
        const int npass = (r_end - pb < PASS_ROWS) ? (r_end - pb) : PASS_ROWS;
        for (int g4 = F.wave; RG * g4 < npass; g4 += 8) {
            f32x4 hm[RG][4]; int urows[RG];
#pragma unroll
            for (int r = 0; r < RG; ++r) {
                const int lr = RG * g4 + r;
                if (lr < npass) {
                    const int j = pb + lr; int urow, which; const float* src = nullptr;
                    if (l == 0) { urow = j; src = src_row_l0(F, urow, which); }
                    else { const int b = j >> 14; urow = b * RB + CTXL + (j & 16383); which = b; }
                    urows[r] = urow;
                    f32x4 v[4], y[4], g1[4]; if (l == 0) ld_f32_nt(src, F.lane, v); else ld_bf16_nt(XB + (size_t)urow * 1024, F.lane, v); ld_bf16_nt(YP + (size_t)urow * 1024, F.lane, y); ld_f32(modp(F, l, which, 2), F.lane, g1);
#pragma unroll
                    for (int jj = 0; jj < 4; ++jj) v[jj] = v[jj] * DN_ALPHA + g1[jj] * y[jj];
                    layer_norm_row(v, lng, lnb, F.lane);
                    st_bf16_nt(XA + (size_t)urow * 1024, F.lane, v);
                    modulate_row(hm[r], v, modp(F, l, which, 4), modp(F, l, which, 3), F.lane);
                    st_fp8row((unsigned char*)H + (size_t)urow * 1024, F.lane, hm[r]);
                } else { urows[r] = 0;
#pragma unroll
                    for (int jj = 0; jj < 4; ++jj) hm[r][jj] = (f32x4){0.f, 0.f, 0.f, 0.f}; }
            }
#pragma unroll 3
            for (int c4 = 0; c4 < 9; ++c4) {
                float pr[RG][4];
#pragma unroll
                for (int cc = 0; cc < 4; ++cc) {
                    f32x4 w[4];
#pragma unroll
                    for (int jj = 0; jj < 4; ++jj) w[jj] = *(const LAS f32x4*)(Wr + (c4 * 4 + cc) * WRS + 256 * jj + 4 * F.lane);
#pragma unroll
                    for (int r = 0; r < RG; ++r) { f32x2 a2 = (f32x2){0.f, 0.f};
#pragma unroll
                        for (int jj = 0; jj < 4; ++jj) { a2 += (f32x2){hm[r][jj][0], hm[r][jj][1]} * (f32x2){w[jj][0], w[jj][1]}; a2 += (f32x2){hm[r][jj][2], hm[r][jj][3]} * (f32x2){w[jj][2], w[jj][3]}; }
                        pr[r][cc] = a2[0] + a2[1]; }
                }
#pragma unroll
                for (int r = 0; r < RG; ++r) {
                    const float wv = reduce4(pr[r][0], pr[r][1], pr[r][2], pr[r][3]);
                    const int q = F.lane >> 4; const int cmap = (q == 1) ? 2 : (q == 2 ? 1 : q);
                    if ((F.lane & 15) == 0) lgs[r * 36 + c4 * 4 + cmap] = wv;
                }
            }
            asm volatile("s_waitcnt lgkmcnt(0)" ::: "memory");
            if (F.lane < RG && RG * g4 + F.lane < npass) {
                const int r = F.lane, lr = RG * g4 + r; const LAS float* lg = lgs + r * 36;
                float gv[4];
#pragma unroll
                for (int i = 0; i < 4; ++i) gv[i] = lg[i] + bgp[i];
                int gi = 0; float gm = gv[0];
#pragma unroll
                for (int i = 1; i < 4; ++i) if (gv[i] > gm) { gm = gv[i]; gi = i; }
                float gs = 0.f;
#pragma unroll
                for (int i = 0; i < 4; ++i) gs += fast_exp2((gv[i] - gm) * LOG2E);
                const float gval = 1.0f / gs;
                float ev[8];
#pragma unroll
                for (int i = 0; i < 8; ++i) ev[i] = lg[4 + 8 * gi + i] + bep[8 * gi + i];
                int i1 = 0; float m1 = ev[0];
#pragma unroll
                for (int i = 1; i < 8; ++i) if (ev[i] > m1) { m1 = ev[i]; i1 = i; }
                int i2 = -1; float m2 = -INFINITY;
#pragma unroll
                for (int i = 0; i < 8; ++i) if (i != i1 && ev[i] > m2) { m2 = ev[i]; i2 = i; }
                const float tt = fast_exp2((m2 - m1) * LOG2E); const float w0 = gval / (1.f + tt), w1 = gval * tt / (1.f + tt);
                const int E0 = gi * 8 + i1, E1 = gi * 8 + i2;
                const int ls0 = __hip_atomic_fetch_add(lcnt + E0, 1, __ATOMIC_RELAXED, __HIP_MEMORY_SCOPE_WORKGROUP);
                const int ls1 = __hip_atomic_fetch_add(lcnt + E1, 1, __ATOMIC_RELAXED, __HIP_MEMORY_SCOPE_WORKGROUP);
                LAS unsigned* ri = rinfo + lr * 8;
                ri[0] = (unsigned)E0; ri[1] = (unsigned)ls0; ri[2] = __float_as_uint(w0); ri[3] = (unsigned)E1; ri[4] = (unsigned)ls1; ri[5] = __float_as_uint(w1);
                ri[6] = (unsigned)(r == 0 ? urows[0] : urows[RG - 1]);
            }
            asm volatile("s_waitcnt lgkmcnt(0)" ::: "memory");
        }
        __syncthreads();
        if (F.tid < 32) { const int n = lcnt[F.tid]; lbase[F.tid] = n > 0 ? (int)__hip_atomic_fetch_add(gcnt + F.tid, (unsigned)n, __ATOMIC_RELAXED, __HIP_MEMORY_SCOPE_AGENT) : 0; }
        __syncthreads();
        for (int lr = F.tid; lr < npass; lr += 512) {
            const LAS unsigned* ri = rinfo + lr * 8;
            const int E0 = (int)ri[0], E1 = (int)ri[3]; const int s0 = lbase[E0] + (int)ri[1], s1 = lbase[E1] + (int)ri[4]; const int urow = (int)ri[6];
            list[(size_t)E0 * LIST_CAP + s0] = urow; list[(size_t)E1 * LIST_CAP + s1] = urow;
            u32x4 a; a.x = (unsigned)E0; a.y = (unsigned)s0; a.z = ri[2]; a.w = (unsigned)E1; u32x4 b; b.x = (unsigned)s1; b.y = ri[5]; b.z = 0u; b.w = 0u;
            *(u32x4*)(tokinfo + (size_t)urow * 8) = a; *(u32x4*)(tokinfo + (size_t)urow * 8 + 4) = b;
        }
        __syncthreads();
        if (F.tid < 32) lcnt[F.tid] = 0;
        __syncthreads();
    }
}

DI void moe_tables(const Ctx& F, int l) {
    LAS int* tb = (LAS int*)(F.lds + LDS_AUX);
    if (F.tid < 32) tb[64 + F.tid] = (int)__hip_atomic_load(F.ctl + CW_CNT + l * 32 + F.tid, RLX_AGENT);
    __syncthreads();
    if (F.tid == 0) { int a = 0; for (int e = 0; e < 32; ++e) { tb[e] = a; a += (tb[64 + e] + 255) >> 8; } tb[32] = a; }
    __syncthreads();
}
struct MoeOrder {
    const LAS int* tb; int G, c; const char* A; const char* W; size_t wstride, tstepB, tstepA; const int* list; unsigned lda2; bool gatherA;
    DI bool next(int i, pg8::Unit& u) const {
        const int ntot = tb[32]; const long L = (long)i * G + c; if (L >= (long)ntot * 4) return false;
        const int rt = (int)(L >> 2), pn = (int)(L & 3); int e = 0;
        for (int j = 1; j < 32; ++j) e += (tb[j] <= rt) ? 1 : 0;
        e = __builtin_amdgcn_readfirstlane(e);
        u.pm = rt; u.pn = pn; u.aux0 = e; u.aux1 = __builtin_amdgcn_readfirstlane((rt - tb[e]) * 256);
        u.A = gatherA ? A : A + (size_t)rt * tstepA; u.B = W + (size_t)e * wstride + (size_t)pn * tstepB; return true;
    }
    DI unsigned gather(const pg8::Unit& u, int r) const {
        const int slot = u.aux1 + r, n = tb[64 + u.aux0];
        const int tok = list[(size_t)u.aux0 * LIST_CAP + (slot < n ? slot : 0)];
        return (unsigned)tok * lda2;
    }
};

DI void phase_ln2(const Ctx& F, const int l) {
    moe_tables(F, l);
    const LAS int* tb = (const LAS int*)(F.lds + LDS_AUX);
    const bf16_t* YS = (const bf16_t*)(F.ws + WS_YS); const bf16_t* XA = (const bf16_t*)(F.ws + WS_XA); bf16_t* XB = (bf16_t*)(F.ws + WS_XB); bf16_t* H = (bf16_t*)(F.ws + WS_H);
    const unsigned* tokinfo = (const unsigned*)(F.ws + WS_TOKINFO);
    const float* lng = F.inp[6] + (size_t)(l * 2 + 1) * 1024; const float* lnb = F.inp[7] + (size_t)(l * 2 + 1) * 1024;
    const int nrows = (l == 0) ? MU : NB * SEQ;
    const int stride = F.G * 8;
    for (int j0 = F.vcu * 8 + F.wave; j0 < nrows; j0 += 2 * stride) {
        int urow[2], which[2], bb[2], ss[2]; bool ok[2]; u32x4 ia[2]; u32x2 ib[2]; f32x4 v[2][4], ya[2][4], yb[2][4];
#pragma unroll
        for (int r = 0; r < 2; ++r) { const int j = j0 + r * stride; ok[r] = j < nrows; const int jj = ok[r] ? j : j0;
            if (l == 0) { urow[r] = jj; bb[r] = jj / RB; which[r] = (jj - bb[r] * RB) < CTXL ? 2 : bb[r]; ss[r] = 0; }
            else { bb[r] = jj >> 14; ss[r] = jj & 16383; urow[r] = bb[r] * RB + CTXL + ss[r]; which[r] = bb[r]; }
            ia[r] = *(const u32x4*)(tokinfo + (size_t)urow[r] * 8); ib[r] = *(const u32x2*)(tokinfo + (size_t)urow[r] * 8 + 4);
            ld_bf16_nt(XA + (size_t)urow[r] * 1024, F.lane, v[r]); }
#pragma unroll
        for (int r = 0; r < 2; ++r) { const int p0 = tb[ia[r].x] * 256 + (int)ia[r].y, p1 = tb[ia[r].w] * 256 + (int)ib[r].x;
            ld_bf16_nt(YS + (size_t)p0 * 1024, F.lane, ya[r]); ld_bf16_nt(YS + (size_t)p1 * 1024, F.lane, yb[r]); }
#pragma unroll
        for (int r = 0; r < 2; ++r) {
            if (!ok[r]) continue;
            const float w0 = __uint_as_float(ia[r].z), w1 = __uint_as_float(ib[r].y);
            f32x4 g2[4]; ld_f32(modp(F, l, which[r], 5), F.lane, g2);
#pragma unroll
            for (int jj = 0; jj < 4; ++jj) v[r][jj] = v[r][jj] * DN_ALPHA + g2[jj] * (ya[r][jj] * w0 + yb[r][jj] * w1);
            layer_norm_row(v[r], lng, lnb, F.lane);
            if (l == 0) {
                st_bf16_nt(XB + (size_t)urow[r] * 1024, F.lane, v[r]);
                f32x4 h[4]; modulate_row(h, v[r], modp(F, 1, which[r], 1), modp(F, 1, which[r], 0), F.lane);
                st_fp8row((unsigned char*)H + (size_t)urow[r] * 1024, F.lane, h);
            } else st_f32_nt(F.out + ((size_t)bb[r] * SEQ + ss[r]) * 1024, F.lane, v[r]);
        }
    }
}

template <class Sched> DI void rms_tables(const Ctx& F, const Sched& S, const bf16_t* base, int col0, int ncols, LAS float* rs) {
    pg8::Unit u;
    for (int i = 0; i < 16 && S.next(i, u); ++i) {
        const int r = F.tid >> 1, hsel = F.tid & 1; const int half = ncols / 2;
        const bf16_t* p = base + (size_t)(u.pm * 256 + r) * NQKV + col0 + hsel * half; float ss = 0.f;
        for (int k = 0; k < half; k += 8) { const u32x4 w = *(const u32x4*)(p + k);
            ss += bf_lo(w.x) * bf_lo(w.x) + bf_hi(w.x) * bf_hi(w.x) + bf_lo(w.y) * bf_lo(w.y) + bf_hi(w.y) * bf_hi(w.y) + bf_lo(w.z) * bf_lo(w.z) + bf_hi(w.z) * bf_hi(w.z) + bf_lo(w.w) * bf_lo(w.w) + bf_hi(w.w) * bf_hi(w.w); }
        ss += __shfl_xor(ss, 1);
        if (hsel == 0) rs[i * 256 + r] = 1.0f / sqrtf(ss / (float)ncols + 1e-6f);
    }
    __syncthreads();
}

#ifndef MK_PER_PHASE
#define MK_PER_PHASE 0
#endif
constexpr int N_PHASES = 17;
struct Args { const float* in[26]; float* out; unsigned char* ws; int ph_lo, ph_hi; };

__global__ void __launch_bounds__(512, 2) mk_fwd(Args args) {
    extern __shared__ __attribute__((aligned(16))) unsigned char lds_raw[];
    Ctx F;
    F.lds = (LAS unsigned char*)lds_raw; F.ws = args.ws; F.ctl = (gu32*)(args.ws + WS_CTL);
    F.tid = threadIdx.x; F.lane = F.tid & 63; F.wave = __builtin_amdgcn_readfirstlane(F.tid >> 6);
    F.G = gridDim.x; { const int bx = blockIdx.x; F.vcu = (F.G % 8 == 0) ? (bx % 8) * (F.G / 8) + bx / 8 : bx; }
    F.inp = (const float* const __attribute__((address_space(4)))*)__builtin_amdgcn_kernarg_segment_ptr();
    F.out = args.out;
    volatile LAS unsigned* MISC = (volatile LAS unsigned*)(F.lds + LDS_MISC);
    if (F.tid < 16) MISC[F.tid] = 0u;
    __syncthreads();
    XcdBarrier bar; bar.bar = (unsigned*)(F.ctl + CW_BAR); bar.x = 0; bar.st = nullptr;
    if (!MK_PER_PHASE) bar = xcd_barrier_post((unsigned*)(F.ctl + CW_BAR), MISC);
    const int lo = args.ph_lo, hi = args.ph_hi;
#define IN(k) (lo <= (k) && (k) < hi)
#define SEAM(k) do { if (IN(k) && IN((k) + 1)) xcd_barrier(bar); } while (0)
#define H ((bf16_t*)(F.ws + WS_H))
#define AO ((bf16_t*)(F.ws + WS_AO))
#define QKV ((bf16_t*)(F.ws + WS_QKV))
#define YP ((bf16_t*)(F.ws + WS_YP))
#define ACT ((bf16_t*)(F.ws + WS_ACT))
#define YS ((bf16_t*)(F.ws + WS_YS))
#define QM ((bf16_t*)(F.ws + WS_QM))
#define KVM ((bf16_t*)(F.ws + WS_KVM))
#define r32c ((const float*)(F.ws + WS_ROPE) + 8192)
#define r32s ((const float*)(F.ws + WS_ROPE) + 8192 + 2048)
    LAS unsigned char* ring = F.lds;

    if (IN(0)) { phase_prologue(F); } SEAM(0);
    if (IN(1)) { phase_modulate0(F); } SEAM(1);

    if (IN(2)) {
        pg8::DenseOrder S; S.init(130, 9, F.G, (int)blockIdx.x, false, H, 512, F.ws + WS_WAB_IN, 512);
        pg8::EpiInProj<0> E{F.ws};
        pg8::gemm_phase<pg8::EpiInProj<0>, pg8::DenseOrder, false, true>(ring, 512, 512, S, E);
    } SEAM(2);
    if (IN(3)) {
        LAS float* rpbL = (LAS float*)(F.lds + LDS_AUX); int nconv = 0;
        for (int i = 0;; ++i) {
            const int L = i * F.G + F.vcu; if (L >= 2048 + 32) break;
            att::P p; p.opitch = 1024; p.qpitch = 512; p.k8r = nullptr; p.lam = 0.f; p.subln = nullptr; p.sink2 = 0.f; p.t_lo = 4; p.s0 = 0;
            int b, head, mixer; size_t qr0;
            if (L >= 2048) { const int Lc = L - 2048, j = Lc & 15; mixer = Lc >> 4; b = j >> 3; head = j & 7; p.kind = 2 + mixer; p.nt = 4; qr0 = (size_t)(b * RB); }
            else { const int j = L & 1023; mixer = L >> 10; const int qb = j & 63; head = (j >> 6) & 7; b = j >> 9; p.kind = mixer; p.s0 = qb * 256; qr0 = (size_t)(b * RB + CTXL + p.s0);
                int tlo, thi;
                if (mixer == 0) { tlo = p.s0 / 64 - 2; thi = p.s0 / 64 + 5; tlo = tlo < 0 ? 0 : tlo; thi = thi > 255 ? 255 : thi; }
                else { const int R0 = p.s0 >> 6; tlo = R0 - 4; tlo = tlo < 0 ? 0 : (tlo > 248 ? 248 : tlo); thi = R0 - 1; thi = thi < 0 ? 0 : (thi > 248 ? 248 : thi); thi += 7; }
                p.t_lo = 4 + tlo; p.nt = 4 + (thi - tlo + 1); }
            p.o = (unsigned char*)AO + qr0 * 1024;
            if (mixer == 0) { p.o += head * 64; p.sink2 = F.inp[9][head] * LOG2E;
                p.k8 = F.ws + WS_K8A + (size_t)(b * 2 + (head >> 2)) * 260 * 4096; p.v8 = F.ws + WS_VT8A + (size_t)(b * 2 + (head >> 2)) * 260 * 4096; p.q8 = F.ws + WS_Q8A + qr0 * 512 + head * 64; }
            else { p.o += 512 + head * 64;
                p.k8 = F.ws + WS_K8B + (size_t)(b * 8 + head) * 260 * 4096; p.v8 = F.ws + WS_VT8B + (size_t)(b * 8 + head) * 260 * 4096; p.q8 = F.ws + WS_Q8B + qr0 * 512 + head * 64;
                if (p.kind == 1) for (int idx = F.tid; idx < 465; idx += 512) rpbL[idx] = F.inp[10][head * 465 + idx] * LOG2E; }
            p.nt += (p.nt & 1);
            att::attn_unit_f8l0(p, ring, rpbL);
            if (i < 8) { conv_moe_slice(F, 0, i); __syncthreads(); }
            nconv = i + 1;
        }
        for (int s = nconv; s < 8; ++s) { conv_moe_slice(F, 0, s); __syncthreads(); }
    } SEAM(3);

#define LAYER_TAIL(l) do {\
        const int pb = (l == 0) ? 4 : 12;\
        if (IN(pb)) {\
            pg8::DenseOrder S; S.init(l == 0 ? 130 : 128, 4, F.G, (int)blockIdx.x, l == 1, AO, 512, F.ws + (l == 0 ? WS_WAB_OUT : WS_WCD_OUT), 512);\
            pg8::EpiPlain E{YP, 1024};\
            pg8::gemm_phase<pg8::EpiPlain, pg8::DenseOrder, false, true>(ring, 512, 512, S, E, 0x7a7a7a7a);    \
        } SEAM(pb);\
        if (IN(pb + 1)) { phase_ln1_router(F, l); } SEAM(pb + 1);\
        if (IN(pb + 2)) {\
            moe_tables(F, l);\
            MoeOrder S{(const LAS int*)(F.lds + LDS_AUX), F.G, (int)blockIdx.x, (const char*)H, (const char*)(F.ws + WS_WGU) + (size_t)l * 32 * 1024 * 1024, (size_t)1024 * 1024, (size_t)256 * 1024, 0,\
                       (const int*)(F.ws + WS_LIST), 1024u, true};\
            pg8::EpiGU E{(unsigned char*)ACT};\
            pg8::gemm_phase<pg8::EpiGU, MoeOrder, true, true>(ring, 512, 512, S, E);                     \
        } SEAM(pb + 2);\
        if (IN(pb + 3)) {\
            moe_tables(F, l);\
            MoeOrder S{(const LAS int*)(F.lds + LDS_AUX), F.G, (int)blockIdx.x, (const char*)ACT, (const char*)(F.ws + WS_WDN) + (size_t)l * 32 * 1024 * 512, (size_t)1024 * 512, (size_t)256 * 512, (size_t)256 * 512,\
                       (const int*)(F.ws + WS_LIST), 0u, false};\
            pg8::EpiPlain E{YS, 1024};\
            pg8::gemm_phase<pg8::EpiPlain, MoeOrder, false, true>(ring, 256, 256, S, E);                \
        } SEAM(pb + 3);\
        if (IN(pb + 4)) { phase_ln2(F, l); }\
    } while (0)
    LAYER_TAIL(0); SEAM(8);

    if (IN(9)) {
        pg8::DenseOrder S; S.init(130, 9, F.G, (int)blockIdx.x, false, H, 512, F.ws + WS_WCD_IN, 512);
        pg8::EpiInProj<1> E{F.ws};
        pg8::gemm_phase<pg8::EpiInProj<1>, pg8::DenseOrder, false, true>(ring, 512, 512, S, E);
    } SEAM(9);
    if (IN(10)) {
        LAS float* rsq = (LAS float*)(F.lds + LDS_AUX); LAS float* rskv = rsq + 1024;
        pg8::DenseOrder Sq; Sq.init(128, 3, F.G, (int)blockIdx.x, true, QKV + 1536, NQKV, F.ws + WS_WUQ, 384);
        pg8::DenseOrder Skv; Skv.init(130, 4, F.G, (int)blockIdx.x, false, QKV + 1920, NQKV, F.ws + WS_WUKV, 256);
        rms_tables(F, Sq, QKV, 1536, 384, rsq);
        rms_tables(F, Skv, QKV, 1920, 256, rskv);
        pg8::EpiUQ Eq{F.ws + WS_Q8M, rsq, r32c, r32s};
        pg8::gemm_phase<pg8::EpiUQ, pg8::DenseOrder, false>(ring, NQKV, 384, Sq, Eq);
        pg8::EpiUKV Ekv{F.ws + WS_K8M, rskv, F.ws + WS_VT8M};
        pg8::gemm_phase<pg8::EpiUKV, pg8::DenseOrder, false>(ring, NQKV, 256, Skv, Ekv);
    } SEAM(10);
    if (IN(11)) {
        float lam; { const float* lp = F.inp[17]; float s01 = 0.f, s23 = 0.f; for (int i = 0; i < 64; ++i) { s01 += lp[i] * lp[64 + i]; s23 += lp[128 + i] * lp[192 + i]; }
            lam = fast_exp2(s01 * LOG2E) - fast_exp2(s23 * LOG2E) + LAM_INIT; }
        int nconv = 0;
        for (int i = 0;; ++i) {
            const int L = i * F.G + F.vcu; if (L >= 2048) break;
            att::P p; p.kind = 0; p.t_lo = 0; p.s0 = 0; p.sink2 = 0.f; p.nt = RB / 64; p.opitch = 1024; p.lam = lam; p.subln = F.inp[18];
            if (L < 1024) { const int qb = L & 63, head = (L >> 6) & 7, b = L >> 9; const size_t qrow0 = (size_t)(b * RB + CTXL + qb * 256);
                p.o = (unsigned char*)AO + qrow0 * 1024 + head * 64; p.v8 = F.ws + WS_VT8M + (size_t)(b * 8 + head) * 260 * 4096; p.k8 = F.ws + WS_K8M + (size_t)(b * 8 + head) * 260 * 4096; p.k8r = F.ws + WS_K8R + (size_t)b * 260 * 2048;
                p.q8 = F.ws + WS_Q8M + qrow0 * 768 + head * 96; p.qpitch = 768;
                att::attn_unit_f8q<1>(p, ring);
            } else { const int j = L - 1024; const int qb = j & 127, head = (j >> 7) & 3, b = j >> 9; const size_t qrow0 = (size_t)(b * RB + CTXL + qb * 128);
                p.o = (unsigned char*)AO + qrow0 * 1024 + 512 + head * 128; p.v8 = F.ws + WS_VT8D + (size_t)(b * 4 + head) * 260 * 8192; p.k8 = F.ws + WS_K8D + (size_t)(b * 4 + head) * 260 * 8192; p.k8r = nullptr;
                p.q8 = F.ws + WS_Q8D + qrow0 * 512 + head * 128; p.qpitch = 512;
                att::attn_unit_f8q<2>(p, ring);
            }
            if (i < 8) { conv_moe_slice(F, 1, i); __syncthreads(); }
            nconv = i + 1;
        }
        for (int s = nconv; s < 8; ++s) { conv_moe_slice(F, 1, s); __syncthreads(); }
    } SEAM(11);

    LAYER_TAIL(1);
#undef LAYER_TAIL
#undef IN
#undef SEAM
#undef H
#undef AO
#undef QKV
#undef YP
#undef ACT
#undef YS
#undef QM
#undef KVM
#undef r32c
#undef r32s
}

extern "C" void kernel_launch(void* const* d_in, const int* in_sizes, int n_in, void* d_out, int out_size, void* d_ws, size_t ws_size, hipStream_t stream) {
    static int grid = 0;
    if (grid == 0) {
        if (n_in != 26 || out_size != NB * SEQ * DM || ws_size < WS_END) { fprintf(stderr, "kernel_launch: unexpected shapes (n_in %d, out %d, ws %zu < %zu)\n", n_in, out_size, ws_size, (size_t)WS_END); grid = -1; return; }
        int dev = 0, cus = 0, per_cu = 0;
        if (hipGetDevice(&dev) != hipSuccess || hipDeviceGetAttribute(&cus, hipDeviceAttributeMultiprocessorCount, dev) != hipSuccess) { grid = -1; return; }
        if (hipFuncSetAttribute((const void*)mk_fwd, hipFuncAttributeMaxDynamicSharedMemorySize, LDS_BYTES) != hipSuccess) { fprintf(stderr, "kernel_launch: hipFuncSetAttribute failed\n"); grid = -1; return; }
        if (hipOccupancyMaxActiveBlocksPerMultiprocessor(&per_cu, (const void*)mk_fwd, 512, LDS_BYTES) != hipSuccess || per_cu < 1) fprintf(stderr, "kernel_launch: occupancy query says %d\n", per_cu);
        (void)hipGetLastError();
        grid = cus;
    }
    if (grid < 0) return;
    (void)hipMemsetAsync((char*)d_ws + WS_CTL, 0, CTL_ZERO_BYTES, stream);
    Args a{};
    for (int i = 0; i < 26; ++i) a.in[i] = (const float*)d_in[i];
    a.out = (float*)d_out; a.ws = (unsigned char*)d_ws;
#if MK_PER_PHASE
    for (int ph = 0; ph < N_PHASES; ++ph) { a.ph_lo = ph; a.ph_hi = ph + 1; hipLaunchKernelGGL(mk_fwd, dim3(grid), dim3(512), LDS_BYTES, stream, a); }
#else
    a.ph_lo = 0; a.ph_hi = N_PHASES;
    hipLaunchKernelGGL(mk_fwd, dim3(grid), dim3(512), LDS_BYTES, stream, a);
#endif
}
```

```cpp
#include <hip/hip_runtime.h>
#include <cstdio>
#include <cstdint>

#define GAS __attribute__((address_space(1)))
#define LAS __attribute__((address_space(3)))
typedef unsigned short bf16_t;
typedef short bf16x8 __attribute__((ext_vector_type(8)));
typedef short s16x4 __attribute__((ext_vector_type(4)));
typedef float f32x4 __attribute__((ext_vector_type(4)));
typedef float f32x2 __attribute__((ext_vector_type(2)));
typedef float f32x16 __attribute__((ext_vector_type(16)));
typedef unsigned u32x4 __attribute__((ext_vector_type(4)));
typedef unsigned u32x2 __attribute__((ext_vector_type(2)));
typedef __bf16 bf16x2_t __attribute__((ext_vector_type(2)));
typedef short v4i16_t __attribute__((ext_vector_type(4)));
typedef GAS unsigned gu32;
#define RLX_AGENT __ATOMIC_RELAXED, __HIP_MEMORY_SCOPE_AGENT
#define DI __device__ __forceinline__

constexpr int DM = 1024, NB = 2, SEQ = 16384, CTXL = 256;
constexpr int RB = SEQ + CTXL;
constexpr int MU = NB * RB;
constexpr int NEXP = 32, DEXP = 512;
constexpr float LOG2E = 1.4426950408889634f;
constexpr float DN_ALPHA = 1.4142135623730951f;
constexpr float LAM_INIT = 0.8f - 0.6f * 0.7408182206817179f;
constexpr int NQKV = 2304;
constexpr int LIST_CAP = MU;
constexpr int RMAX = 74752;

constexpr size_t MiB = 1u << 20;
constexpr size_t WS_CTL = 0, CTL_ZERO_BYTES = 64 * 1024;
constexpr size_t WS_MOD = 1 * MiB;
constexpr size_t WS_ROPE = 1 * MiB + 256 * 1024;
constexpr size_t WS_TOKINFO = 2 * MiB;
constexpr size_t WS_LIST = 4 * MiB;
constexpr size_t WS_WAB_IN = 10 * MiB, WS_WAB_OUT = 15 * MiB, WS_WCD_IN = 17 * MiB, WS_WCD_OUT = 22 * MiB, WS_WUQ = 24 * MiB, WS_WUKV = 25 * MiB;
constexpr size_t WS_WGU = 26 * MiB;
constexpr size_t WS_WDN = 154 * MiB;
constexpr size_t WS_XA = 218 * MiB, WS_XB = 348 * MiB;
constexpr size_t WS_H = 478 * MiB;
constexpr size_t WS_AO = 543 * MiB;
constexpr size_t WS_S = 608 * MiB;
constexpr size_t WS_QKV = WS_S;
constexpr size_t WS_QM = WS_S + 147 * MiB;
constexpr size_t WS_KVM = WS_S + 196 * MiB;
constexpr size_t WS_YP = WS_S;
constexpr size_t WS_ACT = WS_S + 65 * MiB;
constexpr size_t WS_YS = WS_S + 138 * MiB;
constexpr size_t WS_END = WS_S + 284 * MiB;
constexpr size_t WS_VT8M = 892 * MiB, WS_VT8D = 910 * MiB;
constexpr size_t WS_K8M = 928 * MiB, WS_K8D = 946 * MiB, WS_K8R = 964 * MiB;
constexpr size_t WS_Q8M = WS_QM, WS_Q8D = WS_QM + 26 * MiB;
constexpr size_t WS_Q8A = WS_QM, WS_Q8B = WS_QM + 17 * MiB, WS_K8A = WS_K8D, WS_K8B = WS_K8M, WS_VT8A = WS_VT8D, WS_VT8B = WS_VT8M;
static_assert(WS_YS + (size_t)RMAX * 1024 * 2 <= WS_END && WS_KVM + (size_t)MU * 1024 * 2 <= WS_END && WS_QM + (size_t)MU * 768 * 2 <= WS_KVM && WS_QKV + (size_t)MU * NQKV * 2 <= WS_QM, "ws map");
static_assert(WS_ACT + (size_t)RMAX * 512 * 2 <= WS_YS && WS_YP + (size_t)MU * 1024 * 2 <= WS_ACT, "ws map 2");

constexpr int CW_TMO = 0, CW_CODE = 1;
constexpr int CW_BAR = 4096;
constexpr int CW_CNT = 8192;

constexpr int RING_BYTES = 131072;
constexpr int LDS_AUX = RING_BYTES;
constexpr int LDS_MISC = 159744 - 64;
constexpr int LDS_BYTES = 159744;

DI unsigned cvtpk(float lo, float hi) { f32x2 v = {lo, hi}; bf16x2_t b = __builtin_convertvector(v, bf16x2_t); return __builtin_bit_cast(unsigned, b); }
DI float bf_lo(unsigned u) { return __uint_as_float(u << 16); }
DI float bf_hi(unsigned u) { return __uint_as_float(u & 0xffff0000u); }
DI float wave_sum(float v) {
#pragma unroll
    for (int o = 1; o < 64; o <<= 1) v += __shfl_xor(v, o);
    return v;
}
DI float fast_exp2(float x) { return __builtin_amdgcn_exp2f(x); }
DI float fast_rcp(float x) { return __builtin_amdgcn_rcpf(x); }

#define XB_TMO      128
#define XB_XCNT(j)  (256  + 64 * (j))
#define XB_XSUB(j)  (1280 + 64 * (j))
#define XB_XGEN(j)  (2304 + 64 * (j))
#define XB_TOP      3328
#define XB_TOPGEN   3392
#define XCD_BAR_WORDS 3456
#define XB_SPIN_CAP (1u << 22)

DI unsigned xb_ld(unsigned* p)              { return __hip_atomic_load(p, __ATOMIC_RELAXED, __HIP_MEMORY_SCOPE_AGENT); }
DI unsigned xb_add(unsigned* p, unsigned v) { return __hip_atomic_fetch_add(p, v, __ATOMIC_RELAXED, __HIP_MEMORY_SCOPE_AGENT); }
DI unsigned xb_xcc_id() { return (unsigned)__builtin_amdgcn_s_getreg((3 << 11) | 20) & 0xFu; }
#define XB_SPIN(cond, bar) do { unsigned _sp = 0; while (cond) { __builtin_amdgcn_s_sleep(1); \
    if ((++_sp & 255u) == 0u) { if (xb_ld(&(bar)[XB_TMO])) break; if (_sp > XB_SPIN_CAP) { atomicAdd(&(bar)[XB_TMO], 1u); break; } } } } while (0)

struct XcdBarrier { unsigned* bar; unsigned x; volatile LAS unsigned* st; };

DI XcdBarrier xcd_barrier_post(unsigned* bar, volatile LAS unsigned* st) {
    XcdBarrier b; b.bar = bar; b.x = xb_xcc_id(); b.st = st;
    if (threadIdx.x == 0) (void)xb_add(&bar[XB_XCNT(b.x)], 1u);
    return b;
}
DI void xcd_barrier_complete(unsigned* bar, unsigned x, unsigned& nloc, unsigned& nx) {
    const unsigned G = gridDim.x * gridDim.y * gridDim.z;
    unsigned sum, cnt, mine, sp = 0u;
    for (;;) {
        sum = 0u; cnt = 0u; mine = 0u;
#pragma unroll
        for (unsigned j = 0; j < 16; ++j) { const unsigned c = xb_ld(&bar[XB_XCNT(j)]); sum += c; cnt += (c > 0u) ? 1u : 0u; mine = (j == x) ? c : mine; }
        if (sum == G) break;
        __builtin_amdgcn_s_sleep(1);
        if ((++sp & 255u) == 0u) { if (xb_ld(&bar[XB_TMO])) break; if (sp > XB_SPIN_CAP) { atomicAdd(&bar[XB_TMO], 1u); break; } }
    }
    nloc = mine > 0u ? mine : 1u; nx = cnt > 0u ? cnt : 1u;
}
DI void xcd_barrier(const XcdBarrier& b) {
    asm volatile("s_waitcnt vmcnt(0)" ::: "memory");
    __syncthreads();
    if (threadIdx.x == 0) {
        unsigned* bar = b.bar;
        __builtin_amdgcn_s_waitcnt(0);
        unsigned nloc = b.st[0], nx = b.st[1];
        if (nloc == 0u) { xcd_barrier_complete(bar, b.x, nloc, nx); b.st[0] = nloc; b.st[1] = nx; }
        const unsigned old = xb_add(&bar[XB_XSUB(b.x)], 1u);
        const unsigned gen = old / nloc;
        if (old + 1u == (gen + 1u) * nloc) {
            __builtin_amdgcn_fence(__ATOMIC_RELEASE, "agent");
            asm volatile("s_waitcnt vmcnt(0)" ::: "memory");
            const unsigned og = xb_add(&bar[XB_TOP], 1u);
            const unsigned tg = og / nx;
            if (og + 1u == (tg + 1u) * nx) xb_add(&bar[XB_TOPGEN], 1u);
            else XB_SPIN(xb_ld(&bar[XB_TOPGEN]) == tg, bar);
            __builtin_amdgcn_fence(__ATOMIC_ACQUIRE, "agent");
            xb_add(&bar[XB_XGEN(b.x)], 1u);
            asm volatile("s_waitcnt vmcnt(0)" ::: "memory");
        } else {
            XB_SPIN(xb_ld(&bar[XB_XGEN(b.x)]) == gen, bar);
            __builtin_amdgcn_fence(__ATOMIC_ACQUIRE, "agent");
            asm volatile("s_waitcnt vmcnt(0)" ::: "memory");
        }
    }
    __syncthreads();
}

namespace pg8 {
constexpr int BM = 256, BK = 64, HALF = 128, HTB = HALF * BK * 2, STAGE_BYTES = 8 * HTB, NXCD = 8, WGM = 8;
__host__ __device__ __forceinline__ int lds_byte(int r, int c) { const int st = (r >> 4) * 2 + (c >> 5), rr = r & 15, cc = c & 31, ob = rr * 64 + cc * 2; return st * 1024 + (ob ^ (((ob >> 9) & 1) << 5)); }
__host__ __device__ __forceinline__ void stage_rc(int b, int& R, int& C) { const int st = b / 1024, sb = b % 1024, swz = sb ^ (((sb >> 9) & 1) << 5); R = (st >> 1) * 16 + swz / 64; C = (st & 1) * 32 + (swz % 64) / 2; }
__host__ __device__ __forceinline__ int perm32(int rho) { const int n = rho >> 4, i = rho & 15; return 8 * (i >> 2) + 4 * n + (i & 3); }

typedef int v8i_g __attribute__((ext_vector_type(8)));
struct Unit { int pm, pn; const char* A; const char* B; int aux0, aux1; };

struct DenseOrder {
    int nM, nN, nwg, G, c; bool latent_only; const char* A; const char* Bt; size_t tstepA, tstepB;
    DI void init(int nM_, int nN_, int G_, int c_, bool lat, const void* A_, int lda, const void* Bt_, int K) {
        nM = nM_; nN = nN_; nwg = nM * nN; G = G_; c = c_; latent_only = lat; A = (const char*)A_; Bt = (const char*)Bt_; tstepA = (size_t)BM * lda * 2; tstepB = (size_t)BM * K * 2; }
    DI bool next(int i, Unit& u) const {
        const long L = (long)i * G + c; if (L >= nwg) return false;
        int wgid = (int)L; { const int q = nwg / NXCD, r = nwg % NXCD, xcd = wgid % NXCD, off = wgid / NXCD; wgid = (xcd < r ? xcd * (q + 1) : r * (q + 1) + (xcd - r) * q) + off; }
        const int nig = WGM * nN, gid = wgid / nig, fm = gid * WGM, gsz = (nM - fm) < WGM ? (nM - fm) : WGM;
        int pm = fm + ((wgid % nig) % gsz); const int pn = (wgid % nig) / gsz;
        if (latent_only) pm = pm + 1 + (pm >= 64 ? 1 : 0);
        u.pm = pm; u.pn = pn; u.A = A + (size_t)pm * tstepA; u.B = Bt + (size_t)pn * tstepB; u.aux0 = 0; u.aux1 = 0; return true;
    }
    DI unsigned gather(const Unit&, int) const { return 0u; }
};

template <class Epi, class Sched, bool GATHER, bool F8 = false>
DI void gemm_phase(LAS unsigned char* lds, const int lda, const int K, const Sched& S, const Epi& E, const int sc_x8 = 0x7f7f7f7f) {
    const int tid = threadIdx.x, wid = __builtin_amdgcn_readfirstlane(tid >> 6), lane = tid & 63, wr = wid >> 2, wc = wid & 3, fr = lane & 15, fq = lane >> 4;
    const int nt = K / BK;
    int RR[2], CC[2]; unsigned voffB[2];
#pragma unroll
    for (int i = 0; i < 2; ++i) { stage_rc(tid * 16 + i * 8192, RR[i], CC[i]); const int Rb = Epi::PERM ? ((RR[i] & ~31) + perm32(RR[i] & 31)) : RR[i]; voffB[i] = (unsigned)(Rb * K + CC[i]) * 2u; }
    unsigned cv0[2], cv1[2], nv0[2], nv1[2];
    const size_t kstep = (size_t)(BK * 2);
    const size_t hstepB = (size_t)HALF * K * 2;
    const unsigned ldsw = (unsigned)wid * 1024u;
    const int aoff = lds_byte(wr * 64 + fr, fq * 8), boff = lds_byte(wc * 32 + fr, fq * 8);
#define PG8_SA(b, h) (((b) * 2 + (h)) * HTB)
#define PG8_SB(b, h) ((4 + (b) * 2 + (h)) * HTB)
#define PG8_STAGE(bufoff, gbase, voff) do { _Pragma("unroll") for (int _i = 0; _i < 2; ++_i) \
        __builtin_amdgcn_global_load_lds((const unsigned*)((const char*)(gbase) + (voff)[_i]), (LAS unsigned*)(lds + (bufoff) + ldsw + _i * 8192), 16, 0, 0); } while (0)
#define PG8_LDA(dst, b, h) do { _Pragma("unroll") for (int m = 0; m < 4; ++m) _Pragma("unroll") for (int k = 0; k < 2; ++k) dst[m][k] = *(const LAS bf16x8*)(lds + PG8_SA(b, h) + aoff + m * 2048 + k * 1024); } while (0)
#define PG8_LDB(dst, b, h) do { _Pragma("unroll") for (int n = 0; n < 2; ++n) _Pragma("unroll") for (int k = 0; k < 2; ++k) dst[n][k] = *(const LAS bf16x8*)(lds + PG8_SB(b, h) + boff + n * 2048 + k * 1024); } while (0)
#define PG8_MMA(ai, bj, At, Bt) do { __builtin_amdgcn_s_setprio(1); _Pragma("unroll") for (int m = 0; m < 4; ++m) _Pragma("unroll") for (int n = 0; n < 2; ++n) { \
        if (F8) { const u32x4 b0_ = __builtin_bit_cast(u32x4, Bt[n][0]), b1_ = __builtin_bit_cast(u32x4, Bt[n][1]), a0_ = __builtin_bit_cast(u32x4, At[m][0]), a1_ = __builtin_bit_cast(u32x4, At[m][1]); \
            const v8i_g wf_ = (v8i_g){(int)b0_[0], (int)b0_[1], (int)b0_[2], (int)b0_[3], (int)b1_[0], (int)b1_[1], (int)b1_[2], (int)b1_[3]}; \
            const v8i_g xf_ = (v8i_g){(int)a0_[0], (int)a0_[1], (int)a0_[2], (int)a0_[3], (int)a1_[0], (int)a1_[1], (int)a1_[2], (int)a1_[3]}; \
            asm volatile("v_mfma_scale_f32_16x16x128_f8f6f4 %0, %1, %2, %0, %3, %4 op_sel_hi:[0,0,0]" : "+v"(acc[ai][bj][m][n]) : "v"(wf_), "v"(xf_), "v"(sc_w8), "v"(sc_x8)); } \
        else { _Pragma("unroll") for (int k = 0; k < 2; ++k) acc[ai][bj][m][n] = __builtin_amdgcn_mfma_f32_16x16x32_bf16(Bt[n][k], At[m][k], acc[ai][bj][m][n], 0, 0, 0); } } \
        __builtin_amdgcn_s_setprio(0); } while (0)
#define PG8_WAIT_V(n) asm volatile("s_waitcnt vmcnt(" #n ")" ::: "memory")
#define PG8_WAIT_L(n) asm volatile("s_waitcnt lgkmcnt(" #n ")" ::: "memory")
#define PG8_BAR __builtin_amdgcn_s_barrier()
#define PG8_SCHED __builtin_amdgcn_sched_barrier(0)
#define PG8_SETV(v0, v1, u) do { _Pragma("unroll") for (int _i = 0; _i < 2; ++_i) { \
        if (GATHER) { v0[_i] = S.gather(u, RR[_i]) + (unsigned)CC[_i] * 2u; v1[_i] = S.gather(u, HALF + RR[_i]) + (unsigned)CC[_i] * 2u; } \
        else { v0[_i] = (unsigned)(RR[_i] * lda + CC[_i]) * 2u; v1[_i] = (unsigned)((HALF + RR[_i]) * lda + CC[_i]) * 2u; } } } while (0)
    const int sc_w8 = 0x79797979;
    Unit cur, nxt; int ui = 0;
    if (!S.next(0, cur)) return;
    PG8_SETV(cv0, cv1, cur);
    f32x4 acc[2][2][4][2];
#pragma unroll
    for (int a = 0; a < 2; ++a)
#pragma unroll
        for (int b = 0; b < 2; ++b)
#pragma unroll
            for (int m = 0; m < 4; ++m)
#pragma unroll
                for (int n = 0; n < 2; ++n) acc[a][b][m][n] = (f32x4){0.f, 0.f, 0.f, 0.f};
    bf16x8 At[4][2], B0[2][2], B1[2][2];
    const char* cA = cur.A; const char* cB = cur.B;
    PG8_STAGE(PG8_SB(0, 0), cB, voffB); PG8_STAGE(PG8_SB(0, 1), cB + hstepB, voffB); PG8_STAGE(PG8_SA(0, 0), cA, cv0); PG8_STAGE(PG8_SA(0, 1), cA, cv1);
    if (wr == 1) PG8_BAR;
    PG8_WAIT_V(2); PG8_BAR;
    PG8_STAGE(PG8_SB(1, 0), cB + kstep, voffB); PG8_STAGE(PG8_SA(1, 0), cA + kstep, cv0); PG8_STAGE(PG8_SB(1, 1), cB + hstepB + kstep, voffB);
    PG8_WAIT_V(6); PG8_BAR;
    for (;;) {
        const bool has_next = S.next(ui + 1, nxt);
        const char* nA = has_next ? nxt.A : cA; const char* nB = has_next ? nxt.B : cB;
        if (GATHER) { if (has_next) { PG8_SETV(nv0, nv1, nxt); } else {
#pragma unroll
            for (int i = 0; i < 2; ++i) { nv0[i] = cv0[i]; nv1[i] = cv1[i]; } } }
#pragma nounroll
        for (int t = 0; t < nt; t += 2) {
            const bool last = (t == nt - 2);
            const char* a1 = cA + (size_t)(t + 1) * kstep;
            const char* a2 = last ? nA : cA + (size_t)(t + 2) * kstep; const char* b2 = last ? nB : cB + (size_t)(t + 2) * kstep;
            const char* a3 = a2 + kstep; const char* b3 = b2 + kstep;
            unsigned s0[2], s1[2];
#pragma unroll
            for (int i = 0; i < 2; ++i) { s0[i] = (GATHER && last) ? nv0[i] : cv0[i]; s1[i] = (GATHER && last) ? nv1[i] : cv1[i]; }
            PG8_LDB(B0, 0, 0); PG8_LDB(B1, 0, 1); PG8_SCHED; PG8_LDA(At, 0, 0); PG8_STAGE(PG8_SA(1, 1), a1, cv1);
            PG8_WAIT_V(8); PG8_WAIT_L(0); PG8_BAR; PG8_MMA(0, 0, At, B0); PG8_MMA(0, 1, At, B1); PG8_BAR; PG8_SCHED;
            PG8_LDA(At, 0, 1); PG8_STAGE(PG8_SB(0, 0), b2, voffB); PG8_STAGE(PG8_SB(0, 1), b2 + hstepB, voffB); PG8_STAGE(PG8_SA(0, 0), a2, s0);
            PG8_WAIT_V(8); PG8_WAIT_L(0); PG8_BAR; PG8_MMA(1, 0, At, B0); PG8_MMA(1, 1, At, B1); PG8_BAR; PG8_SCHED;
            PG8_LDB(B0, 1, 0); PG8_LDB(B1, 1, 1); PG8_SCHED; PG8_LDA(At, 1, 0); PG8_STAGE(PG8_SA(0, 1), a2, s1);
            PG8_WAIT_V(8); PG8_WAIT_L(0); PG8_BAR; PG8_MMA(0, 0, At, B0); PG8_MMA(0, 1, At, B1); PG8_BAR; PG8_SCHED;
            PG8_LDA(At, 1, 1); PG8_STAGE(PG8_SB(1, 0), b3, voffB); PG8_STAGE(PG8_SB(1, 1), b3 + hstepB, voffB); PG8_STAGE(PG8_SA(1, 0), a3, s0);
            PG8_WAIT_V(8); PG8_WAIT_L(0); PG8_BAR; PG8_MMA(1, 0, At, B0); PG8_MMA(1, 1, At, B1); PG8_BAR; PG8_SCHED;
        }
        if (wr == 0) PG8_BAR;
        if (F8) asm volatile("s_nop 15\n\ts_nop 7" ::: "memory");
        E(acc, cur, ui, wr, wc, fr, fq);
        if (!has_next) break;
#pragma unroll
        for (int a = 0; a < 2; ++a)
#pragma unroll
            for (int b = 0; b < 2; ++b)
#pragma unroll
                for (int m = 0; m < 4; ++m)
#pragma unroll
                    for (int n = 0; n < 2; ++n) acc[a][b][m][n] = (f32x4){0.f, 0.f, 0.f, 0.f};
        cur = nxt; cA = nA; cB = nB; ++ui;
        if (GATHER) {
#pragma unroll
            for (int i = 0; i < 2; ++i) { cv0[i] = nv0[i]; cv1[i] = nv1[i]; } }
        if (wr == 1) PG8_BAR;
    }
    PG8_WAIT_V(0);
    PG8_BAR;
#undef PG8_SA
#undef PG8_SB
#undef PG8_STAGE
#undef PG8_LDA
#undef PG8_LDB
#undef PG8_MMA
#undef PG8_WAIT_V
#undef PG8_WAIT_L
#undef PG8_BAR
#undef PG8_SCHED
#undef PG8_SETV
}

DI void st4(bf16_t* p, f32x4 v) { u32x2 w; w.x = cvtpk(v[0], v[1]); w.y = cvtpk(v[2], v[3]); *(u32x2*)p = w; }
DI void st8(bf16_t* p, f32x4 a, f32x4 b) { u32x4 w; w.x = cvtpk(a[0], a[1]); w.y = cvtpk(a[2], a[3]); w.z = cvtpk(b[0], b[1]); w.w = cvtpk(b[2], b[3]); *(u32x4*)p = w; }

DI unsigned pk_fp8x4(f32x4 v) { int w = __builtin_amdgcn_cvt_pk_fp8_f32(v[0], v[1], 0, false); w = __builtin_amdgcn_cvt_pk_fp8_f32(v[2], v[3], w, true); return (unsigned)w; }
DI unsigned vt8_keyoff(int kap) { const int a = kap >> 5, c = kap & 31, h = (c >> 2) & 1, i = (c & 3) | ((c >> 3) << 2); return (unsigned)((h * 2 + a) * 512 + i); }
DI void st_fp8x4_strided(unsigned char* p, f32x4 v) {
    int w = __builtin_amdgcn_cvt_pk_fp8_f32(v[0], v[1], 0, false); w = __builtin_amdgcn_cvt_pk_fp8_f32(v[2], v[3], w, true);
    p[0] = (unsigned char)(w & 0xff); p[16] = (unsigned char)((w >> 8) & 0xff); p[32] = (unsigned char)((w >> 16) & 0xff); p[48] = (unsigned char)((unsigned)w >> 24);
}
struct EpiPlain {
    static constexpr bool PERM = true;
    bf16_t* O; int ldc;
    DI void operator()(const f32x4 (&acc)[2][2][4][2], const Unit& u, int ui, int wr, int wc, int fr, int fq) const {
        const int row0 = u.pm * BM + wr * 64 + fr, col0 = u.pn * BM + wc * 32 + 8 * fq;
#pragma unroll
        for (int ai = 0; ai < 2; ++ai)
#pragma unroll
            for (int m = 0; m < 4; ++m) { bf16_t* rowp = O + (size_t)(row0 + ai * HALF + m * 16) * ldc + col0;
#pragma unroll
                for (int bj = 0; bj < 2; ++bj) st8(rowp + bj * HALF, acc[ai][bj][m][0], acc[ai][bj][m][1]); }
    }
};
struct EpiGU {
    static constexpr bool PERM = true;
    unsigned char* O;
    DI static f32x4 silu_mul(f32x4 g, f32x4 u) { f32x4 r;
#pragma unroll
        for (int e = 0; e < 4; ++e) r[e] = g[e] * fast_rcp(1.f + fast_exp2(-g[e] * LOG2E)) * u[e];
        return r; }
    DI void operator()(const f32x4 (&acc)[2][2][4][2], const Unit& u, int ui, int wr, int wc, int fr, int fq) const {
        const int row0 = u.pm * BM + wr * 64 + fr, col0 = u.pn * HALF + wc * 32 + 8 * fq;
#pragma unroll
        for (int ai = 0; ai < 2; ++ai)
#pragma unroll
            for (int m = 0; m < 4; ++m) { unsigned char* rowp = O + (size_t)(row0 + ai * HALF + m * 16) * DEXP + col0;
                u32x2 w; w.x = pk_fp8x4(silu_mul(acc[ai][0][m][0], acc[ai][1][m][0])); w.y = pk_fp8x4(silu_mul(acc[ai][0][m][1], acc[ai][1][m][1])); *(u32x2*)rowp = w; }
    }
};
template <int LAYER> struct EpiInProj {
    static constexpr bool PERM = false;
    unsigned char* ws;
    DI void operator()(const f32x4 (&acc)[2][2][4][2], const Unit& u, int ui, int wr, int wc, int fr_in, int fq) const {
        int fr = fr_in; asm volatile("" : "+v"(fr));
        bf16_t* const O = (bf16_t*)(ws + WS_QKV); const float* const r64c = (const float*)(ws + WS_ROPE); const float* const r64s = r64c + 4096; const float* const r32c = r64s + 4096; const float* const r32s = r32c + 2048;
        unsigned char* const vt8 = ws + WS_VT8D; unsigned char* const q8d = ws + WS_Q8D; unsigned char* const k8d = ws + WS_K8D; unsigned char* const k8r = ws + WS_K8R;
        const int bidx = u.pm / 65; const bool ctx = (u.pm - bidx * 65) == 0;
        const float C2 = 0.125f * LOG2E;
#pragma unroll
        for (int bj = 0; bj < 2; ++bj) {
            const int g = 2 * u.pn + bj;
            bool rope64, scale, rope32 = false, skip = false;
            if (LAYER == 0) { rope64 = !ctx && g <= 4; scale = (g <= 3) || (g >= 6 && g <= 9); }
            else { rope64 = !ctx && g <= 7; scale = g <= 3; rope32 = !ctx && g == 17 && wc == 0; skip = (g == 17 && wc != 0); }
            if (skip) continue;
            const int col0 = g * HALF + wc * 32 + 4 * fq;
#pragma unroll
            for (int ai = 0; ai < 2; ++ai)
#pragma unroll
                for (int m = 0; m < 4; ++m) {
                    const int row = u.pm * BM + ai * HALF + wr * 64 + m * 16 + fr;
                    const int s = row - (bidx * RB + CTXL);
                    f32x4 v0 = acc[ai][bj][m][0], v1 = acc[ai][bj][m][1];
                    if (rope64) { const int pos = (wc & 1) ? (s & 63) : (s >> 6);
                        const f32x4 c4 = *(const f32x4*)(r64c + pos * 16 + 4 * fq), s4 = *(const f32x4*)(r64s + pos * 16 + 4 * fq);
                        const f32x4 y0 = v0 * c4 - v1 * s4, y1 = v1 * c4 + v0 * s4; v0 = y0; v1 = y1; }
                    if (rope32) { const int pos = (fq >= 2) ? (s & 63) : (s >> 6);
                        const f32x4 c4 = *(const f32x4*)(r32c + pos * 8 + 4 * (fq & 1)), s4 = *(const f32x4*)(r32s + pos * 8 + 4 * (fq & 1));
                        const f32x4 y0 = v0 * c4 - v1 * s4, y1 = v1 * c4 + v0 * s4; v0 = y0; v1 = y1; }
                    if (scale) { v0 = v0 * C2; v1 = v1 * C2; }
                    if (LAYER == 0) {
                        const int hsel = wc >> 1, dim0 = (wc & 1) * 32 + 4 * fq;
                        const int rr = row - bidx * RB, kt = rr >> 6, kap = rr & 63;
                        if (g <= 3 || (g >= 6 && g <= 9)) {
                            const int head = (g <= 3) ? (2 * g + hsel) : (2 * (g - 6) + hsel);
                            unsigned char* p8 = ws + (g <= 3 ? WS_Q8A : WS_Q8B) + (size_t)row * 512 + head * 64 + dim0;
                            *(unsigned*)p8 = pk_fp8x4(v0 * 8.f); *(unsigned*)(p8 + 16) = pk_fp8x4(v1 * 8.f);
                        } else if (g == 4 || (g >= 10 && g <= 13)) {
                            const size_t img = (g == 4) ? ((size_t)(bidx * 2 + hsel) * 260 + kt) : ((size_t)(bidx * 8 + 2 * (g - 10) + hsel) * 260 + kt);
                            unsigned char* p8 = ws + (g == 4 ? WS_K8A : WS_K8B) + img * 4096 + ((wc & 1) * 2) * 1024 + kap * 16 + 4 * fq;
                            *(unsigned*)p8 = pk_fp8x4(v0); *(unsigned*)(p8 + 1024) = pk_fp8x4(v1);
                        } else {
                            const size_t img = (g == 5) ? ((size_t)(bidx * 2 + hsel) * 260 + kt) : ((size_t)(bidx * 8 + 2 * (g - 14) + hsel) * 260 + kt);
                            unsigned char* p8 = ws + (g == 5 ? WS_VT8A : WS_VT8B) + img * 4096 + (wc & 1) * 2048 + vt8_keyoff(kap) + (4 * fq) * 16;
                            st_fp8x4_strided(p8, v0); st_fp8x4_strided(p8 + 256, v1);
                        }
                        if (m & 1) asm volatile("" ::: "memory"); continue;
                    }
                    if (LAYER == 1 && g <= 3) {
                        unsigned char* p8 = q8d + (size_t)row * 512 + g * HALF + wc * 32 + 4 * fq;
                        *(unsigned*)p8 = pk_fp8x4(v0 * 8.f); *(unsigned*)(p8 + 16) = pk_fp8x4(v1 * 8.f);
                        if (m & 1) asm volatile("" ::: "memory"); continue;
                    }
                    if (LAYER == 1 && g >= 4 && g <= 7) {
                        const int rr = row - bidx * RB, kt = rr >> 6, kap = rr & 63;
                        unsigned char* p8 = k8d + ((size_t)(bidx * 4 + (g - 4)) * 260 + kt) * 8192 + (wc >> 1) * 4096 + ((wc & 1) * 2) * 1024 + kap * 16 + 4 * fq;
                        *(unsigned*)p8 = pk_fp8x4(v0); *(unsigned*)(p8 + 1024) = pk_fp8x4(v1);
                        if (m & 1) asm volatile("" ::: "memory"); continue;
                    }
                    if (LAYER == 1 && g == 17) {
                        const int rr = row - bidx * RB, kt = rr >> 6, kap = rr & 63;
                        unsigned char* p8 = k8r + ((size_t)bidx * 260 + kt) * 2048 + kap * 16 + 4 * fq;
                        *(unsigned*)p8 = pk_fp8x4(v0); *(unsigned*)(p8 + 1024) = pk_fp8x4(v1);
                        if (m & 1) asm volatile("" ::: "memory"); continue;
                    }
                    if (LAYER == 1 && g >= 8 && g <= 11) {
                        const int rr = row - bidx * RB, kt = rr >> 6;
                        unsigned char* p8 = vt8 + ((size_t)(bidx * 4 + (g - 8)) * 260 + kt) * 8192 + wc * 2048 + vt8_keyoff(rr & 63) + (4 * fq) * 16;
                        st_fp8x4_strided(p8, v0); st_fp8x4_strided(p8 + 256, v1);
                        if (m & 1) asm volatile("" ::: "memory"); continue;
                    }
                    bf16_t* p = O + (size_t)row * NQKV + col0;
                    st4(p, v0); st4(p + 16, v1);
                    if (m & 1) asm volatile("" ::: "memory");
                }
        }
    }
};

struct EpiUKV {
    static constexpr bool PERM = true;
    unsigned char* k8; const LAS float* rs; unsigned char* vt8;
    DI void operator()(const f32x4 (&acc)[2][2][4][2], const Unit& u, int ui, int wr, int wc, int fr_in, int fq) const {
        int fr = fr_in;
        asm volatile("" : "+v"(fr));
        const int lr0 = wr * 64 + fr, bidx = u.pm / 65;
#pragma unroll
        for (int ai = 0; ai < 2; ++ai)
#pragma unroll
            for (int m = 0; m < 4; ++m) { const int lr = lr0 + ai * HALF + m * 16; const float s = rs[ui * 256 + lr]; const int row = u.pm * BM + lr;
                if (u.pn < 2) { const int rr = row - bidx * RB, kt = rr >> 6, kap = rr & 63;
#pragma unroll
                    for (int bj = 0; bj < 2; ++bj) { const int col = u.pn * BM + bj * HALF + wc * 32 + 8 * fq, head = col >> 6, dim = col & 63;
                        unsigned char* p = k8 + ((size_t)(bidx * 8 + head) * 260 + kt) * 4096 + (dim >> 4) * 1024 + kap * 16 + (dim & 15);
                        u32x2 w; w.x = pk_fp8x4(acc[ai][bj][m][0] * s); w.y = pk_fp8x4(acc[ai][bj][m][1] * s); *(u32x2*)p = w; }
                } else { const int rr = row - bidx * RB, kt = rr >> 6;
#pragma unroll
                    for (int bj = 0; bj < 2; ++bj) { const int col = (u.pn - 2) * BM + bj * HALF + wc * 32 + 8 * fq, head = col >> 6, d = col & 63;
                        unsigned char* p = vt8 + ((size_t)(bidx * 8 + head) * 260 + kt) * 4096 + (d >> 5) * 2048 + vt8_keyoff(rr & 63) + (d & 31) * 16;
                        st_fp8x4_strided(p, acc[ai][bj][m][0] * s); st_fp8x4_strided(p + 64, acc[ai][bj][m][1] * s); } }
            }
    }
};
struct EpiUQ {
    static constexpr bool PERM = false;
    unsigned char* q8; const LAS float* rs; const float* r32c; const float* r32s;
    DI void operator()(const f32x4 (&acc)[2][2][4][2], const Unit& u, int ui, int wr, int wc, int fr, int fq) const {
        const int bidx = u.pm / 65;
        const float C2 = 0.10206207261596577f * LOG2E * 8.f;
#pragma unroll
        for (int bj = 0; bj < 2; ++bj) {
            int off;
            if (u.pn < 2) { const int col = u.pn * BM + bj * HALF + wc * 32 + 4 * fq; off = (col >> 6) * 96 + (col & 63); }
            else off = (bj * 4 + wc) * 96 + 64 + 4 * fq;
#pragma unroll
            for (int ai = 0; ai < 2; ++ai)
#pragma unroll
                for (int m = 0; m < 4; ++m) {
                    const int lr = ai * HALF + wr * 64 + m * 16 + fr, row = u.pm * BM + lr;
                    const int s = row - (bidx * RB + CTXL);
                    const float sc = rs[ui * 256 + lr] * C2;
                    f32x4 v0 = acc[ai][bj][m][0] * sc, v1 = acc[ai][bj][m][1] * sc;
                    if (u.pn == 2) { const int pos = (fq >= 2) ? (s & 63) : (s >> 6);
                        const f32x4 c4 = *(const f32x4*)(r32c + pos * 8 + 4 * (fq & 1)), s4 = *(const f32x4*)(r32s + pos * 8 + 4 * (fq & 1));
                        const f32x4 y0 = v0 * c4 - v1 * s4, y1 = v1 * c4 + v0 * s4; v0 = y0; v1 = y1; }
                    unsigned char* p = q8 + (size_t)row * 768 + off;
                    *(unsigned*)p = pk_fp8x4(v0); *(unsigned*)(p + 16) = pk_fp8x4(v1);
                }
        }
    }
};
}

namespace att {
constexpr float THR = 8.f;
struct P {
    const unsigned char* q8; int qpitch;
    const unsigned char* k8; const unsigned char* k8r;
    const unsigned char* v8;
    unsigned char* o; int opitch;
    int nt, t_lo, kind, s0;
    float sink2, lam; const float* subln;
};
DI int crow(int r, int hi) { return (r & 3) + 8 * (r >> 2) + 4 * hi; }
DI float xsum32(float v) { auto rr = __builtin_amdgcn_permlane32_swap(__float_as_uint(v), __float_as_uint(v), false, false); return __uint_as_float(rr[0]) + __uint_as_float(rr[1]); }
DI int ximax32(int v) { auto rr = __builtin_amdgcn_permlane32_swap((unsigned)v, (unsigned)v, false, false); const int a = (int)rr[0], b = (int)rr[1]; return a > b ? a : b; }
DI float xmax32(float v) { auto rr = __builtin_amdgcn_permlane32_swap(__float_as_uint(v), __float_as_uint(v), false, false); float r; asm("v_max_f32 %0, %1, %2" : "=v"(r) : "v"(rr[0]), "v"(rr[1])); return r; }
#define ATT_WAITBAR() asm volatile("s_waitcnt vmcnt(0) lgkmcnt(0)\n\ts_barrier" ::: "memory")

DI void glds16s(unsigned voff, const void* sbase, unsigned lds_dst) { unsigned keep;
    asm volatile("s_mov_b32 %0, m0\n\ts_mov_b32 m0, %3\n\ts_nop 0\n\tglobal_load_lds_dwordx4 %1, %2\n\ts_mov_b32 m0, %0" : "=&s"(keep) : "v"(voff), "s"(sbase), "s"(lds_dst) : "memory"); }
#define ATT_WAITN_BAR(N) asm volatile("s_waitcnt vmcnt(" #N ") lgkmcnt(0)\n\ts_barrier" ::: "memory")
typedef int v8i_t __attribute__((ext_vector_type(8)));
DI f32x16 mfma_f8(v8i_t a, v8i_t b, f32x16 c) { return __builtin_amdgcn_mfma_scale_f32_32x32x64_f8f6f4(a, b, c, 0, 0, 0, 0x7f7f7f7f, 0, 0x7f7f7f7f); }
DI f32x16 mfma_f8s(v8i_t a, v8i_t b, f32x16 c, int sb) { return __builtin_amdgcn_mfma_scale_f32_32x32x64_f8f6f4(a, b, c, 0, 0, 0, 0x7f7f7f7f, 0, sb); }
typedef float f32x4v __attribute__((ext_vector_type(4)));
DI f32x4v mfma_f8s16(v8i_t a, v8i_t b, f32x4v c, int sb) { return __builtin_amdgcn_mfma_scale_f32_16x16x128_f8f6f4(a, b, c, 0, 0, 0, 0x7f7f7f7f, 0, sb); }
constexpr float F8_OFF = 4.f;
DI f32x16 mfma_f8q(v8i_t a, v8i_t b, f32x16 c) { return __builtin_amdgcn_mfma_scale_f32_32x32x64_f8f6f4(a, b, c, 0, 0, 0, 0x7f7f7f7f, 0, 0x7c7c7c7c); }
template <int MODE> DI void attn_unit_f8q(const P& p, LAS unsigned char* lds) {
    constexpr int DV = MODE == 2 ? 128 : 64;
    constexpr int NKC = MODE == 1 ? 6 : 8;
    constexpr int KSLOT = NKC * 1024, VSLOT = DV * 64, VRING = 4 * KSLOT, NDB = DV / 32;
    constexpr int NQK = MODE == 1 ? 4 : 2;
    const int tid = threadIdx.x, lane = tid & 63, r32 = lane & 31, hi = lane >> 5; const int wid = __builtin_amdgcn_readfirstlane(tid >> 6);
    const int sub = (MODE == 2) ? (wid >> 2) : 0;
    const int qrow = (MODE == 2) ? (32 * (wid & 3) + r32) : (32 * wid + r32);
    const int nt = p.nt;
    const unsigned ldsb = (unsigned)(size_t)lds;
    v8i_t qf[MODE == 1 ? 2 : 1];
    { const unsigned char* qp = p.q8 + (size_t)qrow * p.qpitch + (MODE == 2 ? sub * 64 : 0);
      const u32x4 a0 = *(const u32x4*)(qp + 32 * hi), a1 = *(const u32x4*)(qp + 32 * hi + 16);
      qf[0] = (v8i_t){(int)a0[0], (int)a0[1], (int)a0[2], (int)a0[3], (int)a1[0], (int)a1[1], (int)a1[2], (int)a1[3]};
      if (MODE == 1) { u32x4 b0 = *(const u32x4*)(qp + 64), b1 = *(const u32x4*)(qp + 80);
          if (hi) { b0 = (u32x4){0u, 0u, 0u, 0u}; b1 = b0; }
          qf[MODE == 1 ? 1 : 0] = (v8i_t){(int)b0[0], (int)b0[1], (int)b0[2], (int)b0[3], (int)b1[0], (int)b1[1], (int)b1[2], (int)b1[3]}; } }
    const int kpc = (MODE == 1) ? (wid < 6 ? wid : wid - 2) : wid;
    const int vpc = (MODE == 1) ? (wid & 3) : wid;
    const unsigned koff = (unsigned)(((MODE == 1 && kpc >= 4) ? (kpc - 4) : kpc) * 1024 + lane * 16);
    const unsigned voff = (unsigned)(vpc * 1024 + lane * 16);
    const unsigned char* kbase = (MODE == 1 && kpc >= 4) ? p.k8r : p.k8;
    const size_t kstep = (MODE == 1) ? ((kpc >= 4) ? 2048 : 4096) : 8192;
#define AQ_ISSUE_K(t) do { const int t_ = (t); if (t_ < nt) { const unsigned sb_ = ldsb + (unsigned)((t_ & 3) * KSLOT); \
        glds16s(koff, kbase + (size_t)t_ * kstep, (unsigned)__builtin_amdgcn_readfirstlane(sb_ + kpc * 1024)); } } while (0)
#define AQ_ISSUE_V(t) do { const int t_ = (t); if (t_ < nt) { const unsigned sb_ = ldsb + (unsigned)(VRING + ((t_ + 3) & 7) * VSLOT); \
        glds16s(voff, p.v8 + (size_t)t_ * VSLOT, (unsigned)__builtin_amdgcn_readfirstlane(sb_ + vpc * 1024)); } } while (0)
    float m = 0.f, l = 0.f;
    if (wid >= 4) __builtin_amdgcn_s_setprio(1);
    f32x16 o[NDB], negm, sa0, sa1, sb0, sb1;
#pragma unroll
    for (int db = 0; db < NDB; ++db)
#pragma unroll
        for (int i = 0; i < 16; ++i) o[db][i] = 0.f;
#pragma unroll
    for (int i = 0; i < 16; ++i) negm[i] = 0.f;
    const int vo = hi * 1024 + r32 * 16;
    const int ko_n = ((MODE == 2 ? sub * 4 : 0) + 2 * hi) * 1024 + r32 * 16;
    const int ko_r = 4 * 1024 + r32 * 16;
    u32x4 kfl[MODE == 1 ? 2 : 1], kfh[MODE == 1 ? 2 : 1], vfl[MODE == 1 ? 2 : 1], vfh[MODE == 1 ? 2 : 1]; v8i_t pfa, pfb;
    f32x4v ol = (f32x4v){0.f, 0.f, 0.f, 0.f};
    const int onesw = ((lane & 15) == ((lane >> 4) & 1)) ? 0x38383838 : 0;
    const v8i_t ones_fr = (v8i_t){onesw, onesw, onesw, onesw, onesw, onesw, onesw, onesw};
#define AQ_SB() __builtin_amdgcn_sched_barrier(0)
#define AQ_LDKF(s_, j, Ks_) do { const int o_ = ((MODE == 1 && ((j) >> 1)) ? ko_r : ko_n) + ((j) & 1) * 512; kfl[s_] = *(const LAS u32x4*)((Ks_) + o_); kfh[s_] = *(const LAS u32x4*)((Ks_) + o_ + 1024); } while (0)
#define AQ_LDVF(s_, db, Vs_) do { vfl[s_] = *(const LAS u32x4*)((Vs_) + (db) * 2048); vfh[s_] = *(const LAS u32x4*)((Vs_) + (db) * 2048 + 512); } while (0)
#define AQ_KF(s_) ((v8i_t){(int)kfl[s_][0], (int)kfl[s_][1], (int)kfl[s_][2], (int)kfl[s_][3], (int)kfh[s_][0], (int)kfh[s_][1], (int)kfh[s_][2], (int)kfh[s_][3]})
#define AQ_VF(s_) ((v8i_t){(int)vfl[s_][0], (int)vfl[s_][1], (int)vfl[s_][2], (int)vfl[s_][3], (int)vfh[s_][0], (int)vfh[s_][1], (int)vfh[s_][2], (int)vfh[s_][3]})
#define AQ_Q(j, s_, N0, N1) do { if ((j) & 1) { if ((j) < 2) N1 = mfma_f8q(AQ_KF(s_), qf[0], negm); else N1 = mfma_f8q(AQ_KF(s_), qf[MODE == 1 ? 1 : 0], N1); asm volatile("" : "+v"(N1)); } \
        else { if ((j) < 2) N0 = mfma_f8q(AQ_KF(s_), qf[0], negm); else N0 = mfma_f8q(AQ_KF(s_), qf[MODE == 1 ? 1 : 0], N0); asm volatile("" : "+v"(N0)); } } while (0)
#define AQ_P(db, s_, PF) do { o[db] = mfma_f8(AQ_VF(s_), PF, o[db]); asm volatile("" : "+v"(o[db])); } while (0)
#define AQ_PL(PF) do { ol = mfma_f8s16(ones_fr, PF, ol, 0x7f7f7f7f); asm volatile("" : "+v"(ol)); } while (0)
#define AQ_EXP8(g, C) do { const int b_ = 8 * ((g) & 1); _Pragma("unroll") for (int i_ = 0; i_ < 8; ++i_) { C[b_ + i_] = fast_exp2(C[b_ + i_]); asm volatile("" : "+v"(C[b_ + i_])); } } while (0)
#define AQ_CVT4(g, C, PF) do { const int b_ = 8 * ((g) & 1); \
        int w0_, w1_; asm volatile("" : "=v"(w0_), "=v"(w1_));                                                    \
        w0_ = __builtin_amdgcn_cvt_pk_fp8_f32(C[b_ + 0], C[b_ + 1], w0_, false); w0_ = __builtin_amdgcn_cvt_pk_fp8_f32(C[b_ + 2], C[b_ + 3], w0_, true); \
        w1_ = __builtin_amdgcn_cvt_pk_fp8_f32(C[b_ + 4], C[b_ + 5], w1_, false); w1_ = __builtin_amdgcn_cvt_pk_fp8_f32(C[b_ + 6], C[b_ + 7], w1_, true); \
        asm volatile("" : "+v"(w0_), "+v"(w1_)); PF[2 * (g)] = w0_; PF[2 * (g) + 1] = w1_; } while (0)
#define AQ_EXP(g, C0, C1) do { if ((g) < 2) AQ_EXP8(g, C0); else AQ_EXP8(g, C1); } while (0)
#define AQ_CVT(g, C0, C1, PF) do { if ((g) < 2) AQ_CVT4(g, C0, PF); else AQ_CVT4(g, C1, PF); } while (0)
#define AQ_IMAX(a_, b_) ((a_) > (b_) ? (a_) : (b_))
#define AQ_TILE(C0, C1, N0, N1, PFC, PFP, HASN, HASP, MID, tm, KSC, VSC) do { \
        const LAS unsigned char* Ks_ = ((KSC) >= 0) ? lds + (KSC) * KSLOT : lds + ks_next * KSLOT;                   \
        const LAS unsigned char* Vs_ = ((VSC) >= 0) ? vqb + (VSC) * VSLOT : lds + VRING + vs_prev * VSLOT + vo; \
        if (HASN) { AQ_LDKF(0, 0, Ks_); if (MODE == 1) AQ_LDKF(1, 1, Ks_); } if (HASP) { AQ_LDVF(0, 0, Vs_); if (MODE == 1) AQ_LDVF(1, 1, Vs_); } \
        AQ_EXP(0, C0, C1); AQ_SB(); \
        if (MODE == 1) { if (HASN) { AQ_Q(0, 0, N0, N1); AQ_Q(1, 1, N0, N1); AQ_LDKF(0, 2, Ks_); AQ_LDKF(1, 3, Ks_); } } \
        else { if (HASN) { AQ_Q(0, 0, N0, N1); AQ_LDKF(0, 1, Ks_); } if (HASP) { AQ_P(0, 0, PFP); AQ_LDVF(0, 1, Vs_); } } AQ_SB(); \
        AQ_CVT(0, C0, C1, PFC); AQ_EXP(1, C0, C1); AQ_SB(); \
        if (MODE == 1) { if (HASN) { AQ_Q(2, 0, N0, N1); AQ_Q(3, 1, N0, N1); } } \
        else { if (HASN) AQ_Q(1, 0, N0, N1); if (HASP) { AQ_P(1, 0, PFP); AQ_LDVF(0, 2, Vs_); } } AQ_SB(); \
        AQ_CVT(1, C0, C1, PFC); AQ_SB(); \
        if (MID) ATT_WAITN_BAR(0);                                         \
        if (HASP) { if (MODE == 1) { AQ_P(0, 0, PFP); AQ_P(1, 1, PFP); } else { AQ_P(2, 0, PFP); AQ_LDVF(0, 3, Vs_); AQ_PL(PFP); } } \
        if (MID) { AQ_ISSUE_K((tm) + 4); AQ_ISSUE_K((tm) + 5); AQ_ISSUE_V((tm) + 2); AQ_ISSUE_V((tm) + 3); } AQ_SB(); \
        AQ_EXP(2, C0, C1); AQ_CVT(2, C0, C1, PFC); AQ_EXP(3, C0, C1); AQ_SB(); \
        if (HASP) { if (MODE == 1) AQ_PL(PFP); else AQ_P(3, 0, PFP); } AQ_SB(); \
        AQ_CVT(3, C0, C1, PFC); \
        if (HASN) { int ri_ = AQ_IMAX(AQ_IMAX(__float_as_int(N0[0]), __float_as_int(N1[0])), __float_as_int(N0[1]));     \
            _Pragma("unroll") for (int i_ = 1; i_ < 15; ++i_) ri_ = AQ_IMAX(AQ_IMAX(ri_, __float_as_int(N1[i_])), __float_as_int(N0[i_ + 1])); \
            ri_ = AQ_IMAX(ri_, __float_as_int(N1[15])); \
            if (__any(__int_as_float(ri_) > THR)) {                                                                                    \
                const float rm_ = __int_as_float(ximax32(ri_)); \
                { const LAS unsigned char* Vn_ = lds + VRING + ((vs_prev + 1) & 7) * VSLOT + vo;                    \
                  _Pragma("unroll") for (int db_ = 0; db_ < NDB; ++db_) { AQ_LDVF(0, db_, Vn_); AQ_P(db_, 0, PFC); } AQ_PL(PFC); \
                  _Pragma("unroll") for (int i_ = 0; i_ < 8; ++i_) PFC[i_] = 0; } \
                const float dl_ = fmaxf(rm_ - F8_OFF, 0.f); m += dl_; const float f_ = fast_exp2(-dl_); ol[0] *= __shfl(f_, lane & 15); ol[1] *= __shfl(f_, (lane & 15) + 16); \
                _Pragma("unroll") for (int i_ = 0; i_ < 16; ++i_) { N0[i_] -= dl_; N1[i_] -= dl_; negm[i_] = -m; } \
                _Pragma("unroll") for (int db_ = 0; db_ < NDB; ++db_) _Pragma("unroll") for (int i_ = 0; i_ < 16; ++i_) o[db_][i_] *= f_; } } \
        ks_next = (ks_next + 1) & 3; vs_prev = (vs_prev + 1) & 7; } while (0)
    AQ_ISSUE_K(0); AQ_ISSUE_K(1); AQ_ISSUE_K(2); AQ_ISSUE_V(0);
    ATT_WAITN_BAR(0);
    { const LAS unsigned char* Ks_ = lds;
#pragma unroll
      for (int j = 0; j < NQK; ++j) { AQ_LDKF(MODE == 1 ? (j & 1) : 0, j, Ks_); AQ_Q(j, MODE == 1 ? (j & 1) : 0, sa0, sa1); }
      float rm = fmaxf(sa0[0], sa1[0]);
#pragma unroll
      for (int i = 1; i < 16; ++i) rm = fmaxf(fmaxf(rm, sa0[i]), sa1[i]);
      rm = xmax32(rm) - F8_OFF; m = rm;
#pragma unroll
      for (int i = 0; i < 16; ++i) { sa0[i] -= rm; sa1[i] -= rm; negm[i] = -rm; } }
    const LAS unsigned char* vqb = lds;
    int ks_next = 1, vs_prev = 2;
    ATT_WAITN_BAR(0); AQ_ISSUE_K(3); AQ_ISSUE_K(4); AQ_ISSUE_V(1); AQ_ISSUE_V(2);
    AQ_TILE(sa0, sa1, sb0, sb1, pfa, pfb, true, false, false, 0, -1, -1); AQ_TILE(sb0, sb1, sa0, sa1, pfb, pfa, true, true, true, 1, -1, -1);
    int t = 2;
    for (; t + 4 <= nt - 2; t += 4) {
        vqb = lds + VRING + ((t + 2) & 7) * VSLOT + vo;
        AQ_TILE(sa0, sa1, sb0, sb1, pfa, pfb, true, true, false, 0, 3, 0); AQ_TILE(sb0, sb1, sa0, sa1, pfb, pfa, true, true, true, t + 1, 0, 1);
        AQ_TILE(sa0, sa1, sb0, sb1, pfa, pfb, true, true, false, 0, 1, 2); AQ_TILE(sb0, sb1, sa0, sa1, pfb, pfa, true, true, true, t + 3, 2, 3);
    }
    for (; t < nt - 2; t += 2) {
        AQ_TILE(sa0, sa1, sb0, sb1, pfa, pfb, true, true, false, 0, -1, -1); AQ_TILE(sb0, sb1, sa0, sa1, pfb, pfa, true, true, true, t + 1, -1, -1);
    }
    AQ_TILE(sa0, sa1, sb0, sb1, pfa, pfb, true, true, false, 0, -1, -1); AQ_TILE(sb0, sb1, sa0, sa1, pfb, pfa, false, true, true, nt - 1, -1, -1);
    { const LAS unsigned char* Vs_ = lds + VRING + vs_prev * VSLOT + vo;
      if (MODE == 1) { AQ_LDVF(0, 0, Vs_); AQ_LDVF(1, 1, Vs_); AQ_P(0, 0, pfb); AQ_P(1, 1, pfb); }
      else {
#pragma unroll
          for (int db = 0; db < NDB; ++db) { AQ_LDVF(0, db, Vs_); AQ_P(db, 0, pfb); } }
      AQ_PL(pfb); }
    { const float l0 = __shfl(ol[0], lane & 15), l1 = __shfl(ol[1], lane & 15); l = (lane & 16) ? l1 : l0; }
    const float inv = fast_rcp(l);
    if (MODE != 2) {
#pragma unroll
        for (int db = 0; db < NDB; ++db)
#pragma unroll
            for (int g = 0; g < 4; ++g) { const f32x4 v4 = (f32x4){o[db][4 * g], o[db][4 * g + 1], o[db][4 * g + 2], o[db][4 * g + 3]} * inv;
                *(unsigned*)(p.o + (size_t)qrow * p.opitch + 32 * db + 8 * g + 4 * hi) = pg8::pk_fp8x4(v4 * 32.f); }
    } else {
        LAS float* X = (LAS float*)lds;
        ATT_WAITBAR();
        if (sub == 1) {
#pragma unroll
            for (int db = 0; db < NDB; ++db)
#pragma unroll
                for (int i = 0; i < 16; ++i) X[((wid - 4) * 64 + db * 16 + i) * 64 + lane] = o[db][i] * inv;
        }
        ATT_WAITBAR();
        if (sub == 0) {
            float ss = 0.f;
#pragma unroll
            for (int db = 0; db < NDB; ++db)
#pragma unroll
                for (int i = 0; i < 16; ++i) { const float val = o[db][i] * inv - p.lam * X[(wid * 64 + db * 16 + i) * 64 + lane]; o[db][i] = val; ss += val * val; }
            ss = xsum32(ss);
            const float rstd = (1.0f - LAM_INIT) / sqrtf(ss * (1.0f / 128.0f) + 1e-6f);
#pragma unroll
            for (int db = 0; db < NDB; ++db)
#pragma unroll
                for (int g = 0; g < 4; ++g) { const int d = 32 * db + 8 * g + 4 * hi; const f32x4 w4 = *(const f32x4*)(p.subln + d);
                    const f32x4 v4 = (f32x4){o[db][4 * g], o[db][4 * g + 1], o[db][4 * g + 2], o[db][4 * g + 3]} * rstd * w4;
                    *(unsigned*)(p.o + (size_t)qrow * p.opitch + d) = pg8::pk_fp8x4(v4 * 32.f); }
        }
    }
    __builtin_amdgcn_s_setprio(0);
    ATT_WAITBAR();
#undef AQ_ISSUE_K
#undef AQ_ISSUE_V
#undef AQ_SB
#undef AQ_LDKF
#undef AQ_LDVF
#undef AQ_KF
#undef AQ_VF
#undef AQ_Q
#undef AQ_P
#undef AQ_PL
#undef AQ_EXP8
#undef AQ_CVT4
#undef AQ_EXP
#undef AQ_CVT
#undef AQ_IMAX
#undef AQ_TILE
}

DI void attn_unit_f8l0(const P& p, LAS unsigned char* lds, const LAS float* rpbL) {
    constexpr int KSLOT = 4096, VSLOT = 4096, VRING = 3 * KSLOT, NDB = 2;
    const int tid = threadIdx.x, lane = tid & 63, r32 = lane & 31, hi = lane >> 5; const int wid = __builtin_amdgcn_readfirstlane(tid >> 6);
    const int qrow = 32 * wid + r32;
    const int nt = p.nt;
    const unsigned ldsb = (unsigned)(size_t)lds;
    v8i_t qf;
    { const unsigned char* qp = p.q8 + (size_t)qrow * p.qpitch;
      const u32x4 a0 = *(const u32x4*)(qp + 32 * hi), a1 = *(const u32x4*)(qp + 32 * hi + 16);
      qf = (v8i_t){(int)a0[0], (int)a0[1], (int)a0[2], (int)a0[3], (int)a1[0], (int)a1[1], (int)a1[2], (int)a1[3]}; }
    const bool isk = wid < 4; const int pc = wid & 3;
    const unsigned doff = (unsigned)(pc * 1024 + lane * 16);
    const unsigned char* dbase = isk ? p.k8 : p.v8;
#define L0_UT(t) (((t) >= 4) ? (p.t_lo + (t) - 4) : (t))
#define L0_ISSUE(t) do { const int tt_ = isk ? (t) + 3 : (t) + 2; if (tt_ >= 0 && tt_ < nt) { const unsigned sb_ = ldsb + (unsigned)((isk ? 0 : VRING) + (tt_ % 3) * 4096); \
        glds16s(doff, dbase + (size_t)L0_UT(tt_) * 4096, (unsigned)__builtin_amdgcn_readfirstlane(sb_ + pc * 1024)); } } while (0)
    float m = 0.f, l = 0.f;
    f32x16 o[NDB], negm, sa0, sa1, sb0, sb1, ol;
#pragma unroll
    for (int db = 0; db < NDB; ++db)
#pragma unroll
        for (int i = 0; i < 16; ++i) o[db][i] = 0.f;
#pragma unroll
    for (int i = 0; i < 16; ++i) { negm[i] = 0.f; ol[i] = 0.f; }
    const int onesw = (r32 == 0) ? 0x38383838 : 0;
    const v8i_t ones_fr = (v8i_t){onesw, onesw, onesw, onesw, onesw, onesw, onesw, onesw};
    const bool has_sink = (p.kind & 1) == 0;
    const int vo = hi * 1024 + r32 * 16;
    const int ko_n = (2 * hi) * 1024 + r32 * 16;
    u32x4 klo[2], khi[2]; v8i_t pf; u32x4 vlo[NDB], vhi[NDB];
#define L0_SB() __builtin_amdgcn_sched_barrier(0)
#define L0_LDK(j, Ks_) do { klo[j] = *(const LAS u32x4*)((Ks_) + ko_n + (j) * 512); khi[j] = *(const LAS u32x4*)((Ks_) + ko_n + (j) * 512 + 1024); } while (0)
#define L0_LDV(Vs_) do { _Pragma("unroll") for (int db_ = 0; db_ < NDB; ++db_) { vlo[db_] = *(const LAS u32x4*)((Vs_) + db_ * 2048); vhi[db_] = *(const LAS u32x4*)((Vs_) + db_ * 2048 + 512); } } while (0)
#define L0_KFR(j) ((v8i_t){(int)klo[j][0], (int)klo[j][1], (int)klo[j][2], (int)klo[j][3], (int)khi[j][0], (int)khi[j][1], (int)khi[j][2], (int)khi[j][3]})
#define L0_PV() do { _Pragma("unroll") for (int db_ = 0; db_ < NDB; ++db_) { \
        const v8i_t vfr_ = (v8i_t){(int)vlo[db_][0], (int)vlo[db_][1], (int)vlo[db_][2], (int)vlo[db_][3], (int)vhi[db_][0], (int)vhi[db_][1], (int)vhi[db_][2], (int)vhi[db_][3]}; \
        o[db_] = mfma_f8(vfr_, pf, o[db_]); } ol = mfma_f8(ones_fr, pf, ol); } while (0)
#define L0_VALU8(g, C) do { const int b_ = 8 * ((g) & 1); \
        _Pragma("unroll") for (int i_ = 0; i_ < 8; ++i_) { C[b_ + i_] = fast_exp2(C[b_ + i_]); } \
        int w0_, w1_; asm volatile("" : "=v"(w0_), "=v"(w1_));                                                    \
        w0_ = __builtin_amdgcn_cvt_pk_fp8_f32(C[b_ + 0], C[b_ + 1], w0_, false); w0_ = __builtin_amdgcn_cvt_pk_fp8_f32(C[b_ + 2], C[b_ + 3], w0_, true); \
        w1_ = __builtin_amdgcn_cvt_pk_fp8_f32(C[b_ + 4], C[b_ + 5], w1_, false); w1_ = __builtin_amdgcn_cvt_pk_fp8_f32(C[b_ + 6], C[b_ + 7], w1_, true); \
        asm volatile("" : "+v"(w0_), "+v"(w1_)); pf[2 * (g)] = w0_; pf[2 * (g) + 1] = w1_; } while (0)
#define L0_VALU(g, C0, C1) do { if ((g) < 2) L0_VALU8(g, C0); else L0_VALU8(g, C1); } while (0)
#define L0_CR(i_) (((i_) & 3) + 8 * ((i_) >> 2))
#define L0_MASK(tn, N0, N1) do { if ((tn) >= 4) { const int ut_ = L0_UT(tn); \
        if (p.kind == 0) { const int kb_ = (ut_ - 4) * 64 - (p.s0 + qrow) + 4 * hi + 128;                 \
            if (!__all(kb_ >= 0 && kb_ + 59 <= 256)) { \
            _Pragma("unroll") for (int i_ = 0; i_ < 16; ++i_) { if ((unsigned)(kb_ + L0_CR(i_)) > 256u) N0[i_] = -INFINITY; if ((unsigned)(kb_ + L0_CR(i_) + 32) > 256u) N1[i_] = -INFINITY; } } \
        } else if (p.kind == 1) { const int kr_ = ut_ - 4, r_ = (p.s0 >> 6) + (wid >> 1), qc_ = 32 * (wid & 1) + r32; int rs_ = r_ - 4; rs_ = rs_ < 0 ? 0 : (rs_ > 248 ? 248 : rs_); \
            const bool rowok_ = (kr_ >= rs_) && (kr_ < rs_ + 8); int cs_ = qc_ - 8; cs_ = cs_ < 0 ? 0 : (cs_ > 48 ? 48 : cs_); \
            int bri_ = kr_ - r_ + 7; bri_ = bri_ < 0 ? 0 : (bri_ > 14 ? 14 : bri_); \
            const LAS float* bp_ = rpbL + bri_ * 31 + (4 * hi - qc_ + 15);                                  \
            const int cb_ = rowok_ ? (4 * hi - cs_) : 4096;                                                     \
            _Pragma("unroll") for (int i_ = 0; i_ < 16; ++i_) { \
                const float b0_ = bp_[L0_CR(i_)], b1_ = bp_[L0_CR(i_) + 32]; \
                N0[i_] = ((unsigned)(cb_ + L0_CR(i_)) < 16u) ? N0[i_] + b0_ : -INFINITY; N1[i_] = ((unsigned)(cb_ + L0_CR(i_) + 32) < 16u) ? N1[i_] + b1_ : -INFINITY; } } } } while (0)
#define L0_TILE(t, C0, C1, N0, N1, HASN) do { \
        const LAS unsigned char* Ks_ = lds + ks_next * KSLOT; const LAS unsigned char* Vs_ = lds + VRING + vs_cur * VSLOT + vo; \
        if (HASN) L0_LDK(0, Ks_); L0_VALU(0, C0, C1); L0_SB(); \
        L0_VALU(1, C0, C1); if (HASN) { N0 = mfma_f8q(L0_KFR(0), qf, negm); asm volatile("" : "+v"(N0)); } L0_SB(); \
        if (HASN) L0_LDK(1, Ks_); L0_VALU(2, C0, C1); L0_SB(); \
        L0_LDV(Vs_); L0_VALU(3, C0, C1); if (HASN) { N1 = mfma_f8q(L0_KFR(1), qf, negm); asm volatile("" : "+v"(N1)); } L0_SB(); \
        L0_PV(); \
        if (HASN) { L0_MASK((t) + 1, N0, N1); float rm_ = fmaxf(N0[0], N1[0]); \
            _Pragma("unroll") for (int i_ = 1; i_ < 16; ++i_) rm_ = fmaxf(fmaxf(rm_, N0[i_]), N1[i_]); \
            rm_ = xmax32(rm_); \
            if (__any(rm_ > THR)) { const float dl_ = fmaxf(rm_ - F8_OFF, 0.f); m += dl_; const float f_ = fast_exp2(-dl_); ol[0] *= f_; \
                _Pragma("unroll") for (int i_ = 0; i_ < 16; ++i_) { N0[i_] -= dl_; N1[i_] -= dl_; negm[i_] = -m; } \
                _Pragma("unroll") for (int db_ = 0; db_ < NDB; ++db_) _Pragma("unroll") for (int i_ = 0; i_ < 16; ++i_) o[db_][i_] *= f_; } } \
        ks_next = (ks_next == 2) ? 0 : ks_next + 1; vs_cur = (vs_cur == 2) ? 0 : vs_cur + 1; } while (0)
#define L0_TOP(t) do { if ((t) + 2 < nt) ATT_WAITN_BAR(1); else ATT_WAITN_BAR(0); L0_ISSUE(t); } while (0)
    L0_ISSUE(-3);
    L0_ISSUE(-2);
    ATT_WAITBAR();
    L0_ISSUE(-1);
    { const LAS unsigned char* Ks_ = lds;
      L0_LDK(0, Ks_); L0_LDK(1, Ks_); sa0 = mfma_f8q(L0_KFR(0), qf, negm); sa1 = mfma_f8q(L0_KFR(1), qf, negm);
      float rm = fmaxf(sa0[0], sa1[0]);
#pragma unroll
      for (int i = 1; i < 16; ++i) rm = fmaxf(fmaxf(rm, sa0[i]), sa1[i]);
      rm = xmax32(rm); if (has_sink) rm = fmaxf(rm, p.sink2);
      rm -= F8_OFF; m = rm;
#pragma unroll
      for (int i = 0; i < 16; ++i) { sa0[i] -= rm; sa1[i] -= rm; negm[i] = -rm; }
      if (has_sink && hi == 0) ol[0] = fast_exp2(p.sink2 - m); }
    int ks_next = 1, vs_cur = 0;
    for (int t = 0; t < nt - 2; t += 2) {
        L0_TOP(t);     L0_TILE(t, sa0, sa1, sb0, sb1, true);
        L0_TOP(t + 1); L0_TILE(t + 1, sb0, sb1, sa0, sa1, true);
    }
    L0_TOP(nt - 2); L0_TILE(nt - 2, sa0, sa1, sb0, sb1, true);
    ATT_WAITN_BAR(0); L0_TILE(nt - 1, sb0, sb1, sa0, sa1, false);
    l = hi ? 0.f : ol[0];
    const float inv = fast_rcp(xsum32(l));
#pragma unroll
    for (int db = 0; db < NDB; ++db)
#pragma unroll
        for (int g = 0; g < 4; ++g) { const f32x4 v4 = (f32x4){o[db][4 * g], o[db][4 * g + 1], o[db][4 * g + 2], o[db][4 * g + 3]} * inv;
            *(unsigned*)(p.o + (size_t)qrow * p.opitch + 32 * db + 8 * g + 4 * hi) = pg8::pk_fp8x4(v4 * 32.f); }
    ATT_WAITBAR();
#undef L0_UT
#undef L0_ISSUE
#undef L0_SB
#undef L0_LDK
#undef L0_LDV
#undef L0_KFR
#undef L0_PV
#undef L0_VALU8
#undef L0_VALU
#undef L0_MASK
#undef L0_CR
#undef L0_TILE
#undef L0_TOP
}
}

struct Ctx {
    LAS unsigned char* lds; gu32* ctl; unsigned char* ws;
    int tid, lane, wave, vcu, G;
    const float* const __attribute__((address_space(4)))* inp;
    float* out;
};
DI const float* modp(const Ctx& F, int l, int which, int chunk) { return (const float*)(F.ws + WS_MOD) + ((size_t)(l * 3 + which) * 6 + chunk) * 1024; }

DI void ld_f32(const float* p, int lane, f32x4 (&v)[4]) {
#pragma unroll
    for (int j = 0; j < 4; ++j) v[j] = *(const f32x4*)(p + 4 * lane + 256 * j); }
DI void ld_bf16(const bf16_t* p, int lane, f32x4 (&v)[4]) {
#pragma unroll
    for (int j = 0; j < 4; ++j) { const u32x2 w = *(const u32x2*)(p + 4 * lane + 256 * j); v[j] = (f32x4){bf_lo(w.x), bf_hi(w.x), bf_lo(w.y), bf_hi(w.y)}; } }
DI void st_f32(float* p, int lane, const f32x4 (&v)[4]) {
#pragma unroll
    for (int j = 0; j < 4; ++j) *(f32x4*)(p + 4 * lane + 256 * j) = v[j]; }
DI void st_bf16(bf16_t* p, int lane, const f32x4 (&v)[4]) {
#pragma unroll
    for (int j = 0; j < 4; ++j) pg8::st4(p + 4 * lane + 256 * j, v[j]); }
DI void st_fp8row(unsigned char* p, int lane, const f32x4 (&v)[4]) {
#pragma unroll
    for (int j = 0; j < 4; ++j) *(unsigned*)(p + 4 * lane + 256 * j) = pg8::pk_fp8x4(v[j]); }
DI void ld_f32_nt(const float* p, int lane, f32x4 (&v)[4]) {
#pragma unroll
    for (int j = 0; j < 4; ++j) v[j] = __builtin_nontemporal_load((const f32x4*)(p + 4 * lane + 256 * j)); }
DI void ld_bf16_nt(const bf16_t* p, int lane, f32x4 (&v)[4]) {
#pragma unroll
    for (int j = 0; j < 4; ++j) { const u32x2 w = __builtin_nontemporal_load((const u32x2*)(p + 4 * lane + 256 * j)); v[j] = (f32x4){bf_lo(w.x), bf_hi(w.x), bf_lo(w.y), bf_hi(w.y)}; } }
DI void st_f32_nt(float* p, int lane, const f32x4 (&v)[4]) {
#pragma unroll
    for (int j = 0; j < 4; ++j) __builtin_nontemporal_store(v[j], (f32x4*)(p + 4 * lane + 256 * j)); }
DI void st_bf16_nt(bf16_t* p, int lane, const f32x4 (&v)[4]) {
#pragma unroll
    for (int j = 0; j < 4; ++j) { u32x2 w; w.x = cvtpk(v[j][0], v[j][1]); w.y = cvtpk(v[j][2], v[j][3]); __builtin_nontemporal_store(w, (u32x2*)(p + 4 * lane + 256 * j)); } }
DI void layer_norm_row(f32x4 (&v)[4], const float* g, const float* b, int lane) {
    float s = 0.f;
#pragma unroll
    for (int j = 0; j < 4; ++j) s += (v[j][0] + v[j][1]) + (v[j][2] + v[j][3]);
    const float mean = wave_sum(s) * (1.f / 1024.f); float s2 = 0.f;
#pragma unroll
    for (int j = 0; j < 4; ++j) { v[j] = v[j] - mean; s2 += (v[j][0] * v[j][0] + v[j][1] * v[j][1]) + (v[j][2] * v[j][2] + v[j][3] * v[j][3]); }
    const float rstd = 1.0f / sqrtf(wave_sum(s2) * (1.f / 1024.f) + 1e-5f);
    f32x4 gg[4], bb[4]; ld_f32(g, lane, gg); ld_f32(b, lane, bb);
#pragma unroll
    for (int j = 0; j < 4; ++j) v[j] = v[j] * rstd * gg[j] + bb[j];
}
DI void modulate_row(f32x4 (&h)[4], const f32x4 (&v)[4], const float* sc, const float* sh, int lane) {
    f32x4 a[4], b[4]; ld_f32(sc, lane, a); ld_f32(sh, lane, b);
#pragma unroll
    for (int j = 0; j < 4; ++j) h[j] = v[j] * (1.0f + a[j]) + b[j];
}

DI void conv_item(const float* W, int K, int Nsrc, bf16_t* WT, int Ndst, int kind, const float* gk, LAS float* scr, int item, int lane, bool f8 = false) {
    const int nblk = Ndst / 32, kb = item / nblk, nb = item % nblk, k0 = 64 * kb, n0 = 32 * nb;
    int srcb = n0; bool perm = false;
    if (kind == 1) { if (n0 < 512) srcb = 672 + n0; else if (n0 < 1024) srcb = 1184 + (n0 - 512); else if (n0 < 1536) srcb = 1696 + (n0 - 1024); else if (n0 < 1920) srcb = n0 - 1536;
                     else if (n0 < 2176) srcb = 384 + (n0 - 1920); else if (n0 == 2176) { srcb = 640; perm = true; } else srcb = -1; }
    else if (kind == 2) { if (n0 < 512) srcb = (n0 >> 6) * 96 + (n0 & 63); else { srcb = ((n0 - 512) >> 5) * 96 + 64; perm = true; } }
    else if (kind == 3) { if (n0 < 512) srcb = (n0 >> 6) * 128 + (n0 & 63); else srcb = ((n0 - 512) >> 6) * 128 + 64 + ((n0 - 512) & 63); }
    else if (kind == 4) { const int pn = n0 >> 8, w = n0 & 255; srcb = (w < 128) ? (128 * pn + w) : (512 + 128 * pn + (w - 128)); }
    const int nl = lane & 31; int sc = nl; if (perm) sc = (nl < 8) ? nl : (nl < 16 ? nl + 8 : (nl < 24 ? nl - 8 : nl));
    float vv[32];
#pragma unroll
    for (int i = 0; i < 32; ++i) { const int kk = 2 * i + (lane >> 5); vv[i] = (srcb >= 0) ? __builtin_nontemporal_load(W + (size_t)(k0 + kk) * Nsrc + srcb + sc) : 0.f; }
    if (gk) {
#pragma unroll
        for (int i = 0; i < 32; ++i) vv[i] *= gk[k0 + 2 * i + (lane >> 5)]; }
#pragma unroll
    for (int i = 0; i < 32; ++i) scr[(2 * i + (lane >> 5)) * 33 + nl] = vv[i];
    asm volatile("s_waitcnt lgkmcnt(0)" ::: "memory");
    const int c = lane & 7;
#pragma unroll
    for (int j = 0; j < 4; ++j) { const int n = (lane >> 3) + 8 * j; const LAS float* s = scr + (8 * c) * 33 + n;
        u32x4 o; o.x = cvtpk(s[0 * 33], s[1 * 33]); o.y = cvtpk(s[2 * 33], s[3 * 33]); o.z = cvtpk(s[4 * 33], s[5 * 33]); o.w = cvtpk(s[6 * 33], s[7 * 33]);
        if (f8) { u32x2 o8; o8.x = pg8::pk_fp8x4((f32x4){s[0 * 33], s[1 * 33], s[2 * 33], s[3 * 33]} * 64.f); o8.y = pg8::pk_fp8x4((f32x4){s[4 * 33], s[5 * 33], s[6 * 33], s[7 * 33]} * 64.f);
            *(u32x2*)((unsigned char*)WT + (size_t)(n0 + n) * K + k0 + 8 * c) = o8; }
        else __builtin_nontemporal_store(o, (u32x4*)(WT + (size_t)(n0 + n) * K + k0 + 8 * c)); }
    asm volatile("s_waitcnt lgkmcnt(0)" ::: "memory");
}

DI void phase_prologue(const Ctx& F) {
    LAS float* sl = (LAS float*)F.lds;
    LAS float* red = sl + 3072;
    for (int u = blockIdx.x; u < 193; u += F.G) {
        if (u < 192) {
            const int l = u / 96, n0 = (u % 96) * 64;
            for (int idx = F.tid; idx < 3072; idx += 512) { const int which = idx >> 10, k = idx & 1023; const float v = which < 2 ? F.inp[1][which * 1024 + k] : F.inp[3][k]; sl[idx] = v * fast_rcp(1.f + fast_exp2(-v * LOG2E)); }
            __syncthreads();
            float a0 = 0.f, a1 = 0.f, a2 = 0.f; const float* wp = F.inp[4] + ((size_t)l * 1024 + F.wave * 128) * 6144 + n0 + F.lane;
#pragma unroll 8
            for (int k = 0; k < 128; ++k) { const float w = __builtin_nontemporal_load(wp + (size_t)k * 6144); const int kk = F.wave * 128 + k; a0 += sl[kk] * w; a1 += sl[1024 + kk] * w; a2 += sl[2048 + kk] * w; }
            red[(F.wave * 3 + 0) * 64 + F.lane] = a0; red[(F.wave * 3 + 1) * 64 + F.lane] = a1; red[(F.wave * 3 + 2) * 64 + F.lane] = a2;
            __syncthreads();
            if (F.wave < 3) { float s = F.inp[5][l * 6144 + n0 + F.lane];
#pragma unroll
                for (int w = 0; w < 8; ++w) s += red[(w * 3 + F.wave) * 64 + F.lane];
                ((float*)(F.ws + WS_MOD))[(size_t)(l * 3 + F.wave) * 6144 + n0 + F.lane] = s; }
            __syncthreads();
        } else {
            float* r64c = (float*)(F.ws + WS_ROPE); float* r64s = r64c + 4096; float* r32c = r64s + 4096; float* r32s = r32c + 2048;
            for (int idx = F.tid; idx < 4096 + 2048; idx += 512) {
                const bool big = idx < 4096; const int id = big ? idx : idx - 4096; const int pos = big ? (id >> 4) : (id >> 3), i = big ? (id & 15) : (id & 7);
                const float inv = exp2f(-(float)i * (big ? (13.287712379549449f / 16.f) : (13.287712379549449f / 8.f)));
                const float ang = (float)pos * inv;
                const float kq = rintf(ang * 0.15915494309189535f);
                float r = fmaf(-kq, 6.2831854820251465f, ang); r = fmaf(-kq, -1.7484555314695172e-07f, r);
                const float cs = __cosf(r), sn = __sinf(r);
                if (big) { r64c[id] = cs; r64s[id] = sn; } else { r32c[id] = cs; r32s[id] = sn; }
            }
        }
    }
    __syncthreads();
    LAS float* scr = (LAS float*)(F.lds + F.wave * 8448);
    const int gw = F.vcu * 8 + F.wave, NGW = F.G * 8;
    constexpr int I_IN = 16 * 72, I_SQ = 16 * 32, I_UQ = 6 * 24, I_UKV = 4 * 32;
    constexpr int NITEMS = 2 * I_IN + 2 * I_SQ + I_UQ + I_UKV;
    for (int it = gw; it < NITEMS; it += NGW) {
        int r = it;
        if (r < I_IN) { conv_item(F.inp[8], 1024, 2304, (bf16_t*)(F.ws + WS_WAB_IN), 2304, 0, nullptr, scr, r, F.lane, true); continue; } r -= I_IN;
        if (r < I_IN) { conv_item(F.inp[12], 1024, 2208, (bf16_t*)(F.ws + WS_WCD_IN), 2304, 1, nullptr, scr, r, F.lane, true); continue; } r -= I_IN;
        if (r < I_SQ) { conv_item(F.inp[11], 1024, 1024, (bf16_t*)(F.ws + WS_WAB_OUT), 1024, 0, nullptr, scr, r, F.lane, true); continue; } r -= I_SQ;
        if (r < I_SQ) { conv_item(F.inp[19], 1024, 1024, (bf16_t*)(F.ws + WS_WCD_OUT), 1024, 0, nullptr, scr, r, F.lane, true); continue; } r -= I_SQ;
        if (r < I_UQ) { conv_item(F.inp[14], 384, 768, (bf16_t*)(F.ws + WS_WUQ), 768, 2, F.inp[13], scr, r, F.lane); continue; } r -= I_UQ;
        conv_item(F.inp[16], 256, 1024, (bf16_t*)(F.ws + WS_WUKV), 1024, 3, F.inp[15], scr, r, F.lane);
    }
}

DI void conv_moe_slice(const Ctx& F, int l, int step) {
    constexpr int I_GU = 16 * 32, I_DN = 8 * 32, PER_L = 32 * I_GU + 32 * I_DN;
    LAS float* scr = (LAS float*)(F.lds + F.wave * 8448);
    const int per_wg = (PER_L + F.G - 1) / F.G, per_step = (per_wg + 7) / 8;
    const int lo = (int)blockIdx.x * per_wg + step * per_step;
    int hi = lo + per_step; const int wg_hi = ((int)blockIdx.x + 1) * per_wg; hi = hi < wg_hi ? hi : wg_hi; hi = hi < PER_L ? hi : PER_L;
    for (int r = lo + F.wave; r < hi; r += 8) {
        if (r < 32 * I_GU) { const int mtx = l * 32 + r / I_GU; conv_item(F.inp[24] + (size_t)mtx * 1024 * 1024, 1024, 1024, (bf16_t*)(F.ws + WS_WGU + (size_t)mtx * 1024 * 1024), 1024, 4, nullptr, scr, r % I_GU, F.lane, true); }
        else { const int r2 = r - 32 * I_GU; const int mtx = l * 32 + r2 / I_DN; conv_item(F.inp[25] + (size_t)mtx * 512 * 1024, 512, 1024, (bf16_t*)(F.ws + WS_WDN + (size_t)mtx * 1024 * 512), 1024, 0, nullptr, scr, r2 % I_DN, F.lane, true); }
    }
}

DI const float* src_row_l0(const Ctx& F, int urow, int& which) {
    const int b = urow / RB, rr = urow - b * RB;
    if (rr < CTXL) { which = 2; return F.inp[2] + ((size_t)b * CTXL + rr) * 1024; }
    which = b; return F.inp[0] + ((size_t)b * SEQ + (rr - CTXL)) * 1024;
}

DI void phase_modulate0(const Ctx& F) {
    bf16_t* H = (bf16_t*)(F.ws + WS_H);
    for (int urow = F.vcu * 8 + F.wave; urow < MU; urow += F.G * 8) {
        int which; const float* src = src_row_l0(F, urow, which);
        f32x4 v[4], h[4]; ld_f32_nt(src, F.lane, v);
        modulate_row(h, v, modp(F, 0, which, 1), modp(F, 0, which, 0), F.lane);
        st_fp8row((unsigned char*)H + (size_t)urow * 1024, F.lane, h);
    }
}

constexpr int PASS_ROWS = 136;
template <int CTRL> DI float dpp_ror_add(float v) { return v + __builtin_bit_cast(float, __builtin_amdgcn_update_dpp(0, __builtin_bit_cast(int, v), CTRL, 0xf, 0xf, false)); }
DI float reduce4(float a, float b, float c, float d) {
    auto r1 = __builtin_amdgcn_permlane32_swap(__float_as_uint(a), __float_as_uint(b), false, false);
    auto r2 = __builtin_amdgcn_permlane32_swap(__float_as_uint(c), __float_as_uint(d), false, false);
    const float z1 = __uint_as_float(r1[0]) + __uint_as_float(r1[1]);
    const float z2 = __uint_as_float(r2[0]) + __uint_as_float(r2[1]);
    auto r3 = __builtin_amdgcn_permlane16_swap(__float_as_uint(z1), __float_as_uint(z2), false, false);
    float w = __uint_as_float(r3[0]) + __uint_as_float(r3[1]);
    w = dpp_ror_add<0x128>(w); w = dpp_ror_add<0x124>(w); w = dpp_ror_add<0x122>(w); w = dpp_ror_add<0x121>(w);
    return w;
}
DI void phase_ln1_router(const Ctx& F, const int l) {
    constexpr int RG = 2;
    constexpr int WRS = 1028;
    LAS float* Wr = (LAS float*)F.lds;
    LAS unsigned* rinfo = (LAS unsigned*)(F.lds + 148480);
    LAS int* lcnt = (LAS int*)(F.lds + 148480 + PASS_ROWS * 32);
    LAS int* lbase = lcnt + 32;
    LAS float* lgs = (LAS float*)(F.lds + 148480 + PASS_ROWS * 32 + 256) + F.wave * (RG * 36);
    const float* wg = F.inp[20] + (size_t)l * 4096; const float* we = F.inp[22] + (size_t)l * 32768;
    for (int idx = F.tid; idx < 4096; idx += 512) Wr[(idx & 3) * WRS + (idx >> 2)] = wg[idx];
    for (int idx = F.tid; idx < 32768; idx += 512) Wr[(4 + (idx & 31)) * WRS + (idx >> 5)] = we[idx];
    if (F.tid < 32) lcnt[F.tid] = 0;
    __syncthreads();
    const int nrows = (l == 0) ? MU : NB * SEQ;
    const int rpw = (nrows + F.G - 1) / F.G, r_begin = (int)blockIdx.x * rpw, r_end = (r_begin + rpw < nrows) ? r_begin + rpw : nrows;
    const bf16_t* YP = (const bf16_t*)(F.ws + WS_YP); bf16_t* XA = (bf16_t*)(F.ws + WS_XA); const bf16_t* XB = (const bf16_t*)(F.ws + WS_XB); bf16_t* H = (bf16_t*)(F.ws + WS_H);
    int* list = (int*)(F.ws + WS_LIST); unsigned* tokinfo = (unsigned*)(F.ws + WS_TOKINFO); unsigned* gcnt = (unsigned*)(F.ctl + CW_CNT + l * 32);
    const float* lng = F.inp[6] + (size_t)(l * 2 + 0) * 1024; const float* lnb = F.inp[7] + (size_t)(l * 2 + 0) * 1024;
    const float* bgp = F.inp[21] + l * 4; const float* bep = F.inp[23] + l * 32;
    for (int pb = r_begin; pb < r_end; pb += PASS_ROWS) {
        const int npass = (r_end - pb < PASS_ROWS) ? (r_end - pb) : PASS_ROWS;
        for (int g4 = F.wave; RG * g4 < npass; g4 += 8) {
            f32x4 hm[RG][4]; int urows[RG];
#pragma unroll
            for (int r = 0; r < RG; ++r) {
                const int lr = RG * g4 + r;
                if (lr < npass) {
                    const int j = pb + lr; int urow, which; const float* src = nullptr;
                    if (l == 0) { urow = j; src = src_row_l0(F, urow, which); }
                    else { const int b = j >> 14; urow = b * RB + CTXL + (j & 16383); which = b; }
                    urows[r] = urow;
                    f32x4 v[4], y[4], g1[4]; if (l == 0) ld_f32_nt(src, F.lane, v); else ld_bf16_nt(XB + (size_t)urow * 1024, F.lane, v); ld_bf16_nt(YP + (size_t)urow * 1024, F.lane, y); ld_f32(modp(F, l, which, 2), F.lane, g1);
#pragma unroll
                    for (int jj = 0; jj < 4; ++jj) v[jj] = v[jj] * DN_ALPHA + g1[jj] * y[jj];
                    layer_norm_row(v, lng, lnb, F.lane);
                    st_bf16_nt(XA + (size_t)urow * 1024, F.lane, v);
                    modulate_row(hm[r], v, modp(F, l, which, 4), modp(F, l, which, 3), F.lane);
                    st_fp8row((unsigned char*)H + (size_t)urow * 1024, F.lane, hm[r]);
                } else { urows[r] = 0;
#pragma unroll
                    for (int jj = 0; jj < 4; ++jj) hm[r][jj] = (f32x4){0.f, 0.f, 0.f, 0.f}; }
            }
#pragma unroll 3
            for (int c4 = 0; c4 < 9; ++c4) {
                float pr[RG][4];
#pragma unroll
                for (int cc = 0; cc < 4; ++cc) {
                    f32x4 w[4];
#pragma unroll
                    for (int jj = 0; jj < 4; ++jj) w[jj] = *(const LAS f32x4*)(Wr + (c4 * 4 + cc) * WRS + 256 * jj + 4 * F.lane);
#pragma unroll
                    for (int r = 0; r < RG; ++r) { f32x2 a2 = (f32x2){0.f, 0.f};
#pragma unroll
                        for (int jj = 0; jj < 4; ++jj) { a2 += (f32x2){hm[r][jj][0], hm[r][jj][1]} * (f32x2){w[jj][0], w[jj][1]}; a2 += (f32x2){hm[r][jj][2], hm[r][jj][3]} * (f32x2){w[jj][2], w[jj][3]}; }
                        pr[r][cc] = a2[0] + a2[1]; }
                }
#pragma unroll
                for (int r = 0; r < RG; ++r) {
                    const float wv = reduce4(pr[r][0], pr[r][1], pr[r][2], pr[r][3]);
                    const int q = F.lane >> 4; const int cmap = (q == 1) ? 2 : (q == 2 ? 1 : q);
                    if ((F.lane & 15) == 0) lgs[r * 36 + c4 * 4 + cmap] = wv;
                }
            }
            asm volatile("s_waitcnt lgkmcnt(0)" ::: "memory");
            if (F.lane < RG && RG * g4 + F.lane < npass) {
                const int r = F.lane, lr = RG * g4 + r; const LAS float* lg = lgs + r * 36;
                float gv[4];
#pragma unroll
                for (int i = 0; i < 4; ++i) gv[i] = lg[i] + bgp[i];
                int gi = 0; float gm = gv[0];
#pragma unroll
                for (int i = 1; i < 4; ++i) if (gv[i] > gm) { gm = gv[i]; gi = i; }
                float gs = 0.f;
#pragma unroll
                for (int i = 0; i < 4; ++i) gs += fast_exp2((gv[i] - gm) * LOG2E);
                const float gval = 1.0f / gs;
                float ev[8];
#pragma unroll
                for (int i = 0; i < 8; ++i) ev[i] = lg[4 + 8 * gi + i] + bep[8 * gi + i];
                int i1 = 0; float m1 = ev[0];
#pragma unroll
                for (int i = 1; i < 8; ++i) if (ev[i] > m1) { m1 = ev[i]; i1 = i; }
                int i2 = -1; float m2 = -INFINITY;
#pragma unroll
                for (int i = 0; i < 8; ++i) if (i != i1 && ev[i] > m2) { m2 = ev[i]; i2 = i; }
                const float tt = fast_exp2((m2 - m1) * LOG2E); const float w0 = gval / (1.f + tt), w1 = gval * tt / (1.f + tt);
                const int E0 = gi * 8 + i1, E1 = gi * 8 + i2;
                const int ls0 = __hip_atomic_fetch_add(lcnt + E0, 1, __ATOMIC_RELAXED, __HIP_MEMORY_SCOPE_WORKGROUP);
                const int ls1 = __hip_atomic_fetch_add(lcnt + E1, 1, __ATOMIC_RELAXED, __HIP_MEMORY_SCOPE_WORKGROUP);
                LAS unsigned* ri = rinfo + lr * 8;
                ri[0] = (unsigned)E0; ri[1] = (unsigned)ls0; ri[2] = __float_as_uint(w0); ri[3] = (unsigned)E1; ri[4] = (unsigned)ls1; ri[5] = __float_as_uint(w1);
                ri[6] = (unsigned)(r == 0 ? urows[0] : urows[RG - 1]);
            }
            asm volatile("s_waitcnt lgkmcnt(0)" ::: "memory");
        }
        __syncthreads();
        if (F.tid < 32) { const int n = lcnt[F.tid]; lbase[F.tid] = n > 0 ? (int)__hip_atomic_fetch_add(gcnt + F.tid, (unsigned)n, __ATOMIC_RELAXED, __HIP_MEMORY_SCOPE_AGENT) : 0; }
        __syncthreads();
        for (int lr = F.tid; lr < npass; lr += 512) {
            const LAS unsigned* ri = rinfo + lr * 8;
            const int E0 = (int)ri[0], E1 = (int)ri[3]; const int s0 = lbase[E0] + (int)ri[1], s1 = lbase[E1] + (int)ri[4]; const int urow = (int)ri[6];
            list[(size_t)E0 * LIST_CAP + s0] = urow; list[(size_t)E1 * LIST_CAP + s1] = urow;
            u32x4 a; a.x = (unsigned)E0; a.y = (unsigned)s0; a.z = ri[2]; a.w = (unsigned)E1; u32x4 b; b.x = (unsigned)s1; b.y = ri[5]; b.z = 0u; b.w = 0u;
            *(u32x4*)(tokinfo + (size_t)urow * 8) = a; *(u32x4*)(tokinfo + (size_t)urow * 8 + 4) = b;
        }
        __syncthreads();
        if (F.tid < 32) lcnt[F.tid] = 0;
        __syncthreads();
    }
}

DI void moe_tables(const Ctx& F, int l) {
    LAS int* tb = (LAS int*)(F.lds + LDS_AUX);
    if (F.tid < 32) tb[64 + F.tid] = (int)__hip_atomic_load(F.ctl + CW_CNT + l * 32 + F.tid, RLX_AGENT);
    __syncthreads();
    if (F.tid == 0) { int a = 0; for (int e = 0; e < 32; ++e) { tb[e] = a; a += (tb[64 + e] + 255) >> 8; } tb[32] = a; }
    __syncthreads();
}
struct MoeOrder {
    const LAS int* tb; int G, c; const char* A; const char* W; size_t wstride, tstepB, tstepA; const int* list; unsigned lda2; bool gatherA;
    DI bool next(int i, pg8::Unit& u) const {
        const int ntot = tb[32]; const long L = (long)i * G + c; if (L >= (long)ntot * 4) return false;
        const int rt = (int)(L >> 2), pn = (int)(L & 3); int e = 0;
        for (int j = 1; j < 32; ++j) e += (tb[j] <= rt) ? 1 : 0;
        e = __builtin_amdgcn_readfirstlane(e);
        u.pm = rt; u.pn = pn; u.aux0 = e; u.aux1 = __builtin_amdgcn_readfirstlane((rt - tb[e]) * 256);
        u.A = gatherA ? A : A + (size_t)rt * tstepA; u.B = W + (size_t)e * wstride + (size_t)pn * tstepB; return true;
    }
    DI unsigned gather(const pg8::Unit& u, int r) const {
        const int slot = u.aux1 + r, n = tb[64 + u.aux0];
        const int tok = list[(size_t)u.aux0 * LIST_CAP + (slot < n ? slot : 0)];
        return (unsigned)tok * lda2;
    }
};

DI void phase_ln2(const Ctx& F, const int l) {
    moe_tables(F, l);
    const LAS int* tb = (const LAS int*)(F.lds + LDS_AUX);
    const bf16_t* YS = (const bf16_t*)(F.ws + WS_YS); const bf16_t* XA = (const bf16_t*)(F.ws + WS_XA); bf16_t* XB = (bf16_t*)(F.ws + WS_XB); bf16_t* H = (bf16_t*)(F.ws + WS_H);
    const unsigned* tokinfo = (const unsigned*)(F.ws + WS_TOKINFO);
    const float* lng = F.inp[6] + (size_t)(l * 2 + 1) * 1024; const float* lnb = F.inp[7] + (size_t)(l * 2 + 1) * 1024;
    const int nrows = (l == 0) ? MU : NB * SEQ;
    const int stride = F.G * 8;
    for (int j0 = F.vcu * 8 + F.wave; j0 < nrows; j0 += 2 * stride) {
        int urow[2], which[2], bb[2], ss[2]; bool ok[2]; u32x4 ia[2]; u32x2 ib[2]; f32x4 v[2][4], ya[2][4], yb[2][4];
#pragma unroll
        for (int r = 0; r < 2; ++r) { const int j = j0 + r * stride; ok[r] = j < nrows; const int jj = ok[r] ? j : j0;
            if (l == 0) { urow[r] = jj; bb[r] = jj / RB; which[r] = (jj - bb[r] * RB) < CTXL ? 2 : bb[r]; ss[r] = 0; }
            else { bb[r] = jj >> 14; ss[r] = jj & 16383; urow[r] = bb[r] * RB + CTXL + ss[r]; which[r] = bb[r]; }
            ia[r] = *(const u32x4*)(tokinfo + (size_t)urow[r] * 8); ib[r] = *(const u32x2*)(tokinfo + (size_t)urow[r] * 8 + 4);
            ld_bf16_nt(XA + (size_t)urow[r] * 1024, F.lane, v[r]); }
#pragma unroll
        for (int r = 0; r < 2; ++r) { const int p0 = tb[ia[r].x] * 256 + (int)ia[r].y, p1 = tb[ia[r].w] * 256 + (int)ib[r].x;
            ld_bf16_nt(YS + (size_t)p0 * 1024, F.lane, ya[r]); ld_bf16_nt(YS + (size_t)p1 * 1024, F.lane, yb[r]); }
#pragma unroll
        for (int r = 0; r < 2; ++r) {
            if (!ok[r]) continue;
            const float w0 = __uint_as_float(ia[r].z), w1 = __uint_as_float(ib[r].y);
            f32x4 g2[4]; ld_f32(modp(F, l, which[r], 5), F.lane, g2);
#pragma unroll
            for (int jj = 0; jj < 4; ++jj) v[r][jj] = v[r][jj] * DN_ALPHA + g2[jj] * (ya[r][jj] * w0 + yb[r][jj] * w1);
            layer_norm_row(v[r], lng, lnb, F.lane);
            if (l == 0) {
                st_bf16_nt(XB + (size_t)urow[r] * 1024, F.lane, v[r]);
                f32x4 h[4]; modulate_row(h, v[r], modp(F, 1, which[r], 1), modp(F, 1, which[r], 0), F.lane);
                st_fp8row((unsigned char*)H + (size_t)urow[r] * 1024, F.lane, h);
            } else st_f32_nt(F.out + ((size_t)bb[r] * SEQ + ss[r]) * 1024, F.lane, v[r]);
        }
    }
}

template <class Sched> DI void rms_tables(const Ctx& F, const Sched& S, const bf16_t* base, int col0, int ncols, LAS float* rs) {
    pg8::Unit u;
    for (int i = 0; i < 16 && S.next(i, u); ++i) {
        const int r = F.tid >> 1, hsel = F.tid & 1; const int half = ncols / 2;
        const bf16_t* p = base + (size_t)(u.pm * 256 + r) * NQKV + col0 + hsel * half; float ss = 0.f;
        for (int k = 0; k < half; k += 8) { const u32x4 w = *(const u32x4*)(p + k);
            ss += bf_lo(w.x) * bf_lo(w.x) + bf_hi(w.x) * bf_hi(w.x) + bf_lo(w.y) * bf_lo(w.y) + bf_hi(w.y) * bf_hi(w.y) + bf_lo(w.z) * bf_lo(w.z) + bf_hi(w.z) * bf_hi(w.z) + bf_lo(w.w) * bf_lo(w.w) + bf_hi(w.w) * bf_hi(w.w); }
        ss += __shfl_xor(ss, 1);
        if (hsel == 0) rs[i * 256 + r] = 1.0f / sqrtf(ss / (float)ncols + 1e-6f);
    }
    __syncthreads();
}

#ifndef MK_PER_PHASE
#define MK_PER_PHASE 0
#endif
constexpr int N_PHASES = 17;
struct Args { const float* in[26]; float* out; unsigned char* ws; int ph_lo, ph_hi; };

__global__ void __launch_bounds__(512, 2) mk_fwd(Args args) {
    extern __shared__ __attribute__((aligned(16))) unsigned char lds_raw[];
    Ctx F;
    F.lds = (LAS unsigned char*)lds_raw; F.ws = args.ws; F.ctl = (gu32*)(args.ws + WS_CTL);
    F.tid = threadIdx.x; F.lane = F.tid & 63; F.wave = __builtin_amdgcn_readfirstlane(F.tid >> 6);
    F.G = gridDim.x; { const int bx = blockIdx.x; F.vcu = (F.G % 8 == 0) ? (bx % 8) * (F.G / 8) + bx / 8 : bx; }
    F.inp = (const float* const __attribute__((address_space(4)))*)__builtin_amdgcn_kernarg_segment_ptr();
    F.out = args.out;
    volatile LAS unsigned* MISC = (volatile LAS unsigned*)(F.lds + LDS_MISC);
    if (F.tid < 16) MISC[F.tid] = 0u;
    __syncthreads();
    XcdBarrier bar; bar.bar = (unsigned*)(F.ctl + CW_BAR); bar.x = 0; bar.st = nullptr;
    if (!MK_PER_PHASE) bar = xcd_barrier_post((unsigned*)(F.ctl + CW_BAR), MISC);
    const int lo = args.ph_lo, hi = args.ph_hi;
#define IN(k) (lo <= (k) && (k) < hi)
#define SEAM(k) do { if (IN(k) && IN((k) + 1)) xcd_barrier(bar); } while (0)
#define H ((bf16_t*)(F.ws + WS_H))
#define AO ((bf16_t*)(F.ws + WS_AO))
#define QKV ((bf16_t*)(F.ws + WS_QKV))
#define YP ((bf16_t*)(F.ws + WS_YP))
#define ACT ((bf16_t*)(F.ws + WS_ACT))
#define YS ((bf16_t*)(F.ws + WS_YS))
#define QM ((bf16_t*)(F.ws + WS_QM))
#define KVM ((bf16_t*)(F.ws + WS_KVM))
#define r32c ((const float*)(F.ws + WS_ROPE) + 8192)
#define r32s ((const float*)(F.ws + WS_ROPE) + 8192 + 2048)
    LAS unsigned char* ring = F.lds;

    if (IN(0)) { phase_prologue(F); } SEAM(0);
    if (IN(1)) { phase_modulate0(F); } SEAM(1);

    if (IN(2)) {
        pg8::DenseOrder S; S.init(130, 9, F.G, (int)blockIdx.x, false, H, 512, F.ws + WS_WAB_IN, 512);
        pg8::EpiInProj<0> E{F.ws};
        pg8::gemm_phase<pg8::EpiInProj<0>, pg8::DenseOrder, false, true>(ring, 512, 512, S, E);
    } SEAM(2);
    if (IN(3)) {
        LAS float* rpbL = (LAS float*)(F.lds + LDS_AUX); int nconv = 0;
        for (int i = 0;; ++i) {
            const int L = i * F.G + F.vcu; if (L >= 2048 + 32) break;
            att::P p; p.opitch = 1024; p.qpitch = 512; p.k8r = nullptr; p.lam = 0.f; p.subln = nullptr; p.sink2 = 0.f; p.t_lo = 4; p.s0 = 0;
            int b, head, mixer; size_t qr0;
            if (L >= 2048) { const int Lc = L - 2048, j = Lc & 15; mixer = Lc >> 4; b = j >> 3; head = j & 7; p.kind = 2 + mixer; p.nt = 4; qr0 = (size_t)(b * RB); }
            else { const int j = L & 1023; mixer = L >> 10; const int qb = j & 63; head = (j >> 6) & 7; b = j >> 9; p.kind = mixer; p.s0 = qb * 256; qr0 = (size_t)(b * RB + CTXL + p.s0);
                int tlo, thi;
                if (mixer == 0) { tlo = p.s0 / 64 - 2; thi = p.s0 / 64 + 5; tlo = tlo < 0 ? 0 : tlo; thi = thi > 255 ? 255 : thi; }
                else { const int R0 = p.s0 >> 6; tlo = R0 - 4; tlo = tlo < 0 ? 0 : (tlo > 248 ? 248 : tlo); thi = R0 - 1; thi = thi < 0 ? 0 : (thi > 248 ? 248 : thi); thi += 7; }
                p.t_lo = 4 + tlo; p.nt = 4 + (thi - tlo + 1); }
            p.o = (unsigned char*)AO + qr0 * 1024;
            if (mixer == 0) { p.o += head * 64; p.sink2 = F.inp[9][head] * LOG2E;
                p.k8 = F.ws + WS_K8A + (size_t)(b * 2 + (head >> 2)) * 260 * 4096; p.v8 = F.ws + WS_VT8A + (size_t)(b * 2 + (head >> 2)) * 260 * 4096; p.q8 = F.ws + WS_Q8A + qr0 * 512 + head * 64; }
            else { p.o += 512 + head * 64;
                p.k8 = F.ws + WS_K8B + (size_t)(b * 8 + head) * 260 * 4096; p.v8 = F.ws + WS_VT8B + (size_t)(b * 8 + head) * 260 * 4096; p.q8 = F.ws + WS_Q8B + qr0 * 512 + head * 64;
                if (p.kind == 1) for (int idx = F.tid; idx < 465; idx += 512) rpbL[idx] = F.inp[10][head * 465 + idx] * LOG2E; }
            p.nt += (p.nt & 1);
            att::attn_unit_f8l0(p, ring, rpbL);
            if (i < 8) { conv_moe_slice(F, 0, i); __syncthreads(); }
            nconv = i + 1;
        }
        for (int s = nconv; s < 8; ++s) { conv_moe_slice(F, 0, s); __syncthreads(); }
    } SEAM(3);

#define LAYER_TAIL(l) do {\
        const int pb = (l == 0) ? 4 : 12;\
        if (IN(pb)) {\
            pg8::DenseOrder S; S.init(l == 0 ? 130 : 128, 4, F.G, (int)blockIdx.x, l == 1, AO, 512, F.ws + (l == 0 ? WS_WAB_OUT : WS_WCD_OUT), 512);\
            pg8::EpiPlain E{YP, 1024};\
            pg8::gemm_phase<pg8::EpiPlain, pg8::DenseOrder, false, true>(ring, 512, 512, S, E, 0x7a7a7a7a);    \
        } SEAM(pb);\
        if (IN(pb + 1)) { phase_ln1_router(F, l); } SEAM(pb + 1);\
        if (IN(pb + 2)) {\
            moe_tables(F, l);\
            MoeOrder S{(const LAS int*)(F.lds + LDS_AUX), F.G, (int)blockIdx.x, (const char*)H, (const char*)(F.ws + WS_WGU) + (size_t)l * 32 * 1024 * 1024, (size_t)1024 * 1024, (size_t)256 * 1024, 0,\
                       (const int*)(F.ws + WS_LIST), 1024u, true};\
            pg8::EpiGU E{(unsigned char*)ACT};\
            pg8::gemm_phase<pg8::EpiGU, MoeOrder, true, true>(ring, 512, 512, S, E);                     \
        } SEAM(pb + 2);\
        if (IN(pb + 3)) {\
            moe_tables(F, l);\
            MoeOrder S{(const LAS int*)(F.lds + LDS_AUX), F.G, (int)blockIdx.x, (const char*)ACT, (const char*)(F.ws + WS_WDN) + (size_t)l * 32 * 1024 * 512, (size_t)1024 * 512, (size_t)256 * 512, (size_t)256 * 512,\
                       (const int*)(F.ws + WS_LIST), 0u, false};\
            pg8::EpiPlain E{YS, 1024};\
            pg8::gemm_phase<pg8::EpiPlain, MoeOrder, false, true>(ring, 256, 256, S, E);                \
        } SEAM(pb + 3);\
        if (IN(pb + 4)) { phase_ln2(F, l); }\
    } while (0)
    LAYER_TAIL(0); SEAM(8);

    if (IN(9)) {
        pg8::DenseOrder S; S.init(130, 9, F.G, (int)blockIdx.x, false, H, 512, F.ws + WS_WCD_IN, 512);
        pg8::EpiInProj<1> E{F.ws};
        pg8::gemm_phase<pg8::EpiInProj<1>, pg8::DenseOrder, false, true>(ring, 512, 512, S, E);
    } SEAM(9);
    if (IN(10)) {
        LAS float* rsq = (LAS float*)(F.lds + LDS_AUX); LAS float* rskv = rsq + 1024;
        pg8::DenseOrder Sq; Sq.init(128, 3, F.G, (int)blockIdx.x, true, QKV + 1536, NQKV, F.ws + WS_WUQ, 384);
        pg8::DenseOrder Skv; Skv.init(130, 4, F.G, (int)blockIdx.x, false, QKV + 1920, NQKV, F.ws + WS_WUKV, 256);
        rms_tables(F, Sq, QKV, 1536, 384, rsq);
        rms_tables(F, Skv, QKV, 1920, 256, rskv);
        pg8::EpiUQ Eq{F.ws + WS_Q8M, rsq, r32c, r32s};
        pg8::gemm_phase<pg8::EpiUQ, pg8::DenseOrder, false>(ring, NQKV, 384, Sq, Eq);
        pg8::EpiUKV Ekv{F.ws + WS_K8M, rskv, F.ws + WS_VT8M};
        pg8::gemm_phase<pg8::EpiUKV, pg8::DenseOrder, false>(ring, NQKV, 256, Skv, Ekv);
    } SEAM(10);
    if (IN(11)) {
        float lam; { const float* lp = F.inp[17]; float s01 = 0.f, s23 = 0.f; for (int i = 0; i < 64; ++i) { s01 += lp[i] * lp[64 + i]; s23 += lp[128 + i] * lp[192 + i]; }
            lam = fast_exp2(s01 * LOG2E) - fast_exp2(s23 * LOG2E) + LAM_INIT; }
        int nconv = 0;
        for (int i = 0;; ++i) {
            const int L = i * F.G + F.vcu; if (L >= 2048) break;
            att::P p; p.kind = 0; p.t_lo = 0; p.s0 = 0; p.sink2 = 0.f; p.nt = RB / 64; p.opitch = 1024; p.lam = lam; p.subln = F.inp[18];
            if (L < 1024) { const int qb = L & 63, head = (L >> 6) & 7, b = L >> 9; const size_t qrow0 = (size_t)(b * RB + CTXL + qb * 256);
                p.o = (unsigned char*)AO + qrow0 * 1024 + head * 64; p.v8 = F.ws + WS_VT8M + (size_t)(b * 8 + head) * 260 * 4096; p.k8 = F.ws + WS_K8M + (size_t)(b * 8 + head) * 260 * 4096; p.k8r = F.ws + WS_K8R + (size_t)b * 260 * 2048;
                p.q8 = F.ws + WS_Q8M + qrow0 * 768 + head * 96; p.qpitch = 768;
                att::attn_unit_f8q<1>(p, ring);
            } else { const int j = L - 1024; const int qb = j & 127, head = (j >> 7) & 3, b = j >> 9; const size_t qrow0 = (size_t)(b * RB + CTXL + qb * 128);
                p.o = (unsigned char*)AO + qrow0 * 1024 + 512 + head * 128; p.v8 = F.ws + WS_VT8D + (size_t)(b * 4 + head) * 260 * 8192; p.k8 = F.ws + WS_K8D + (size_t)(b * 4 + head) * 260 * 8192; p.k8r = nullptr;
                p.q8 = F.ws + WS_Q8D + qrow0 * 512 + head * 128; p.qpitch = 512;
                att::attn_unit_f8q<2>(p, ring);
            }
            if (i < 8) { conv_moe_slice(F, 1, i); __syncthreads(); }
            nconv = i + 1;
        }
        for (int s = nconv; s < 8; ++s) { conv_moe_slice(F, 1, s); __syncthreads(); }
    } SEAM(11);

    LAYER_TAIL(1);
#undef LAYER_TAIL
#undef IN
#undef SEAM
#undef H
#undef AO
#undef QKV
#undef YP
#undef ACT
#undef YS
#undef QM
#undef KVM
#undef r32c
#undef r32s
}

extern "C" void kernel_launch(void* const* d_in, const int* in_sizes, int n_in, void* d_out, int out_size, void* d_ws, size_t ws_size, hipStream_t stream) {
    static int grid = 0;
    if (grid == 0) {
        if (n_in != 26 || out_size != NB * SEQ * DM || ws_size < WS_END) { fprintf(stderr, "kernel_launch: unexpected shapes (n_in %d, out %d, ws %zu < %zu)\n", n_in, out_size, ws_size, (size_t)WS_END); grid = -1; return; }
        int dev = 0, cus = 0, per_cu = 0;
        if (hipGetDevice(&dev) != hipSuccess || hipDeviceGetAttribute(&cus, hipDeviceAttributeMultiprocessorCount, dev) != hipSuccess) { grid = -1; return; }
        if (hipFuncSetAttribute((const void*)mk_fwd, hipFuncAttributeMaxDynamicSharedMemorySize, LDS_BYTES) != hipSuccess) { fprintf(stderr, "kernel_launch: hipFuncSetAttribute failed\n"); grid = -1; return; }
        if (hipOccupancyMaxActiveBlocksPerMultiprocessor(&per_cu, (const void*)mk_fwd, 512, LDS_BYTES) != hipSuccess || per_cu < 1) fprintf(stderr, "kernel_launch: occupancy query says %d\n", per_cu);
        (void)hipGetLastError();
        grid = cus;
    }
    if (grid < 0) return;
    (void)hipMemsetAsync((char*)d_ws + WS_CTL, 0, CTL_ZERO_BYTES, stream);
    Args a{};
    for (int i = 0; i < 26; ++i) a.in[i] = (const float*)d_in[i];
    a.out = (float*)d_out; a.ws = (unsigned char*)d_ws;
#if MK_PER_PHASE
    for (int ph = 0; ph < N_PHASES; ++ph) { a.ph_lo = ph; a.ph_hi = ph + 1; hipLaunchKernelGGL(mk_fwd, dim3(grid), dim3(512), LDS_BYTES, stream, a); }
#else
    a.ph_lo = 0; a.ph_hi = N_PHASES;
    hipLaunchKernelGGL(mk_fwd, dim3(grid), dim3(512), LDS_BYTES, stream, a);
#endif
}
```

```cpp
#include <hip/hip_runtime.h>
#include <cstdio>
#include <cstdint>

#define GAS __attribute__((address_space(1)))
#define LAS __attribute__((address_space(3)))
typedef unsigned short bf16_t;
typedef short bf16x8 __attribute__((ext_vector_type(8)));
typedef short s16x4 __attribute__((ext_vector_type(4)));
typedef float f32x4 __attribute__((ext_vector_type(4)));
typedef float f32x2 __attribute__((ext_vector_type(2)));
typedef float f32x16 __attribute__((ext_vector_type(16)));
typedef unsigned u32x4 __attribute__((ext_vector_type(4)));
typedef unsigned u32x2 __attribute__((ext_vector_type(2)));
typedef __bf16 bf16x2_t __attribute__((ext_vector_type(2)));
typedef short v4i16_t __attribute__((ext_vector_type(4)));
typedef GAS unsigned gu32;
#define RLX_AGENT __ATOMIC_RELAXED, __HIP_MEMORY_SCOPE_AGENT
#define DI __device__ __forceinline__

constexpr int DM = 1024, NB = 2, SEQ = 16384, CTXL = 256;
constexpr int RB = SEQ + CTXL;
constexpr int MU = NB * RB;
constexpr int NEXP = 32, DEXP = 512;
constexpr float LOG2E = 1.4426950408889634f;
constexpr float DN_ALPHA = 1.4142135623730951f;
constexpr float LAM_INIT = 0.8f - 0.6f * 0.7408182206817179f;
constexpr int NQKV = 2304;
constexpr int LIST_CAP = MU;
constexpr int RMAX = 74752;

constexpr size_t MiB = 1u << 20;
constexpr size_t WS_CTL = 0, CTL_ZERO_BYTES = 64 * 1024;
constexpr size_t WS_MOD = 1 * MiB;
constexpr size_t WS_ROPE = 1 * MiB + 256 * 1024;
constexpr size_t WS_TOKINFO = 2 * MiB;
constexpr size_t WS_LIST = 4 * MiB;
constexpr size_t WS_WAB_IN = 10 * MiB, WS_WAB_OUT = 15 * MiB, WS_WCD_IN = 17 * MiB, WS_WCD_OUT = 22 * MiB, WS_WUQ = 24 * MiB, WS_WUKV = 25 * MiB;
constexpr size_t WS_WGU = 26 * MiB;
constexpr size_t WS_WDN = 154 * MiB;
constexpr size_t WS_XA = 218 * MiB, WS_XB = 348 * MiB;
constexpr size_t WS_H = 478 * MiB;
constexpr size_t WS_AO = 543 * MiB;
constexpr size_t WS_S = 608 * MiB;
constexpr size_t WS_QKV = WS_S;
constexpr size_t WS_QM = WS_S + 147 * MiB;
constexpr size_t WS_KVM = WS_S + 196 * MiB;
constexpr size_t WS_YP = WS_S;
constexpr size_t WS_ACT = WS_S + 65 * MiB;
constexpr size_t WS_YS = WS_S + 138 * MiB;
constexpr size_t WS_END = WS_S + 284 * MiB;
constexpr size_t WS_VT8M = 892 * MiB, WS_VT8D = 910 * MiB;
constexpr size_t WS_K8M = 928 * MiB, WS_K8D = 946 * MiB, WS_K8R = 964 * MiB;
constexpr size_t WS_Q8M = WS_QM, WS_Q8D = WS_QM + 26 * MiB;
constexpr size_t WS_Q8A = WS_QM, WS_Q8B = WS_QM + 17 * MiB, WS_K8A = WS_K8D, WS_K8B = WS_K8M, WS_VT8A = WS_VT8D, WS_VT8B = WS_VT8M;
static_assert(WS_YS + (size_t)RMAX * 1024 * 2 <= WS_END && WS_KVM + (size_t)MU * 1024 * 2 <= WS_END && WS_QM + (size_t)MU * 768 * 2 <= WS_KVM && WS_QKV + (size_t)MU * NQKV * 2 <= WS_QM, "ws map");
static_assert(WS_ACT + (size_t)RMAX * 512 * 2 <= WS_YS && WS_YP + (size_t)MU * 1024 * 2 <= WS_ACT, "ws map 2");

constexpr int CW_TMO = 0, CW_CODE = 1;
constexpr int CW_BAR = 4096;
constexpr int CW_CNT = 8192;

constexpr int RING_BYTES = 131072;
constexpr int LDS_AUX = RING_BYTES;
constexpr int LDS_MISC = 159744 - 64;
constexpr int LDS_BYTES = 159744;

DI unsigned cvtpk(float lo, float hi) { f32x2 v = {lo, hi}; bf16x2_t b = __builtin_convertvector(v, bf16x2_t); return __builtin_bit_cast(unsigned, b); }
DI float bf_lo(unsigned u) { return __uint_as_float(u << 16); }
DI float bf_hi(unsigned u) { return __uint_as_float(u & 0xffff0000u); }
DI float wave_sum(float v) {
#pragma unroll
    for (int o = 1; o < 64; o <<= 1) v += __shfl_xor(v, o);
    return v;
}
DI float fast_exp2(float x) { return __builtin_amdgcn_exp2f(x); }
DI float fast_rcp(float x) { return __builtin_amdgcn_rcpf(x); }

#define XB_TMO      128
#define XB_XCNT(j)  (256  + 64 * (j))
#define XB_XSUB(j)  (1280 + 64 * (j))
#define XB_XGEN(j)  (2304 + 64 * (j))
#define XB_TOP      3328
#define XB_TOPGEN   3392
#define XCD_BAR_WORDS 3456
#define XB_SPIN_CAP (1u << 22)

DI unsigned xb_ld(unsigned* p)              { return __hip_atomic_load(p, __ATOMIC_RELAXED, __HIP_MEMORY_SCOPE_AGENT); }
DI unsigned xb_add(unsigned* p, unsigned v) { return __hip_atomic_fetch_add(p, v, __ATOMIC_RELAXED, __HIP_MEMORY_SCOPE_AGENT); }
DI unsigned xb_xcc_id() { return (unsigned)__builtin_amdgcn_s_getreg((3 << 11) | 20) & 0xFu; }
#define XB_SPIN(cond, bar) do { unsigned _sp = 0; while (cond) { __builtin_amdgcn_s_sleep(1); \
    if ((++_sp & 255u) == 0u) { if (xb_ld(&(bar)[XB_TMO])) break; if (_sp > XB_SPIN_CAP) { atomicAdd(&(bar)[XB_TMO], 1u); break; } } } } while (0)

struct XcdBarrier { unsigned* bar; unsigned x; volatile LAS unsigned* st; };

DI XcdBarrier xcd_barrier_post(unsigned* bar, volatile LAS unsigned* st) {
    XcdBarrier b; b.bar = bar; b.x = xb_xcc_id(); b.st = st;
    if (threadIdx.x == 0) (void)xb_add(&bar[XB_XCNT(b.x)], 1u);
    return b;
}
DI void xcd_barrier_complete(unsigned* bar, unsigned x, unsigned& nloc, unsigned& nx) {
    const unsigned G = gridDim.x * gridDim.y * gridDim.z;
    unsigned sum, cnt, mine, sp = 0u;
    for (;;) {
        sum = 0u; cnt = 0u; mine = 0u;
#pragma unroll
        for (unsigned j = 0; j < 16; ++j) { const unsigned c = xb_ld(&bar[XB_XCNT(j)]); sum += c; cnt += (c > 0u) ? 1u : 0u; mine = (j == x) ? c : mine; }
        if (sum == G) break;
        __builtin_amdgcn_s_sleep(1);
        if ((++sp & 255u) == 0u) { if (xb_ld(&bar[XB_TMO])) break; if (sp > XB_SPIN_CAP) { atomicAdd(&bar[XB_TMO], 1u); break; } }
    }
    nloc = mine > 0u ? mine : 1u; nx = cnt > 0u ? cnt : 1u;
}
DI void xcd_barrier(const XcdBarrier& b) {
    asm volatile("s_waitcnt vmcnt(0)" ::: "memory");
    __syncthreads();
    if (threadIdx.x == 0) {
        unsigned* bar = b.bar;
        __builtin_amdgcn_s_waitcnt(0);
        unsigned nloc = b.st[0], nx = b.st[1];
        if (nloc == 0u) { xcd_barrier_complete(bar, b.x, nloc, nx); b.st[0] = nloc; b.st[1] = nx; }
        const unsigned old = xb_add(&bar[XB_XSUB(b.x)], 1u);
        const unsigned gen = old / nloc;
        if (old + 1u == (gen + 1u) * nloc) {
            __builtin_amdgcn_fence(__ATOMIC_RELEASE, "agent");
            asm volatile("s_waitcnt vmcnt(0)" ::: "memory");
            const unsigned og = xb_add(&bar[XB_TOP], 1u);
            const unsigned tg = og / nx;
            if (og + 1u == (tg + 1u) * nx) xb_add(&bar[XB_TOPGEN], 1u);
            else XB_SPIN(xb_ld(&bar[XB_TOPGEN]) == tg, bar);
            __builtin_amdgcn_fence(__ATOMIC_ACQUIRE, "agent");
            xb_add(&bar[XB_XGEN(b.x)], 1u);
            asm volatile("s_waitcnt vmcnt(0)" ::: "memory");
        } else {
            XB_SPIN(xb_ld(&bar[XB_XGEN(b.x)]) == gen, bar);
            __builtin_amdgcn_fence(__ATOMIC_ACQUIRE, "agent");
            asm volatile("s_waitcnt vmcnt(0)" ::: "memory");
        }
    }
    __syncthreads();
}

namespace pg8 {
constexpr int BM = 256, BK = 64, HALF = 128, HTB = HALF * BK * 2, STAGE_BYTES = 8 * HTB, NXCD = 8, WGM = 8;
__host__ __device__ __forceinline__ int lds_byte(int r, int c) { const int st = (r >> 4) * 2 + (c >> 5), rr = r & 15, cc = c & 31, ob = rr * 64 + cc * 2; return st * 1024 + (ob ^ (((ob >> 9) & 1) << 5)); }
__host__ __device__ __forceinline__ void stage_rc(int b, int& R, int& C) { const int st = b / 1024, sb = b % 1024, swz = sb ^ (((sb >> 9) & 1) << 5); R = (st >> 1) * 16 + swz / 64; C = (st & 1) * 32 + (swz % 64) / 2; }
__host__ __device__ __forceinline__ int perm32(int rho) { const int n = rho >> 4, i = rho & 15; return 8 * (i >> 2) + 4 * n + (i & 3); }

typedef int v8i_g __attribute__((ext_vector_type(8)));
struct Unit { int pm, pn; const char* A; const char* B; int aux0, aux1; };

struct DenseOrder {
    int nM, nN, nwg, G, c; bool latent_only; const char* A; const char* Bt; size_t tstepA, tstepB;
    DI void init(int nM_, int nN_, int G_, int c_, bool lat, const void* A_, int lda, const void* Bt_, int K) {
        nM = nM_; nN = nN_; nwg = nM * nN; G = G_; c = c_; latent_only = lat; A = (const char*)A_; Bt = (const char*)Bt_; tstepA = (size_t)BM * lda * 2; tstepB = (size_t)BM * K * 2; }
    DI bool next(int i, Unit& u) const {
        const long L = (long)i * G + c; if (L >= nwg) return false;
        int wgid = (int)L; { const int q = nwg / NXCD, r = nwg % NXCD, xcd = wgid % NXCD, off = wgid / NXCD; wgid = (xcd < r ? xcd * (q + 1) : r * (q + 1) + (xcd - r) * q) + off; }
        const int nig = WGM * nN, gid = wgid / nig, fm = gid * WGM, gsz = (nM - fm) < WGM ? (nM - fm) : WGM;
        int pm = fm + ((wgid % nig) % gsz); const int pn = (wgid % nig) / gsz;
        if (latent_only) pm = pm + 1 + (pm >= 64 ? 1 : 0);
        u.pm = pm; u.pn = pn; u.A = A + (size_t)pm * tstepA; u.B = Bt + (size_t)pn * tstepB; u.aux0 = 0; u.aux1 = 0; return true;
    }
    DI unsigned gather(const Unit&, int) const { return 0u; }
};

template <class Epi, class Sched, bool GATHER, bool F8 = false>
DI void gemm_phase(LAS unsigned char* lds, const int lda, const int K, const Sched& S, const Epi& E, const int sc_x8 = 0x7f7f7f7f) {
    const int tid = threadIdx.x, wid = __builtin_amdgcn_readfirstlane(tid >> 6), lane = tid & 63, wr = wid >> 2, wc = wid & 3, fr = lane & 15, fq = lane >> 4;
    const int nt = K / BK;
    int RR[2], CC[2]; unsigned voffB[2];
#pragma unroll
    for (int i = 0; i < 2; ++i) { stage_rc(tid * 16 + i * 8192, RR[i], CC[i]); const int Rb = Epi::PERM ? ((RR[i] & ~31) + perm32(RR[i] & 31)) : RR[i]; voffB[i] = (unsigned)(Rb * K + CC[i]) * 2u; }
    unsigned cv0[2], cv1[2], nv0[2], nv1[2];
    const size_t kstep = (size_t)(BK * 2);
    const size_t hstepB = (size_t)HALF * K * 2;
    const unsigned ldsw = (unsigned)wid * 1024u;
    const int aoff = lds_byte(wr * 64 + fr, fq * 8), boff = lds_byte(wc * 32 + fr, fq * 8);
#define PG8_SA(b, h) (((b) * 2 + (h)) * HTB)
#define PG8_SB(b, h) ((4 + (b) * 2 + (h)) * HTB)
#define PG8_STAGE(bufoff, gbase, voff) do { _Pragma("unroll") for (int _i = 0; _i < 2; ++_i) \
        __builtin_amdgcn_global_load_lds((const unsigned*)((const char*)(gbase) + (voff)[_i]), (LAS unsigned*)(lds + (bufoff) + ldsw + _i * 8192), 16, 0, 0); } while (0)
#define PG8_LDA(dst, b, h) do { _Pragma("unroll") for (int m = 0; m < 4; ++m) _Pragma("unroll") for (int k = 0; k < 2; ++k) dst[m][k] = *(const LAS bf16x8*)(lds + PG8_SA(b, h) + aoff + m * 2048 + k * 1024); } while (0)
#define PG8_LDB(dst, b, h) do { _Pragma("unroll") for (int n = 0; n < 2; ++n) _Pragma("unroll") for (int k = 0; k < 2; ++k) dst[n][k] = *(const LAS bf16x8*)(lds + PG8_SB(b, h) + boff + n * 2048 + k * 1024); } while (0)
#define PG8_MMA(ai, bj, At, Bt) do { __builtin_amdgcn_s_setprio(1); _Pragma("unroll") for (int m = 0; m < 4; ++m) _Pragma("unroll") for (int n = 0; n < 2; ++n) { \
        if (F8) { const u32x4 b0_ = __builtin_bit_cast(u32x4, Bt[n][0]), b1_ = __builtin_bit_cast(u32x4, Bt[n][1]), a0_ = __builtin_bit_cast(u32x4, At[m][0]), a1_ = __builtin_bit_cast(u32x4, At[m][1]); \
            const v8i_g wf_ = (v8i_g){(int)b0_[0], (int)b0_[1], (int)b0_[2], (int)b0_[3], (int)b1_[0], (int)b1_[1], (int)b1_[2], (int)b1_[3]}; \
            const v8i_g xf_ = (v8i_g){(int)a0_[0], (int)a0_[1], (int)a0_[2], (int)a0_[3], (int)a1_[0], (int)a1_[1], (int)a1_[2], (int)a1_[3]}; \
            asm volatile("v_mfma_scale_f32_16x16x128_f8f6f4 %0, %1, %2, %0, %3, %4 op_sel_hi:[0,0,0]" : "+v"(acc[ai][bj][m][n]) : "v"(wf_), "v"(xf_), "v"(sc_w8), "v"(sc_x8)); } \
        else { _Pragma("unroll") for (int k = 0; k < 2; ++k) acc[ai][bj][m][n] = __builtin_amdgcn_mfma_f32_16x16x32_bf16(Bt[n][k], At[m][k], acc[ai][bj][m][n], 0, 0, 0); } } \
        __builtin_amdgcn_s_setprio(0); } while (0)
#define PG8_WAIT_V(n) asm volatile("s_waitcnt vmcnt(" #n ")" ::: "memory")
#define PG8_WAIT_L(n) asm volatile("s_waitcnt lgkmcnt(" #n ")" ::: "memory")
#define PG8_BAR __builtin_amdgcn_s_barrier()
#define PG8_SCHED __builtin_amdgcn_sched_barrier(0)
#define PG8_SETV(v0, v1, u) do { _Pragma("unroll") for (int _i = 0; _i < 2; ++_i) { \
        if (GATHER) { v0[_i] = S.gather(u, RR[_i]) + (unsigned)CC[_i] * 2u; v1[_i] = S.gather(u, HALF + RR[_i]) + (unsigned)CC[_i] * 2u; } \
        else { v0[_i] = (unsigned)(RR[_i] * lda + CC[_i]) * 2u; v1[_i] = (unsigned)((HALF + RR[_i]) * lda + CC[_i]) * 2u; } } } while (0)
    const int sc_w8 = 0x79797979;
    Unit cur, nxt; int ui = 0;
    if (!S.next(0, cur)) return;
    PG8_SETV(cv0, cv1, cur);
    f32x4 acc[2][2][4][2];
#pragma unroll
    for (int a = 0; a < 2; ++a)
#pragma unroll
        for (int b = 0; b < 2; ++b)
#pragma unroll
            for (int m = 0; m < 4; ++m)
#pragma unroll
                for (int n = 0; n < 2; ++n) acc[a][b][m][n] = (f32x4){0.f, 0.f, 0.f, 0.f};
    bf16x8 At[4][2], B0[2][2], B1[2][2];
    const char* cA = cur.A; const char* cB = cur.B;
    PG8_STAGE(PG8_SB(0, 0), cB, voffB); PG8_STAGE(PG8_SB(0, 1), cB + hstepB, voffB); PG8_STAGE(PG8_SA(0, 0), cA, cv0); PG8_STAGE(PG8_SA(0, 1), cA, cv1);
    if (wr == 1) PG8_BAR;
    PG8_WAIT_V(2); PG8_BAR;
    PG8_STAGE(PG8_SB(1, 0), cB + kstep, voffB); PG8_STAGE(PG8_SA(1, 0), cA + kstep, cv0); PG8_STAGE(PG8_SB(1, 1), cB + hstepB + kstep, voffB);
    PG8_WAIT_V(6); PG8_BAR;
    for (;;) {
        const bool has_next = S.next(ui + 1, nxt);
        const char* nA = has_next ? nxt.A : cA; const char* nB = has_next ? nxt.B : cB;
        if (GATHER) { if (has_next) { PG8_SETV(nv0, nv1, nxt); } else {
#pragma unroll
            for (int i = 0; i < 2; ++i) { nv0[i] = cv0[i]; nv1[i] = cv1[i]; } } }
#pragma nounroll
        for (int t = 0; t < nt; t += 2) {
            const bool last = (t == nt - 2);
            const char* a1 = cA + (size_t)(t + 1) * kstep;
            const char* a2 = last ? nA : cA + (size_t)(t + 2) * kstep; const char* b2 = last ? nB : cB + (size_t)(t + 2) * kstep;
            const char* a3 = a2 + kstep; const char* b3 = b2 + kstep;
            unsigned s0[2], s1[2];
#pragma unroll
            for (int i = 0; i < 2; ++i) { s0[i] = (GATHER && last) ? nv0[i] : cv0[i]; s1[i] = (GATHER && last) ? nv1[i] : cv1[i]; }
            PG8_LDB(B0, 0, 0); PG8_LDB(B1, 0, 1); PG8_SCHED; PG8_LDA(At, 0, 0); PG8_STAGE(PG8_SA(1, 1), a1, cv1);
            PG8_WAIT_V(8); PG8_WAIT_L(0); PG8_BAR; PG8_MMA(0, 0, At, B0); PG8_MMA(0, 1, At, B1); PG8_BAR; PG8_SCHED;
            PG8_LDA(At, 0, 1); PG8_STAGE(PG8_SB(0, 0), b2, voffB); PG8_STAGE(PG8_SB(0, 1), b2 + hstepB, voffB); PG8_STAGE(PG8_SA(0, 0), a2, s0);
            PG8_WAIT_V(8); PG8_WAIT_L(0); PG8_BAR; PG8_MMA(1, 0, At, B0); PG8_MMA(1, 1, At, B1); PG8_BAR; PG8_SCHED;
            PG8_LDB(B0, 1, 0); PG8_LDB(B1, 1, 1); PG8_SCHED; PG8_LDA(At, 1, 0); PG8_STAGE(PG8_SA(0, 1), a2, s1);
            PG8_WAIT_V(8); PG8_WAIT_L(0); PG8_BAR; PG8_MMA(0, 0, At, B0); PG8_MMA(0, 1, At, B1); PG8_BAR; PG8_SCHED;
            PG8_LDA(At, 1, 1); PG8_STAGE(PG8_SB(1, 0), b3, voffB); PG8_STAGE(PG8_SB(1, 1), b3 + hstepB, voffB); PG8_STAGE(PG8_SA(1, 0), a3, s0);
            PG8_WAIT_V(8); PG8_WAIT_L(0); PG8_BAR; PG8_MMA(1, 0, At, B0); PG8_MMA(1, 1, At, B1); PG8_BAR; PG8_SCHED;
        }
        if (wr == 0) PG8_BAR;
        if (F8) asm volatile("s_nop 15\n\ts_nop 7" ::: "memory");
        E(acc, cur, ui, wr, wc, fr, fq);
        if (!has_next) break;
#pragma unroll
        for (int a = 0; a < 2; ++a)
#pragma unroll
            for (int b = 0; b < 2; ++b)
#pragma unroll
                for (int m = 0; m < 4; ++m)
#pragma unroll
                    for (int n = 0; n < 2; ++n) acc[a][b][m][n] = (f32x4){0.f, 0.f, 0.f, 0.f};
        cur = nxt; cA = nA; cB = nB; ++ui;
        if (GATHER) {
#pragma unroll
            for (int i = 0; i < 2; ++i) { cv0[i] = nv0[i]; cv1[i] = nv1[i]; } }
        if (wr == 1) PG8_BAR;
    }
    PG8_WAIT_V(0);
    PG8_BAR;
#undef PG8_SA
#undef PG8_SB
#undef PG8_STAGE
#undef PG8_LDA
#undef PG8_LDB
#undef PG8_MMA
#undef PG8_WAIT_V
#undef PG8_WAIT_L
#undef PG8_BAR
#undef PG8_SCHED
#undef PG8_SETV
}

DI void st4(bf16_t* p, f32x4 v) { u32x2 w; w.x = cvtpk(v[0], v[1]); w.y = cvtpk(v[2], v[3]); *(u32x2*)p = w; }
DI void st8(bf16_t* p, f32x4 a, f32x4 b) { u32x4 w; w.x = cvtpk(a[0], a[1]); w.y = cvtpk(a[2], a[3]); w.z = cvtpk(b[0], b[1]); w.w = cvtpk(b[2], b[3]); *(u32x4*)p = w; }

DI unsigned pk_fp8x4(f32x4 v) { int w = __builtin_amdgcn_cvt_pk_fp8_f32(v[0], v[1], 0, false); w = __builtin_amdgcn_cvt_pk_fp8_f32(v[2], v[3], w, true); return (unsigned)w; }
DI unsigned vt8_keyoff(int kap) { const int a = kap >> 5, c = kap & 31, h = (c >> 2) & 1, i = (c & 3) | ((c >> 3) << 2); return (unsigned)((h * 2 + a) * 512 + i); }
DI void st_fp8x4_strided(unsigned char* p, f32x4 v) {
    int w = __builtin_amdgcn_cvt_pk_fp8_f32(v[0], v[1], 0, false); w = __builtin_amdgcn_cvt_pk_fp8_f32(v[2], v[3], w, true);
    p[0] = (unsigned char)(w & 0xff); p[16] = (unsigned char)((w >> 8) & 0xff); p[32] = (unsigned char)((w >> 16) & 0xff); p[48] = (unsigned char)((unsigned)w >> 24);
}
struct EpiPlain {
    static constexpr bool PERM = true;
    bf16_t* O; int ldc;
    DI void operator()(const f32x4 (&acc)[2][2][4][2], const Unit& u, int ui, int wr, int wc, int fr, int fq) const {
        const int row0 = u.pm * BM + wr * 64 + fr, col0 = u.pn * BM + wc * 32 + 8 * fq;
#pragma unroll
        for (int ai = 0; ai < 2; ++ai)
#pragma unroll
            for (int m = 0; m < 4; ++m) { bf16_t* rowp = O + (size_t)(row0 + ai * HALF + m * 16) * ldc + col0;
#pragma unroll
                for (int bj = 0; bj < 2; ++bj) st8(rowp + bj * HALF, acc[ai][bj][m][0], acc[ai][bj][m][1]); }
    }
};
struct EpiPlain8 {
    static constexpr bool PERM = true;
    unsigned char* O; int ldc;
    DI void operator()(const f32x4 (&acc)[2][2][4][2], const Unit& u, int ui, int wr, int wc, int fr, int fq) const {
        const int row0 = u.pm * BM + wr * 64 + fr, col0 = u.pn * BM + wc * 32 + 8 * fq;
#pragma unroll
        for (int ai = 0; ai < 2; ++ai)
#pragma unroll
            for (int m = 0; m < 4; ++m) { unsigned char* rowp = O + (size_t)(row0 + ai * HALF + m * 16) * ldc + col0;
#pragma unroll
                for (int bj = 0; bj < 2; ++bj) { u32x2 w; w.x = pk_fp8x4(acc[ai][bj][m][0] * 64.f); w.y = pk_fp8x4(acc[ai][bj][m][1] * 64.f); *(u32x2*)(rowp + bj * HALF) = w; } }
    }
};
struct EpiGU {
    static constexpr bool PERM = true;
    unsigned char* O;
    DI static f32x4 silu_mul(f32x4 g, f32x4 u) { f32x4 r;
#pragma unroll
        for (int e = 0; e < 4; ++e) r[e] = g[e] * fast_rcp(1.f + fast_exp2(-g[e] * LOG2E)) * u[e];
        return r; }
    DI void operator()(const f32x4 (&acc)[2][2][4][2], const Unit& u, int ui, int wr, int wc, int fr, int fq) const {
        const int row0 = u.pm * BM + wr * 64 + fr, col0 = u.pn * HALF + wc * 32 + 8 * fq;
#pragma unroll
        for (int ai = 0; ai < 2; ++ai)
#pragma unroll
            for (int m = 0; m < 4; ++m) { unsigned char* rowp = O + (size_t)(row0 + ai * HALF + m * 16) * DEXP + col0;
                u32x2 w; w.x = pk_fp8x4(silu_mul(acc[ai][0][m][0], acc[ai][1][m][0])); w.y = pk_fp8x4(silu_mul(acc[ai][0][m][1], acc[ai][1][m][1])); *(u32x2*)rowp = w; }
    }
};
template <int LAYER> struct EpiInProj {
    static constexpr bool PERM = false;
    unsigned char* ws;
    DI void operator()(const f32x4 (&acc)[2][2][4][2], const Unit& u, int ui, int wr, int wc, int fr_in, int fq) const {
        int fr = fr_in; asm volatile("" : "+v"(fr));
        bf16_t* const O = (bf16_t*)(ws + WS_QKV); const float* const r64c = (const float*)(ws + WS_ROPE); const float* const r64s = r64c + 4096; const float* const r32c = r64s + 4096; const float* const r32s = r32c + 2048;
        unsigned char* const vt8 = ws + WS_VT8D; unsigned char* const q8d = ws + WS_Q8D; unsigned char* const k8d = ws + WS_K8D; unsigned char* const k8r = ws + WS_K8R;
        const int bidx = u.pm / 65; const bool ctx = (u.pm - bidx * 65) == 0;
        const float C2 = 0.125f * LOG2E;
#pragma unroll
        for (int bj = 0; bj < 2; ++bj) {
            const int g = 2 * u.pn + bj;
            bool rope64, scale, rope32 = false, skip = false;
            if (LAYER == 0) { rope64 = !ctx && g <= 4; scale = (g <= 3) || (g >= 6 && g <= 9); }
            else { rope64 = !ctx && g <= 7; scale = g <= 3; rope32 = !ctx && g == 17 && wc == 0; skip = (g == 17 && wc != 0); }
            if (skip) continue;
            const int col0 = g * HALF + wc * 32 + 4 * fq;
#pragma unroll
            for (int ai = 0; ai < 2; ++ai)
#pragma unroll
                for (int m = 0; m < 4; ++m) {
                    const int row = u.pm * BM + ai * HALF + wr * 64 + m * 16 + fr;
                    const int s = row - (bidx * RB + CTXL);
                    f32x4 v0 = acc[ai][bj][m][0], v1 = acc[ai][bj][m][1];
                    if (rope64) { const int pos = (wc & 1) ? (s & 63) : (s >> 6);
                        const f32x4 c4 = *(const f32x4*)(r64c + pos * 16 + 4 * fq), s4 = *(const f32x4*)(r64s + pos * 16 + 4 * fq);
                        const f32x4 y0 = v0 * c4 - v1 * s4, y1 = v1 * c4 + v0 * s4; v0 = y0; v1 = y1; }
                    if (rope32) { const int pos = (fq >= 2) ? (s & 63) : (s >> 6);
                        const f32x4 c4 = *(const f32x4*)(r32c + pos * 8 + 4 * (fq & 1)), s4 = *(const f32x4*)(r32s + pos * 8 + 4 * (fq & 1));
                        const f32x4 y0 = v0 * c4 - v1 * s4, y1 = v1 * c4 + v0 * s4; v0 = y0; v1 = y1; }
                    if (scale) { v0 = v0 * C2; v1 = v1 * C2; }
                    if (LAYER == 0) {
                        const int hsel = wc >> 1, dim0 = (wc & 1) * 32 + 4 * fq;
                        const int rr = row - bidx * RB, kt = rr >> 6, kap = rr & 63;
                        if (g <= 3 || (g >= 6 && g <= 9)) {
                            const int head = (g <= 3) ? (2 * g + hsel) : (2 * (g - 6) + hsel);
                            unsigned char* p8 = ws + (g <= 3 ? WS_Q8A : WS_Q8B) + (size_t)row * 512 + head * 64 + dim0;
                            *(unsigned*)p8 = pk_fp8x4(v0 * 8.f); *(unsigned*)(p8 + 16) = pk_fp8x4(v1 * 8.f);
                        } else if (g == 4 || (g >= 10 && g <= 13)) {
                            const size_t img = (g == 4) ? ((size_t)(bidx * 2 + hsel) * 260 + kt) : ((size_t)(bidx * 8 + 2 * (g - 10) + hsel) * 260 + kt);
                            unsigned char* p8 = ws + (g == 4 ? WS_K8A : WS_K8B) + img * 4096 + ((wc & 1) * 2) * 1024 + kap * 16 + 4 * fq;
                            *(unsigned*)p8 = pk_fp8x4(v0); *(unsigned*)(p8 + 1024) = pk_fp8x4(v1);
                        } else {
                            const size_t img = (g == 5) ? ((size_t)(bidx * 2 + hsel) * 260 + kt) : ((size_t)(bidx * 8 + 2 * (g - 14) + hsel) * 260 + kt);
                            unsigned char* p8 = ws + (g == 5 ? WS_VT8A : WS_VT8B) + img * 4096 + (wc & 1) * 2048 + vt8_keyoff(kap) + (4 * fq) * 16;
                            st_fp8x4_strided(p8, v0); st_fp8x4_strided(p8 + 256, v1);
                        }
                        if (m & 1) asm volatile("" ::: "memory"); continue;
                    }
                    if (LAYER == 1 && g <= 3) {
                        unsigned char* p8 = q8d + (size_t)row * 512 + g * HALF + wc * 32 + 4 * fq;
                        *(unsigned*)p8 = pk_fp8x4(v0 * 8.f); *(unsigned*)(p8 + 16) = pk_fp8x4(v1 * 8.f);
                        if (m & 1) asm volatile("" ::: "memory"); continue;
                    }
                    if (LAYER == 1 && g >= 4 && g <= 7) {
                        const int rr = row - bidx * RB, kt = rr >> 6, kap = rr & 63;
                        unsigned char* p8 = k8d + ((size_t)(bidx * 4 + (g - 4)) * 260 + kt) * 8192 + (wc >> 1) * 4096 + ((wc & 1) * 2) * 1024 + kap * 16 + 4 * fq;
                        *(unsigned*)p8 = pk_fp8x4(v0); *(unsigned*)(p8 + 1024) = pk_fp8x4(v1);
                        if (m & 1) asm volatile("" ::: "memory"); continue;
                    }
                    if (LAYER == 1 && g == 17) {
                        const int rr = row - bidx * RB, kt = rr >> 6, kap = rr & 63;
                        unsigned char* p8 = k8r + ((size_t)bidx * 260 + kt) * 2048 + kap * 16 + 4 * fq;
                        *(unsigned*)p8 = pk_fp8x4(v0); *(unsigned*)(p8 + 1024) = pk_fp8x4(v1);
                        if (m & 1) asm volatile("" ::: "memory"); continue;
                    }
                    if (LAYER == 1 && g >= 8 && g <= 11) {
                        const int rr = row - bidx * RB, kt = rr >> 6;
                        unsigned char* p8 = vt8 + ((size_t)(bidx * 4 + (g - 8)) * 260 + kt) * 8192 + wc * 2048 + vt8_keyoff(rr & 63) + (4 * fq) * 16;
                        st_fp8x4_strided(p8, v0); st_fp8x4_strided(p8 + 256, v1);
                        if (m & 1) asm volatile("" ::: "memory"); continue;
                    }
                    bf16_t* p = O + (size_t)row * NQKV + col0;
                    st4(p, v0); st4(p + 16, v1);
                    if (m & 1) asm volatile("" ::: "memory");
                }
        }
    }
};

struct EpiUKV {
    static constexpr bool PERM = true;
    unsigned char* k8; const LAS float* rs; unsigned char* vt8;
    DI void operator()(const f32x4 (&acc)[2][2][4][2], const Unit& u, int ui, int wr, int wc, int fr_in, int fq) const {
        int fr = fr_in;
        asm volatile("" : "+v"(fr));
        const int lr0 = wr * 64 + fr, bidx = u.pm / 65;
#pragma unroll
        for (int ai = 0; ai < 2; ++ai)
#pragma unroll
            for (int m = 0; m < 4; ++m) { const int lr = lr0 + ai * HALF + m * 16; const float s = rs[ui * 256 + lr]; const int row = u.pm * BM + lr;
                if (u.pn < 2) { const int rr = row - bidx * RB, kt = rr >> 6, kap = rr & 63;
#pragma unroll
                    for (int bj = 0; bj < 2; ++bj) { const int col = u.pn * BM + bj * HALF + wc * 32 + 8 * fq, head = col >> 6, dim = col & 63;
                        unsigned char* p = k8 + ((size_t)(bidx * 8 + head) * 260 + kt) * 4096 + (dim >> 4) * 1024 + kap * 16 + (dim & 15);
                        u32x2 w; w.x = pk_fp8x4(acc[ai][bj][m][0] * s); w.y = pk_fp8x4(acc[ai][bj][m][1] * s); *(u32x2*)p = w; }
                } else { const int rr = row - bidx * RB, kt = rr >> 6;
#pragma unroll
                    for (int bj = 0; bj < 2; ++bj) { const int col = (u.pn - 2) * BM + bj * HALF + wc * 32 + 8 * fq, head = col >> 6, d = col & 63;
                        unsigned char* p = vt8 + ((size_t)(bidx * 8 + head) * 260 + kt) * 4096 + (d >> 5) * 2048 + vt8_keyoff(rr & 63) + (d & 31) * 16;
                        st_fp8x4_strided(p, acc[ai][bj][m][0] * s); st_fp8x4_strided(p + 64, acc[ai][bj][m][1] * s); } }
            }
    }
};
struct EpiUQ {
    static constexpr bool PERM = false;
    unsigned char* q8; const LAS float* rs; const float* r32c; const float* r32s;
    DI void operator()(const f32x4 (&acc)[2][2][4][2], const Unit& u, int ui, int wr, int wc, int fr, int fq) const {
        const int bidx = u.pm / 65;
        const float C2 = 0.10206207261596577f * LOG2E * 8.f;
#pragma unroll
        for (int bj = 0; bj < 2; ++bj) {
            int off;
            if (u.pn < 2) { const int col = u.pn * BM + bj * HALF + wc * 32 + 4 * fq; off = (col >> 6) * 96 + (col & 63); }
            else off = (bj * 4 + wc) * 96 + 64 + 4 * fq;
#pragma unroll
            for (int ai = 0; ai < 2; ++ai)
#pragma unroll
                for (int m = 0; m < 4; ++m) {
                    const int lr = ai * HALF + wr * 64 + m * 16 + fr, row = u.pm * BM + lr;
                    const int s = row - (bidx * RB + CTXL);
                    const float sc = rs[ui * 256 + lr] * C2;
                    f32x4 v0 = acc[ai][bj][m][0] * sc, v1 = acc[ai][bj][m][1] * sc;
                    if (u.pn == 2) { const int pos = (fq >= 2) ? (s & 63) : (s >> 6);
                        const f32x4 c4 = *(const f32x4*)(r32c + pos * 8 + 4 * (fq & 1)), s4 = *(const f32x4*)(r32s + pos * 8 + 4 * (fq & 1));
                        const f32x4 y0 = v0 * c4 - v1 * s4, y1 = v1 * c4 + v0 * s4; v0 = y0; v1 = y1; }
                    unsigned char* p = q8 + (size_t)row * 768 + off;
                    *(unsigned*)p = pk_fp8x4(v0); *(unsigned*)(p + 16) = pk_fp8x4(v1);
                }
        }
    }
};
}

namespace att {
constexpr float THR = 8.f;
struct P {
    const unsigned char* q8; int qpitch;
    const unsigned char* k8; const unsigned char* k8r;
    const unsigned char* v8;
    unsigned char* o; int opitch;
    int nt, t_lo, kind, s0;
    float sink2, lam; const float* subln;
};
DI int crow(int r, int hi) { return (r & 3) + 8 * (r >> 2) + 4 * hi; }
DI float xsum32(float v) { auto rr = __builtin_amdgcn_permlane32_swap(__float_as_uint(v), __float_as_uint(v), false, false); return __uint_as_float(rr[0]) + __uint_as_float(rr[1]); }
DI int ximax32(int v) { auto rr = __builtin_amdgcn_permlane32_swap((unsigned)v, (unsigned)v, false, false); const int a = (int)rr[0], b = (int)rr[1]; return a > b ? a : b; }
DI float xmax32(float v) { auto rr = __builtin_amdgcn_permlane32_swap(__float_as_uint(v), __float_as_uint(v), false, false); float r; asm("v_max_f32 %0, %1, %2" : "=v"(r) : "v"(rr[0]), "v"(rr[1])); return r; }
#define ATT_WAITBAR() asm volatile("s_waitcnt vmcnt(0) lgkmcnt(0)\n\ts_barrier" ::: "memory")

DI void glds16s(unsigned voff, const void* sbase, unsigned lds_dst) { unsigned keep;
    asm volatile("s_mov_b32 %0, m0\n\ts_mov_b32 m0, %3\n\ts_nop 0\n\tglobal_load_lds_dwordx4 %1, %2\n\ts_mov_b32 m0, %0" : "=&s"(keep) : "v"(voff), "s"(sbase), "s"(lds_dst) : "memory"); }
#define ATT_WAITN_BAR(N) asm volatile("s_waitcnt vmcnt(" #N ") lgkmcnt(0)\n\ts_barrier" ::: "memory")
typedef int v8i_t __attribute__((ext_vector_type(8)));
DI f32x16 mfma_f8(v8i_t a, v8i_t b, f32x16 c) { return __builtin_amdgcn_mfma_scale_f32_32x32x64_f8f6f4(a, b, c, 0, 0, 0, 0x7f7f7f7f, 0, 0x7f7f7f7f); }
DI f32x16 mfma_f8s(v8i_t a, v8i_t b, f32x16 c, int sb) { return __builtin_amdgcn_mfma_scale_f32_32x32x64_f8f6f4(a, b, c, 0, 0, 0, 0x7f7f7f7f, 0, sb); }
typedef float f32x4v __attribute__((ext_vector_type(4)));
DI f32x4v mfma_f8s16(v8i_t a, v8i_t b, f32x4v c, int sb) { return __builtin_amdgcn_mfma_scale_f32_16x16x128_f8f6f4(a, b, c, 0, 0, 0, 0x7f7f7f7f, 0, sb); }
constexpr float F8_OFF = 4.f;
DI f32x16 mfma_f8q(v8i_t a, v8i_t b, f32x16 c) { return __builtin_amdgcn_mfma_scale_f32_32x32x64_f8f6f4(a, b, c, 0, 0, 0, 0x7f7f7f7f, 0, 0x7c7c7c7c); }
template <int MODE> DI void attn_unit_f8q(const P& p, LAS unsigned char* lds) {
    constexpr int DV = MODE == 2 ? 128 : 64;
    constexpr int NKC = MODE == 1 ? 6 : 8;
    constexpr int KSLOT = NKC * 1024, VSLOT = DV * 64, VRING = 4 * KSLOT, NDB = DV / 32;
    constexpr int NQK = MODE == 1 ? 4 : 2;
    const int tid = threadIdx.x, lane = tid & 63, r32 = lane & 31, hi = lane >> 5; const int wid = __builtin_amdgcn_readfirstlane(tid >> 6);
    const int sub = (MODE == 2) ? (wid >> 2) : 0;
    const int qrow = (MODE == 2) ? (32 * (wid & 3) + r32) : (32 * wid + r32);
    const int nt = p.nt;
    const unsigned ldsb = (unsigned)(size_t)lds;
    v8i_t qf[MODE == 1 ? 2 : 1];
    { const unsigned char* qp = p.q8 + (size_t)qrow * p.qpitch + (MODE == 2 ? sub * 64 : 0);
      const u32x4 a0 = *(const u32x4*)(qp + 32 * hi), a1 = *(const u32x4*)(qp + 32 * hi + 16);
      qf[0] = (v8i_t){(int)a0[0], (int)a0[1], (int)a0[2], (int)a0[3], (int)a1[0], (int)a1[1], (int)a1[2], (int)a1[3]};
      if (MODE == 1) { u32x4 b0 = *(const u32x4*)(qp + 64), b1 = *(const u32x4*)(qp + 80);
          if (hi) { b0 = (u32x4){0u, 0u, 0u, 0u}; b1 = b0; }
          qf[MODE == 1 ? 1 : 0] = (v8i_t){(int)b0[0], (int)b0[1], (int)b0[2], (int)b0[3], (int)b1[0], (int)b1[1], (int)b1[2], (int)b1[3]}; } }
    const int kpc = (MODE == 1) ? (wid < 6 ? wid : wid - 2) : wid;
    const int vpc = (MODE == 1) ? (wid & 3) : wid;
    const unsigned koff = (unsigned)(((MODE == 1 && kpc >= 4) ? (kpc - 4) : kpc) * 1024 + lane * 16);
    const unsigned voff = (unsigned)(vpc * 1024 + lane * 16);
    const unsigned char* kbase = (MODE == 1 && kpc >= 4) ? p.k8r : p.k8;
    const size_t kstep = (MODE == 1) ? ((kpc >= 4) ? 2048 : 4096) : 8192;
#define AQ_ISSUE_K(t) do { const int t_ = (t); if (t_ < nt) { const unsigned sb_ = ldsb + (unsigned)((t_ & 3) * KSLOT); \
        glds16s(koff, kbase + (size_t)t_ * kstep, (unsigned)__builtin_amdgcn_readfirstlane(sb_ + kpc * 1024)); } } while (0)
#define AQ_ISSUE_V(t) do { const int t_ = (t); if (t_ < nt) { const unsigned sb_ = ldsb + (unsigned)(VRING + ((t_ + 3) & 7) * VSLOT); \
        glds16s(voff, p.v8 + (size_t)t_ * VSLOT, (unsigned)__builtin_amdgcn_readfirstlane(sb_ + vpc * 1024)); } } while (0)
    float m = 0.f, l = 0.f;
    if (wid >= 4) __builtin_amdgcn_s_setprio(1);
    f32x16 o[NDB], negm, sa0, sa1, sb0, sb1;
#pragma unroll
    for (int db = 0; db < NDB; ++db)
#pragma unroll
        for (int i = 0; i < 16; ++i) o[db][i] = 0.f;
#pragma unroll
    for (int i = 0; i < 16; ++i) negm[i] = 0.f;
    const int vo = hi * 1024 + r32 * 16;
    const int ko_n = ((MODE == 2 ? sub * 4 : 0) + 2 * hi) * 1024 + r32 * 16;
    const int ko_r = 4 * 1024 + r32 * 16;
    u32x4 kfl[MODE == 1 ? 2 : 1], kfh[MODE == 1 ? 2 : 1], vfl[MODE == 1 ? 2 : 1], vfh[MODE == 1 ? 2 : 1]; v8i_t pfa, pfb;
    f32x4v ol = (f32x4v){0.f, 0.f, 0.f, 0.f};
    const int onesw = ((lane & 15) == ((lane >> 4) & 1)) ? 0x38383838 : 0;
    const v8i_t ones_fr = (v8i_t){onesw, onesw, onesw, onesw, onesw, onesw, onesw, onesw};
#define AQ_SB() __builtin_amdgcn_sched_barrier(0)
#define AQ_LDKF(s_, j, Ks_) do { const int o_ = ((MODE == 1 && ((j) >> 1)) ? ko_r : ko_n) + ((j) & 1) * 512; kfl[s_] = *(const LAS u32x4*)((Ks_) + o_); kfh[s_] = *(const LAS u32x4*)((Ks_) + o_ + 1024); } while (0)
#define AQ_LDVF(s_, db, Vs_) do { vfl[s_] = *(const LAS u32x4*)((Vs_) + (db) * 2048); vfh[s_] = *(const LAS u32x4*)((Vs_) + (db) * 2048 + 512); } while (0)
#define AQ_KF(s_) ((v8i_t){(int)kfl[s_][0], (int)kfl[s_][1], (int)kfl[s_][2], (int)kfl[s_][3], (int)kfh[s_][0], (int)kfh[s_][1], (int)kfh[s_][2], (int)kfh[s_][3]})
#define AQ_VF(s_) ((v8i_t){(int)vfl[s_][0], (int)vfl[s_][1], (int)vfl[s_][2], (int)vfl[s_][3], (int)vfh[s_][0], (int)vfh[s_][1], (int)vfh[s_][2], (int)vfh[s_][3]})
#define AQ_Q(j, s_, N0, N1) do { if ((j) & 1) { if ((j) < 2) N1 = mfma_f8q(AQ_KF(s_), qf[0], negm); else N1 = mfma_f8q(AQ_KF(s_), qf[MODE == 1 ? 1 : 0], N1); asm volatile("" : "+v"(N1)); } \
        else { if ((j) < 2) N0 = mfma_f8q(AQ_KF(s_), qf[0], negm); else N0 = mfma_f8q(AQ_KF(s_), qf[MODE == 1 ? 1 : 0], N0); asm volatile("" : "+v"(N0)); } } while (0)
#define AQ_P(db, s_, PF) do { o[db] = mfma_f8(AQ_VF(s_), PF, o[db]); asm volatile("" : "+v"(o[db])); } while (0)
#define AQ_PL(PF) do { ol = mfma_f8s16(ones_fr, PF, ol, 0x7f7f7f7f); asm volatile("" : "+v"(ol)); } while (0)
#define AQ_EXP8(g, C) do { const int b_ = 8 * ((g) & 1); _Pragma("unroll") for (int i_ = 0; i_ < 8; ++i_) { C[b_ + i_] = fast_exp2(C[b_ + i_]); asm volatile("" : "+v"(C[b_ + i_])); } } while (0)
#define AQ_CVT4(g, C, PF) do { const int b_ = 8 * ((g) & 1); \
        int w0_, w1_; asm volatile("" : "=v"(w0_), "=v"(w1_));                                                    \
        w0_ = __builtin_amdgcn_cvt_pk_fp8_f32(C[b_ + 0], C[b_ + 1], w0_, false); w0_ = __builtin_amdgcn_cvt_pk_fp8_f32(C[b_ + 2], C[b_ + 3], w0_, true); \
        w1_ = __builtin_amdgcn_cvt_pk_fp8_f32(C[b_ + 4], C[b_ + 5], w1_, false); w1_ = __builtin_amdgcn_cvt_pk_fp8_f32(C[b_ + 6], C[b_ + 7], w1_, true); \
        asm volatile("" : "+v"(w0_), "+v"(w1_)); PF[2 * (g)] = w0_; PF[2 * (g) + 1] = w1_; } while (0)
#define AQ_EXP(g, C0, C1) do { if ((g) < 2) AQ_EXP8(g, C0); else AQ_EXP8(g, C1); } while (0)
#define AQ_CVT(g, C0, C1, PF) do { if ((g) < 2) AQ_CVT4(g, C0, PF); else AQ_CVT4(g, C1, PF); } while (0)
#define AQ_IMAX(a_, b_) ((a_) > (b_) ? (a_) : (b_))
#define AQ_TILE(C0, C1, N0, N1, PFC, PFP, HASN, HASP, MID, tm, KSC, VSC) do { \
        const LAS unsigned char* Ks_ = ((KSC) >= 0) ? lds + (KSC) * KSLOT : lds + ks_next * KSLOT;                   \
        const LAS unsigned char* Vs_ = ((VSC) >= 0) ? vqb + (VSC) * VSLOT : lds + VRING + vs_prev * VSLOT + vo; \
        if (HASN) { AQ_LDKF(0, 0, Ks_); if (MODE == 1) AQ_LDKF(1, 1, Ks_); } if (HASP) { AQ_LDVF(0, 0, Vs_); if (MODE == 1) AQ_LDVF(1, 1, Vs_); } \
        AQ_EXP(0, C0, C1); AQ_SB(); \
        if (MODE == 1) { if (HASN) { AQ_Q(0, 0, N0, N1); AQ_Q(1, 1, N0, N1); AQ_LDKF(0, 2, Ks_); AQ_LDKF(1, 3, Ks_); } } \
        else { if (HASN) { AQ_Q(0, 0, N0, N1); AQ_LDKF(0, 1, Ks_); } if (HASP) { AQ_P(0, 0, PFP); AQ_LDVF(0, 1, Vs_); } } AQ_SB(); \
        AQ_CVT(0, C0, C1, PFC); AQ_EXP(1, C0, C1); AQ_SB(); \
        if (MODE == 1) { if (HASN) { AQ_Q(2, 0, N0, N1); AQ_Q(3, 1, N0, N1); } } \
        else { if (HASN) AQ_Q(1, 0, N0, N1); if (HASP) { AQ_P(1, 0, PFP); AQ_LDVF(0, 2, Vs_); } } AQ_SB(); \
        AQ_CVT(1, C0, C1, PFC); AQ_SB(); \
        if (MID) ATT_WAITN_BAR(0);                                         \
        if (HASP) { if (MODE == 1) { AQ_P(0, 0, PFP); AQ_P(1, 1, PFP); } else { AQ_P(2, 0, PFP); AQ_LDVF(0, 3, Vs_); AQ_PL(PFP); } } \
        if (MID) { AQ_ISSUE_K((tm) + 4); AQ_ISSUE_K((tm) + 5); AQ_ISSUE_V((tm) + 2); AQ_ISSUE_V((tm) + 3); } AQ_SB(); \
        AQ_EXP(2, C0, C1); AQ_CVT(2, C0, C1, PFC); AQ_EXP(3, C0, C1); AQ_SB(); \
        if (HASP) { if (MODE == 1) AQ_PL(PFP); else AQ_P(3, 0, PFP); } AQ_SB(); \
        AQ_CVT(3, C0, C1, PFC); \
        if (HASN) { int ri_ = AQ_IMAX(AQ_IMAX(__float_as_int(N0[0]), __float_as_int(N1[0])), __float_as_int(N0[1]));     \
            _Pragma("unroll") for (int i_ = 1; i_ < 15; ++i_) ri_ = AQ_IMAX(AQ_IMAX(ri_, __float_as_int(N1[i_])), __float_as_int(N0[i_ + 1])); \
            ri_ = AQ_IMAX(ri_, __float_as_int(N1[15])); \
            if (__any(__int_as_float(ri_) > THR)) {                                                                                    \
                const float rm_ = __int_as_float(ximax32(ri_)); \
                { const LAS unsigned char* Vn_ = lds + VRING + ((vs_prev + 1) & 7) * VSLOT + vo;                    \
                  _Pragma("unroll") for (int db_ = 0; db_ < NDB; ++db_) { AQ_LDVF(0, db_, Vn_); AQ_P(db_, 0, PFC); } AQ_PL(PFC); \
                  _Pragma("unroll") for (int i_ = 0; i_ < 8; ++i_) PFC[i_] = 0; } \
                const float dl_ = fmaxf(rm_ - F8_OFF, 0.f); m += dl_; const float f_ = fast_exp2(-dl_); ol[0] *= __shfl(f_, lane & 15); ol[1] *= __shfl(f_, (lane & 15) + 16); \
                _Pragma("unroll") for (int i_ = 0; i_ < 16; ++i_) { N0[i_] -= dl_; N1[i_] -= dl_; negm[i_] = -m; } \
                _Pragma("unroll") for (int db_ = 0; db_ < NDB; ++db_) _Pragma("unroll") for (int i_ = 0; i_ < 16; ++i_) o[db_][i_] *= f_; } } \
        ks_next = (ks_next + 1) & 3; vs_prev = (vs_prev + 1) & 7; } while (0)
    AQ_ISSUE_K(0); AQ_ISSUE_K(1); AQ_ISSUE_K(2); AQ_ISSUE_V(0);
    ATT_WAITN_BAR(0);
    { const LAS unsigned char* Ks_ = lds;
#pragma unroll
      for (int j = 0; j < NQK; ++j) { AQ_LDKF(MODE == 1 ? (j & 1) : 0, j, Ks_); AQ_Q(j, MODE == 1 ? (j & 1) : 0, sa0, sa1); }
      float rm = fmaxf(sa0[0], sa1[0]);
#pragma unroll
      for (int i = 1; i < 16; ++i) rm = fmaxf(fmaxf(rm, sa0[i]), sa1[i]);
      rm = xmax32(rm) - F8_OFF; m = rm;
#pragma unroll
      for (int i = 0; i < 16; ++i) { sa0[i] -= rm; sa1[i] -= rm; negm[i] = -rm; } }
    const LAS unsigned char* vqb = lds;
    int ks_next = 1, vs_prev = 2;
    ATT_WAITN_BAR(0); AQ_ISSUE_K(3); AQ_ISSUE_K(4); AQ_ISSUE_V(1); AQ_ISSUE_V(2);
    AQ_TILE(sa0, sa1, sb0, sb1, pfa, pfb, true, false, false, 0, -1, -1); AQ_TILE(sb0, sb1, sa0, sa1, pfb, pfa, true, true, true, 1, -1, -1);
    int t = 2;
    for (; t + 4 <= nt - 2; t += 4) {
        vqb = lds + VRING + ((t + 2) & 7) * VSLOT + vo;
        AQ_TILE(sa0, sa1, sb0, sb1, pfa, pfb, true, true, false, 0, 3, 0); AQ_TILE(sb0, sb1, sa0, sa1, pfb, pfa, true, true, true, t + 1, 0, 1);
        AQ_TILE(sa0, sa1, sb0, sb1, pfa, pfb, true, true, false, 0, 1, 2); AQ_TILE(sb0, sb1, sa0, sa1, pfb, pfa, true, true, true, t + 3, 2, 3);
    }
    for (; t < nt - 2; t += 2) {
        AQ_TILE(sa0, sa1, sb0, sb1, pfa, pfb, true, true, false, 0, -1, -1); AQ_TILE(sb0, sb1, sa0, sa1, pfb, pfa, true, true, true, t + 1, -1, -1);
    }
    AQ_TILE(sa0, sa1, sb0, sb1, pfa, pfb, true, true, false, 0, -1, -1); AQ_TILE(sb0, sb1, sa0, sa1, pfb, pfa, false, true, true, nt - 1, -1, -1);
    { const LAS unsigned char* Vs_ = lds + VRING + vs_prev * VSLOT + vo;
      if (MODE == 1) { AQ_LDVF(0, 0, Vs_); AQ_LDVF(1, 1, Vs_); AQ_P(0, 0, pfb); AQ_P(1, 1, pfb); }
      else {
#pragma unroll
          for (int db = 0; db < NDB; ++db) { AQ_LDVF(0, db, Vs_); AQ_P(db, 0, pfb); } }
      AQ_PL(pfb); }
    { const float l0 = __shfl(ol[0], lane & 15), l1 = __shfl(ol[1], lane & 15); l = (lane & 16) ? l1 : l0; }
    const float inv = fast_rcp(l);
    if (MODE != 2) {
#pragma unroll
        for (int db = 0; db < NDB; ++db)
#pragma unroll
            for (int g = 0; g < 4; ++g) { const f32x4 v4 = (f32x4){o[db][4 * g], o[db][4 * g + 1], o[db][4 * g + 2], o[db][4 * g + 3]} * inv;
                *(unsigned*)(p.o + (size_t)qrow * p.opitch + 32 * db + 8 * g + 4 * hi) = pg8::pk_fp8x4(v4 * 32.f); }
    } else {
        LAS float* X = (LAS float*)lds;
        ATT_WAITBAR();
        if (sub == 1) {
#pragma unroll
            for (int db = 0; db < NDB; ++db)
#pragma unroll
                for (int i = 0; i < 16; ++i) X[((wid - 4) * 64 + db * 16 + i) * 64 + lane] = o[db][i] * inv;
        }
        ATT_WAITBAR();
        if (sub == 0) {
            float ss = 0.f;
#pragma unroll
            for (int db = 0; db < NDB; ++db)
#pragma unroll
                for (int i = 0; i < 16; ++i) { const float val = o[db][i] * inv - p.lam * X[(wid * 64 + db * 16 + i) * 64 + lane]; o[db][i] = val; ss += val * val; }
            ss = xsum32(ss);
            const float rstd = (1.0f - LAM_INIT) / sqrtf(ss * (1.0f / 128.0f) + 1e-6f);
#pragma unroll
            for (int db = 0; db < NDB; ++db)
#pragma unroll
                for (int g = 0; g < 4; ++g) { const int d = 32 * db + 8 * g + 4 * hi; const f32x4 w4 = *(const f32x4*)(p.subln + d);
                    const f32x4 v4 = (f32x4){o[db][4 * g], o[db][4 * g + 1], o[db][4 * g + 2], o[db][4 * g + 3]} * rstd * w4;
                    *(unsigned*)(p.o + (size_t)qrow * p.opitch + d) = pg8::pk_fp8x4(v4 * 32.f); }
        }
    }
    __builtin_amdgcn_s_setprio(0);
    ATT_WAITBAR();
#undef AQ_ISSUE_K
#undef AQ_ISSUE_V
#undef AQ_SB
#undef AQ_LDKF
#undef AQ_LDVF
#undef AQ_KF
#undef AQ_VF
#undef AQ_Q
#undef AQ_P
#undef AQ_PL
#undef AQ_EXP8
#undef AQ_CVT4
#undef AQ_EXP
#undef AQ_CVT
#undef AQ_IMAX
#undef AQ_TILE
}

DI void attn_unit_f8l0(const P& p, LAS unsigned char* lds, const LAS float* rpbL) {
    constexpr int KSLOT = 4096, VSLOT = 4096, VRING = 3 * KSLOT, NDB = 2;
    const int tid = threadIdx.x, lane = tid & 63, r32 = lane & 31, hi = lane >> 5; const int wid = __builtin_amdgcn_readfirstlane(tid >> 6);
    const int qrow = 32 * wid + r32;
    const int nt = p.nt;
    const unsigned ldsb = (unsigned)(size_t)lds;
    v8i_t qf;
    { const unsigned char* qp = p.q8 + (size_t)qrow * p.qpitch;
      const u32x4 a0 = *(const u32x4*)(qp + 32 * hi), a1 = *(const u32x4*)(qp + 32 * hi + 16);
      qf = (v8i_t){(int)a0[0], (int)a0[1], (int)a0[2], (int)a0[3], (int)a1[0], (int)a1[1], (int)a1[2], (int)a1[3]}; }
    const bool isk = wid < 4; const int pc = wid & 3;
    const unsigned doff = (unsigned)(pc * 1024 + lane * 16);
    const unsigned char* dbase = isk ? p.k8 : p.v8;
#define L0_UT(t) (((t) >= 4) ? (p.t_lo + (t) - 4) : (t))
#define L0_ISSUE(t) do { const int tt_ = isk ? (t) + 3 : (t) + 2; if (tt_ >= 0 && tt_ < nt) { const unsigned sb_ = ldsb + (unsigned)((isk ? 0 : VRING) + (tt_ % 3) * 4096); \
        glds16s(doff, dbase + (size_t)L0_UT(tt_) * 4096, (unsigned)__builtin_amdgcn_readfirstlane(sb_ + pc * 1024)); } } while (0)
    float m = 0.f, l = 0.f;
    f32x16 o[NDB], negm, sa0, sa1, sb0, sb1, ol;
#pragma unroll
    for (int db = 0; db < NDB; ++db)
#pragma unroll
        for (int i = 0; i < 16; ++i) o[db][i] = 0.f;
#pragma unroll
    for (int i = 0; i < 16; ++i) { negm[i] = 0.f; ol[i] = 0.f; }
    const int onesw = (r32 == 0) ? 0x38383838 : 0;
    const v8i_t ones_fr = (v8i_t){onesw, onesw, onesw, onesw, onesw, onesw, onesw, onesw};
    const bool has_sink = (p.kind & 1) == 0;
    const int vo = hi * 1024 + r32 * 16;
    const int ko_n = (2 * hi) * 1024 + r32 * 16;
    u32x4 klo[2], khi[2]; v8i_t pf; u32x4 vlo[NDB], vhi[NDB];
#define L0_SB() __builtin_amdgcn_sched_barrier(0)
#define L0_LDK(j, Ks_) do { klo[j] = *(const LAS u32x4*)((Ks_) + ko_n + (j) * 512); khi[j] = *(const LAS u32x4*)((Ks_) + ko_n + (j) * 512 + 1024); } while (0)
#define L0_LDV(Vs_) do { _Pragma("unroll") for (int db_ = 0; db_ < NDB; ++db_) { vlo[db_] = *(const LAS u32x4*)((Vs_) + db_ * 2048); vhi[db_] = *(const LAS u32x4*)((Vs_) + db_ * 2048 + 512); } } while (0)
#define L0_KFR(j) ((v8i_t){(int)klo[j][0], (int)klo[j][1], (int)klo[j][2], (int)klo[j][3], (int)khi[j][0], (int)khi[j][1], (int)khi[j][2], (int)khi[j][3]})
#define L0_PV() do { _Pragma("unroll") for (int db_ = 0; db_ < NDB; ++db_) { \
        const v8i_t vfr_ = (v8i_t){(int)vlo[db_][0], (int)vlo[db_][1], (int)vlo[db_][2], (int)vlo[db_][3], (int)vhi[db_][0], (int)vhi[db_][1], (int)vhi[db_][2], (int)vhi[db_][3]}; \
        o[db_] = mfma_f8(vfr_, pf, o[db_]); } ol = mfma_f8(ones_fr, pf, ol); } while (0)
#define L0_VALU8(g, C) do { const int b_ = 8 * ((g) & 1); \
        _Pragma("unroll") for (int i_ = 0; i_ < 8; ++i_) { C[b_ + i_] = fast_exp2(C[b_ + i_]); } \
        int w0_, w1_; asm volatile("" : "=v"(w0_), "=v"(w1_));                                                    \
        w0_ = __builtin_amdgcn_cvt_pk_fp8_f32(C[b_ + 0], C[b_ + 1], w0_, false); w0_ = __builtin_amdgcn_cvt_pk_fp8_f32(C[b_ + 2], C[b_ + 3], w0_, true); \
        w1_ = __builtin_amdgcn_cvt_pk_fp8_f32(C[b_ + 4], C[b_ + 5], w1_, false); w1_ = __builtin_amdgcn_cvt_pk_fp8_f32(C[b_ + 6], C[b_ + 7], w1_, true); \
        asm volatile("" : "+v"(w0_), "+v"(w1_)); pf[2 * (g)] = w0_; pf[2 * (g) + 1] = w1_; } while (0)
#define L0_VALU(g, C0, C1) do { if ((g) < 2) L0_VALU8(g, C0); else L0_VALU8(g, C1); } while (0)
#define L0_CR(i_) (((i_) & 3) + 8 * ((i_) >> 2))
#define L0_MASK(tn, N0, N1) do { if ((tn) >= 4) { const int ut_ = L0_UT(tn); \
        if (p.kind == 0) { const int kb_ = (ut_ - 4) * 64 - (p.s0 + qrow) + 4 * hi + 128;                 \
            if (!__all(kb_ >= 0 && kb_ + 59 <= 256)) { \
            _Pragma("unroll") for (int i_ = 0; i_ < 16; ++i_) { if ((unsigned)(kb_ + L0_CR(i_)) > 256u) N0[i_] = -INFINITY; if ((unsigned)(kb_ + L0_CR(i_) + 32) > 256u) N1[i_] = -INFINITY; } } \
        } else if (p.kind == 1) { const int kr_ = ut_ - 4, r_ = (p.s0 >> 6) + (wid >> 1), qc_ = 32 * (wid & 1) + r32; int rs_ = r_ - 4; rs_ = rs_ < 0 ? 0 : (rs_ > 248 ? 248 : rs_); \
            const bool rowok_ = (kr_ >= rs_) && (kr_ < rs_ + 8); int cs_ = qc_ - 8; cs_ = cs_ < 0 ? 0 : (cs_ > 48 ? 48 : cs_); \
            int bri_ = kr_ - r_ + 7; bri_ = bri_ < 0 ? 0 : (bri_ > 14 ? 14 : bri_); \
            const LAS float* bp_ = rpbL + bri_ * 31 + (4 * hi - qc_ + 15);                                  \
            const int cb_ = rowok_ ? (4 * hi - cs_) : 4096;                                                     \
            _Pragma("unroll") for (int i_ = 0; i_ < 16; ++i_) { \
                const float b0_ = bp_[L0_CR(i_)], b1_ = bp_[L0_CR(i_) + 32]; \
                N0[i_] = ((unsigned)(cb_ + L0_CR(i_)) < 16u) ? N0[i_] + b0_ : -INFINITY; N1[i_] = ((unsigned)(cb_ + L0_CR(i_) + 32) < 16u) ? N1[i_] + b1_ : -INFINITY; } } } } while (0)
#define L0_TILE(t, C0, C1, N0, N1, HASN) do { \
        const LAS unsigned char* Ks_ = lds + ks_next * KSLOT; const LAS unsigned char* Vs_ = lds + VRING + vs_cur * VSLOT + vo; \
        if (HASN) L0_LDK(0, Ks_); L0_VALU(0, C0, C1); L0_SB(); \
        L0_VALU(1, C0, C1); if (HASN) { N0 = mfma_f8q(L0_KFR(0), qf, negm); asm volatile("" : "+v"(N0)); } L0_SB(); \
        if (HASN) L0_LDK(1, Ks_); L0_VALU(2, C0, C1); L0_SB(); \
        L0_LDV(Vs_); L0_VALU(3, C0, C1); if (HASN) { N1 = mfma_f8q(L0_KFR(1), qf, negm); asm volatile("" : "+v"(N1)); } L0_SB(); \
        L0_PV(); \
        if (HASN) { L0_MASK((t) + 1, N0, N1); float rm_ = fmaxf(N0[0], N1[0]); \
            _Pragma("unroll") for (int i_ = 1; i_ < 16; ++i_) rm_ = fmaxf(fmaxf(rm_, N0[i_]), N1[i_]); \
            rm_ = xmax32(rm_); \
            if (__any(rm_ > THR)) { const float dl_ = fmaxf(rm_ - F8_OFF, 0.f); m += dl_; const float f_ = fast_exp2(-dl_); ol[0] *= f_; \
                _Pragma("unroll") for (int i_ = 0; i_ < 16; ++i_) { N0[i_] -= dl_; N1[i_] -= dl_; negm[i_] = -m; } \
                _Pragma("unroll") for (int db_ = 0; db_ < NDB; ++db_) _Pragma("unroll") for (int i_ = 0; i_ < 16; ++i_) o[db_][i_] *= f_; } } \
        ks_next = (ks_next == 2) ? 0 : ks_next + 1; vs_cur = (vs_cur == 2) ? 0 : vs_cur + 1; } while (0)
#define L0_TOP(t) do { if ((t) + 2 < nt) ATT_WAITN_BAR(1); else ATT_WAITN_BAR(0); L0_ISSUE(t); } while (0)
    L0_ISSUE(-3);
    L0_ISSUE(-2);
    ATT_WAITBAR();
    L0_ISSUE(-1);
    { const LAS unsigned char* Ks_ = lds;
      L0_LDK(0, Ks_); L0_LDK(1, Ks_); sa0 = mfma_f8q(L0_KFR(0), qf, negm); sa1 = mfma_f8q(L0_KFR(1), qf, negm);
      float rm = fmaxf(sa0[0], sa1[0]);
#pragma unroll
      for (int i = 1; i < 16; ++i) rm = fmaxf(fmaxf(rm, sa0[i]), sa1[i]);
      rm = xmax32(rm); if (has_sink) rm = fmaxf(rm, p.sink2);
      rm -= F8_OFF; m = rm;
#pragma unroll
      for (int i = 0; i < 16; ++i) { sa0[i] -= rm; sa1[i] -= rm; negm[i] = -rm; }
      if (has_sink && hi == 0) ol[0] = fast_exp2(p.sink2 - m); }
    int ks_next = 1, vs_cur = 0;
    for (int t = 0; t < nt - 2; t += 2) {
        L0_TOP(t);     L0_TILE(t, sa0, sa1, sb0, sb1, true);
        L0_TOP(t + 1); L0_TILE(t + 1, sb0, sb1, sa0, sa1, true);
    }
    L0_TOP(nt - 2); L0_TILE(nt - 2, sa0, sa1, sb0, sb1, true);
    ATT_WAITN_BAR(0); L0_TILE(nt - 1, sb0, sb1, sa0, sa1, false);
    l = hi ? 0.f : ol[0];
    const float inv = fast_rcp(xsum32(l));
#pragma unroll
    for (int db = 0; db < NDB; ++db)
#pragma unroll
        for (int g = 0; g < 4; ++g) { const f32x4 v4 = (f32x4){o[db][4 * g], o[db][4 * g + 1], o[db][4 * g + 2], o[db][4 * g + 3]} * inv;
            *(unsigned*)(p.o + (size_t)qrow * p.opitch + 32 * db + 8 * g + 4 * hi) = pg8::pk_fp8x4(v4 * 32.f); }
    ATT_WAITBAR();
#undef L0_UT
#undef L0_ISSUE
#undef L0_SB
#undef L0_LDK
#undef L0_LDV
#undef L0_KFR
#undef L0_PV
#undef L0_VALU8
#undef L0_VALU
#undef L0_MASK
#undef L0_CR
#undef L0_TILE
#undef L0_TOP
}
}

struct Ctx {
    LAS unsigned char* lds; gu32* ctl; unsigned char* ws;
    int tid, lane, wave, vcu, G;
    const float* const __attribute__((address_space(4)))* inp;
    float* out;
};
DI const float* modp(const Ctx& F, int l, int which, int chunk) { return (const float*)(F.ws + WS_MOD) + ((size_t)(l * 3 + which) * 6 + chunk) * 1024; }

DI void ld_f32(const float* p, int lane, f32x4 (&v)[4]) {
#pragma unroll
    for (int j = 0; j < 4; ++j) v[j] = *(const f32x4*)(p + 4 * lane + 256 * j); }
DI void ld_bf16(const bf16_t* p, int lane, f32x4 (&v)[4]) {
#pragma unroll
    for (int j = 0; j < 4; ++j) { const u32x2 w = *(const u32x2*)(p + 4 * lane + 256 * j); v[j] = (f32x4){bf_lo(w.x), bf_hi(w.x), bf_lo(w.y), bf_hi(w.y)}; } }
DI void st_f32(float* p, int lane, const f32x4 (&v)[4]) {
#pragma unroll
    for (int j = 0; j < 4; ++j) *(f32x4*)(p + 4 * lane + 256 * j) = v[j]; }
DI void st_bf16(bf16_t* p, int lane, const f32x4 (&v)[4]) {
#pragma unroll
    for (int j = 0; j < 4; ++j) pg8::st4(p + 4 * lane + 256 * j, v[j]); }
DI void st_fp8row(unsigned char* p, int lane, const f32x4 (&v)[4]) {
#pragma unroll
    for (int j = 0; j < 4; ++j) *(unsigned*)(p + 4 * lane + 256 * j) = pg8::pk_fp8x4(v[j]); }
DI void ld_f32_nt(const float* p, int lane, f32x4 (&v)[4]) {
#pragma unroll
    for (int j = 0; j < 4; ++j) v[j] = __builtin_nontemporal_load((const f32x4*)(p + 4 * lane + 256 * j)); }
DI void ld_bf16_nt(const bf16_t* p, int lane, f32x4 (&v)[4]) {
#pragma unroll
    for (int j = 0; j < 4; ++j) { const u32x2 w = __builtin_nontemporal_load((const u32x2*)(p + 4 * lane + 256 * j)); v[j] = (f32x4){bf_lo(w.x), bf_hi(w.x), bf_lo(w.y), bf_hi(w.y)}; } }
DI void st_f32_nt(float* p, int lane, const f32x4 (&v)[4]) {
#pragma unroll
    for (int j = 0; j < 4; ++j) __builtin_nontemporal_store(v[j], (f32x4*)(p + 4 * lane + 256 * j)); }
DI void ld_fp8x64_nt(const unsigned char* p, int lane, f32x4 (&v)[4]) {
#pragma unroll
    for (int j = 0; j < 4; ++j) { const int w = (int)__builtin_nontemporal_load((const unsigned*)(p + 4 * lane + 256 * j));
        const auto lo = __builtin_amdgcn_cvt_pk_f32_fp8(w, false), hi = __builtin_amdgcn_cvt_pk_f32_fp8(w, true);
        v[j] = (f32x4){lo[0], lo[1], hi[0], hi[1]} * (1.f / 64.f); } }
DI void st_bf16_nt(bf16_t* p, int lane, const f32x4 (&v)[4]) {
#pragma unroll
    for (int j = 0; j < 4; ++j) { u32x2 w; w.x = cvtpk(v[j][0], v[j][1]); w.y = cvtpk(v[j][2], v[j][3]); __builtin_nontemporal_store(w, (u32x2*)(p + 4 * lane + 256 * j)); } }
DI void layer_norm_row(f32x4 (&v)[4], const float* g, const float* b, int lane) {
    float s = 0.f;
#pragma unroll
    for (int j = 0; j < 4; ++j) s += (v[j][0] + v[j][1]) + (v[j][2] + v[j][3]);
    const float mean = wave_sum(s) * (1.f / 1024.f); float s2 = 0.f;
#pragma unroll
    for (int j = 0; j < 4; ++j) { v[j] = v[j] - mean; s2 += (v[j][0] * v[j][0] + v[j][1] * v[j][1]) + (v[j][2] * v[j][2] + v[j][3] * v[j][3]); }
    const float rstd = 1.0f / sqrtf(wave_sum(s2) * (1.f / 1024.f) + 1e-5f);
    f32x4 gg[4], bb[4]; ld_f32(g, lane, gg); ld_f32(b, lane, bb);
#pragma unroll
    for (int j = 0; j < 4; ++j) v[j] = v[j] * rstd * gg[j] + bb[j];
}
DI void modulate_row(f32x4 (&h)[4], const f32x4 (&v)[4], const float* sc, const float* sh, int lane) {
    f32x4 a[4], b[4]; ld_f32(sc, lane, a); ld_f32(sh, lane, b);
#pragma unroll
    for (int j = 0; j < 4; ++j) h[j] = v[j] * (1.0f + a[j]) + b[j];
}

DI void conv_item(const float* W, int K, int Nsrc, bf16_t* WT, int Ndst, int kind, const float* gk, LAS float* scr, int item, int lane, bool f8 = false) {
    const int nblk = Ndst / 32, kb = item / nblk, nb = item % nblk, k0 = 64 * kb, n0 = 32 * nb;
    int srcb = n0; bool perm = false;
    if (kind == 1) { if (n0 < 512) srcb = 672 + n0; else if (n0 < 1024) srcb = 1184 + (n0 - 512); else if (n0 < 1536) srcb = 1696 + (n0 - 1024); else if (n0 < 1920) srcb = n0 - 1536;
                     else if (n0 < 2176) srcb = 384 + (n0 - 1920); else if (n0 == 2176) { srcb = 640; perm = true; } else srcb = -1; }
    else if (kind == 2) { if (n0 < 512) srcb = (n0 >> 6) * 96 + (n0 & 63); else { srcb = ((n0 - 512) >> 5) * 96 + 64; perm = true; } }
    else if (kind == 3) { if (n0 < 512) srcb = (n0 >> 6) * 128 + (n0 & 63); else srcb = ((n0 - 512) >> 6) * 128 + 64 + ((n0 - 512) & 63); }
    else if (kind == 4) { const int pn = n0 >> 8, w = n0 & 255; srcb = (w < 128) ? (128 * pn + w) : (512 + 128 * pn + (w - 128)); }
    const int nl = lane & 31; int sc = nl; if (perm) sc = (nl < 8) ? nl : (nl < 16 ? nl + 8 : (nl < 24 ? nl - 8 : nl));
    float vv[32];
#pragma unroll
    for (int i = 0; i < 32; ++i) { const int kk = 2 * i + (lane >> 5); vv[i] = (srcb >= 0) ? __builtin_nontemporal_load(W + (size_t)(k0 + kk) * Nsrc + srcb + sc) : 0.f; }
    if (gk) {
#pragma unroll
        for (int i = 0; i < 32; ++i) vv[i] *= gk[k0 + 2 * i + (lane >> 5)]; }
#pragma unroll
    for (int i = 0; i < 32; ++i) scr[(2 * i + (lane >> 5)) * 33 + nl] = vv[i];
    asm volatile("s_waitcnt lgkmcnt(0)" ::: "memory");
    const int c = lane & 7;
#pragma unroll
    for (int j = 0; j < 4; ++j) { const int n = (lane >> 3) + 8 * j; const LAS float* s = scr + (8 * c) * 33 + n;
        u32x4 o; o.x = cvtpk(s[0 * 33], s[1 * 33]); o.y = cvtpk(s[2 * 33], s[3 * 33]); o.z = cvtpk(s[4 * 33], s[5 * 33]); o.w = cvtpk(s[6 * 33], s[7 * 33]);
        if (f8) { u32x2 o8; o8.x = pg8::pk_fp8x4((f32x4){s[0 * 33], s[1 * 33], s[2 * 33], s[3 * 33]} * 64.f); o8.y = pg8::pk_fp8x4((f32x4){s[4 * 33], s[5 * 33], s[6 * 33], s[7 * 33]} * 64.f);
            *(u32x2*)((unsigned char*)WT + (size_t)(n0 + n) * K + k0 + 8 * c) = o8; }
        else __builtin_nontemporal_store(o, (u32x4*)(WT + (size_t)(n0 + n) * K + k0 + 8 * c)); }
    asm volatile("s_waitcnt lgkmcnt(0)" ::: "memory");
}

DI void phase_prologue(const Ctx& F) {
    LAS float* sl = (LAS float*)F.lds;
    LAS float* red = sl + 3072;
    for (int u = blockIdx.x; u < 193; u += F.G) {
        if (u < 192) {
            const int l = u / 96, n0 = (u % 96) * 64;
            for (int idx = F.tid; idx < 3072; idx += 512) { const int which = idx >> 10, k = idx & 1023; const float v = which < 2 ? F.inp[1][which * 1024 + k] : F.inp[3][k]; sl[idx] = v * fast_rcp(1.f + fast_exp2(-v * LOG2E)); }
            __syncthreads();
            float a0 = 0.f, a1 = 0.f, a2 = 0.f; const float* wp = F.inp[4] + ((size_t)l * 1024 + F.wave * 128) * 6144 + n0 + F.lane;
#pragma unroll 8
            for (int k = 0; k < 128; ++k) { const float w = __builtin_nontemporal_load(wp + (size_t)k * 6144); const int kk = F.wave * 128 + k; a0 += sl[kk] * w; a1 += sl[1024 + kk] * w; a2 += sl[2048 + kk] * w; }
            red[(F.wave * 3 + 0) * 64 + F.lane] = a0; red[(F.wave * 3 + 1) * 64 + F.lane] = a1; red[(F.wave * 3 + 2) * 64 + F.lane] = a2;
            __syncthreads();
            if (F.wave < 3) { float s = F.inp[5][l * 6144 + n0 + F.lane];
#pragma unroll
                for (int w = 0; w < 8; ++w) s += red[(w * 3 + F.wave) * 64 + F.lane];
                ((float*)(F.ws + WS_MOD))[(size_t)(l * 3 + F.wave) * 6144 + n0 + F.lane] = s; }
            __syncthreads();
        } else {
            float* r64c = (float*)(F.ws + WS_ROPE); float* r64s = r64c + 4096; float* r32c = r64s + 4096; float* r32s = r32c + 2048;
            for (int idx = F.tid; idx < 4096 + 2048; idx += 512) {
                const bool big = idx < 4096; const int id = big ? idx : idx - 4096; const int pos = big ? (id >> 4) : (id >> 3), i = big ? (id & 15) : (id & 7);
                const float inv = exp2f(-(float)i * (big ? (13.287712379549449f / 16.f) : (13.287712379549449f / 8.f)));
                const float ang = (float)pos * inv;
                const float kq = rintf(ang * 0.15915494309189535f);
                float r = fmaf(-kq, 6.2831854820251465f, ang); r = fmaf(-kq, -1.7484555314695172e-07f, r);
                const float cs = __cosf(r), sn = __sinf(r);
                if (big) { r64c[id] = cs; r64s[id] = sn; } else { r32c[id] = cs; r32s[id] = sn; }
            }
        }
    }
    __syncthreads();
    LAS float* scr = (LAS float*)(F.lds + F.wave * 8448);
    const int gw = F.vcu * 8 + F.wave, NGW = F.G * 8;
    constexpr int I_IN = 16 * 72, I_SQ = 16 * 32, I_UQ = 6 * 24, I_UKV = 4 * 32;
    constexpr int NITEMS = 2 * I_IN + 2 * I_SQ + I_UQ + I_UKV;
    for (int it = gw; it < NITEMS; it += NGW) {
        int r = it;
        if (r < I_IN) { conv_item(F.inp[8], 1024, 2304, (bf16_t*)(F.ws + WS_WAB_IN), 2304, 0, nullptr, scr, r, F.lane, true); continue; } r -= I_IN;
        if (r < I_IN) { conv_item(F.inp[12], 1024, 2208, (bf16_t*)(F.ws + WS_WCD_IN), 2304, 1, nullptr, scr, r, F.lane, true); continue; } r -= I_IN;
        if (r < I_SQ) { conv_item(F.inp[11], 1024, 1024, (bf16_t*)(F.ws + WS_WAB_OUT), 1024, 0, nullptr, scr, r, F.lane, true); continue; } r -= I_SQ;
        if (r < I_SQ) { conv_item(F.inp[19], 1024, 1024, (bf16_t*)(F.ws + WS_WCD_OUT), 1024, 0, nullptr, scr, r, F.lane, true); continue; } r -= I_SQ;
        if (r < I_UQ) { conv_item(F.inp[14], 384, 768, (bf16_t*)(F.ws + WS_WUQ), 768, 2, F.inp[13], scr, r, F.lane); continue; } r -= I_UQ;
        conv_item(F.inp[16], 256, 1024, (bf16_t*)(F.ws + WS_WUKV), 1024, 3, F.inp[15], scr, r, F.lane);
    }
}

DI void conv_moe_slice(const Ctx& F, int l, int step) {
    constexpr int I_GU = 16 * 32, I_DN = 8 * 32, PER_L = 32 * I_GU + 32 * I_DN;
    LAS float* scr = (LAS float*)(F.lds + F.wave * 8448);
    const int per_wg = (PER_L + F.G - 1) / F.G, per_step = (per_wg + 7) / 8;
    const int lo = (int)blockIdx.x * per_wg + step * per_step;
    int hi = lo + per_step; const int wg_hi = ((int)blockIdx.x + 1) * per_wg; hi = hi < wg_hi ? hi : wg_hi; hi = hi < PER_L ? hi : PER_L;
    for (int r = lo + F.wave; r < hi; r += 8) {
        if (r < 32 * I_GU) { const int mtx = l * 32 + r / I_GU; conv_item(F.inp[24] + (size_t)mtx * 1024 * 1024, 1024, 1024, (bf16_t*)(F.ws + WS_WGU + (size_t)mtx * 1024 * 1024), 1024, 4, nullptr, scr, r % I_GU, F.lane, true); }
        else { const int r2 = r - 32 * I_GU; const int mtx = l * 32 + r2 / I_DN; conv_item(F.inp[25] + (size_t)mtx * 512 * 1024, 512, 1024, (bf16_t*)(F.ws + WS_WDN + (size_t)mtx * 1024 * 512), 1024, 0, nullptr, scr, r2 % I_DN, F.lane, true); }
    }
}

DI const float* src_row_l0(const Ctx& F, int urow, int& which) {
    const int b = urow / RB, rr = urow - b * RB;
    if (rr < CTXL) { which = 2; return F.inp[2] + ((size_t)b * CTXL + rr) * 1024; }
    which = b; return F.inp[0] + ((size_t)b * SEQ + (rr - CTXL)) * 1024;
}

DI void phase_modulate0(const Ctx& F) {
    bf16_t* H = (bf16_t*)(F.ws + WS_H);
    for (int urow = F.vcu * 8 + F.wave; urow < MU; urow += F.G * 8) {
        int which; const float* src = src_row_l0(F, urow, which);
        f32x4 v[4], h[4]; ld_f32_nt(src, F.lane, v);
        modulate_row(h, v, modp(F, 0, which, 1), modp(F, 0, which, 0), F.lane);
        st_fp8row((unsigned char*)H + (size_t)urow * 1024, F.lane, h);
    }
}

constexpr int PASS_ROWS = 136;
template <int CTRL> DI float dpp_ror_add(float v) { return v + __builtin_bit_cast(float, __builtin_amdgcn_update_dpp(0, __builtin_bit_cast(int, v), CTRL, 0xf, 0xf, false)); }
DI float reduce4(float a, float b, float c, float d) {
    auto r1 = __builtin_amdgcn_permlane32_swap(__float_as_uint(a), __float_as_uint(b), false, false);
    auto r2 = __builtin_amdgcn_permlane32_swap(__float_as_uint(c), __float_as_uint(d), false, false);
    const float z1 = __uint_as_float(r1[0]) + __uint_as_float(r1[1]);
    const float z2 = __uint_as_float(r2[0]) + __uint_as_float(r2[1]);
    auto r3 = __builtin_amdgcn_permlane16_swap(__float_as_uint(z1), __float_as_uint(z2), false, false);
    float w = __uint_as_float(r3[0]) + __uint_as_float(r3[1]);
    w = dpp_ror_add<0x128>(w); w = dpp_ror_add<0x124>(w); w = dpp_ror_add<0x122>(w); w = dpp_ror_add<0x121>(w);
    return w;
}
DI void phase_ln1_router(const Ctx& F, const int l) {
    constexpr int RG = 2;
    constexpr int WRS = 1028;
    LAS float* Wr = (LAS float*)F.lds;
    LAS unsigned* rinfo = (LAS unsigned*)(F.lds + 148480);
    LAS int* lcnt = (LAS int*)(F.lds + 148480 + PASS_ROWS * 32);
    LAS int* lbase = lcnt + 32;
    LAS float* lgs = (LAS float*)(F.lds + 148480 + PASS_ROWS * 32 + 256) + F.wave * (RG * 36);
    const float* wg = F.inp[20] + (size_t)l * 4096; const float* we = F.inp[22] + (size_t)l * 32768;
    for (int idx = F.tid; idx < 4096; idx += 512) Wr[(idx & 3) * WRS + (idx >> 2)] = wg[idx];
    for (int idx = F.tid; idx < 32768; idx += 512) Wr[(4 + (idx & 31)) * WRS + (idx >> 5)] = we[idx];
    if (F.tid < 32) lcnt[F.tid] = 0;
    __syncthreads();
    const int nrows = (l == 0) ? MU : NB * SEQ;
    const int rpw = (nrows + F.G - 1) / F.G, r_begin = (int)blockIdx.x * rpw, r_end = (r_begin + rpw < nrows) ? r_begin + rpw : nrows;
    const bf16_t* YP = (const bf16_t*)(F.ws + WS_YP); bf16_t* XA = (bf16_t*)(F.ws + WS_XA); const bf16_t* XB = (const bf16_t*)(F.ws + WS_XB); bf16_t* H = (bf16_t*)(F.ws + WS_H);
    int* list = (int*)(F.ws + WS_LIST); unsigned* tokinfo = (unsigned*)(F.ws + WS_TOKINFO); unsigned* gcnt = (unsigned*)(F.ctl + CW_CNT + l * 32);
    const float* lng = F.inp[6] + (size_t)(l * 2 + 0) * 1024; const float* lnb = F.inp[7] + (size_t)(l * 2 + 0) * 1024;
    const float* bgp = F.inp[21] + l * 4; const float* bep = F.inp[23] + l * 32;
    for (int pb = r_begin; pb < r_end; pb += PASS_ROWS) {
        const int npass = (r_end - pb < PASS_ROWS) ? (r_end - pb) : PASS_ROWS;
        for (int g4 = F.wave; RG * g4 < npass; g4 += 8) {
            f32x4 hm[RG][4]; int urows[RG];
#pragma unroll
            for (int r = 0; r < RG; ++r) {
                const int lr = RG * g4 + r;
                if (lr < npass) {
                    const int j = pb + lr; int urow, which; const float* src = nullptr;
                    if (l == 0) { urow = j; src = src_row_l0(F, urow, which); }
                    else { const int b = j >> 14; urow = b * RB + CTXL + (j & 16383); which = b; }
                    urows[r] = urow;
                    f32x4 v[4], y[4], g1[4]; if (l == 0) ld_f32_nt(src, F.lane, v); else ld_bf16_nt(XB + (size_t)urow * 1024, F.lane, v); ld_bf16_nt(YP + (size_t)urow * 1024, F.lane, y); ld_f32(modp(F, l, which, 2), F.lane, g1);
#pragma unroll
                    for (int jj = 0; jj < 4; ++jj) v[jj] = v[jj] * DN_ALPHA + g1[jj] * y[jj];
                    layer_norm_row(v, lng, lnb, F.lane);
                    st_bf16_nt(XA + (size_t)urow * 1024, F.lane, v);
                    modulate_row(hm[r], v, modp(F, l, which, 4), modp(F, l, which, 3), F.lane);
                    st_fp8row((unsigned char*)H + (size_t)urow * 1024, F.lane, hm[r]);
                } else { urows[r] = 0;
#pragma unroll
                    for (int jj = 0; jj < 4; ++jj) hm[r][jj] = (f32x4){0.f, 0.f, 0.f, 0.f}; }
            }
#pragma unroll 3
            for (int c4 = 0; c4 < 9; ++c4) {
                float pr[RG][4];
#pragma unroll
                for (int cc = 0; cc < 4; ++cc) {
                    f32x4 w[4];
#pragma unroll
                    for (int jj = 0; jj < 4; ++jj) w[jj] = *(const LAS f32x4*)(Wr + (c4 * 4 + cc) * WRS + 256 * jj + 4 * F.lane);
#pragma unroll
                    for (int r = 0; r < RG; ++r) { f32x2 a2 = (f32x2){0.f, 0.f};
#pragma unroll
                        for (int jj = 0; jj < 4; ++jj) { a2 += (f32x2){hm[r][jj][0], hm[r][jj][1]} * (f32x2){w[jj][0], w[jj][1]}; a2 += (f32x2){hm[r][jj][2], hm[r][jj][3]} * (f32x2){w[jj][2], w[jj][3]}; }
                        pr[r][cc] = a2[0] + a2[1]; }
                }
#pragma unroll
                for (int r = 0; r < RG; ++r) {
                    const float wv = reduce4(pr[r][0], pr[r][1], pr[r][2], pr[r][3]);
                    const int q = F.lane >> 4; const int cmap = (q == 1) ? 2 : (q == 2 ? 1 : q);
                    if ((F.lane & 15) == 0) lgs[r * 36 + c4 * 4 + cmap] = wv;
                }
            }
            asm volatile("s_waitcnt lgkmcnt(0)" ::: "memory");
            if (F.lane < RG && RG * g4 + F.lane < npass) {
                const int r = F.lane, lr = RG * g4 + r; const LAS float* lg = lgs + r * 36;
                float gv[4];
#pragma unroll
                for (int i = 0; i < 4; ++i) gv[i] = lg[i] + bgp[i];
                int gi = 0; float gm = gv[0];
#pragma unroll
                for (int i = 1; i < 4; ++i) if (gv[i] > gm) { gm = gv[i]; gi = i; }
                float gs = 0.f;
#pragma unroll
                for (int i = 0; i < 4; ++i) gs += fast_exp2((gv[i] - gm) * LOG2E);
                const float gval = 1.0f / gs;
                float ev[8];
#pragma unroll
                for (int i = 0; i < 8; ++i) ev[i] = lg[4 + 8 * gi + i] + bep[8 * gi + i];
                int i1 = 0; float m1 = ev[0];
#pragma unroll
                for (int i = 1; i < 8; ++i) if (ev[i] > m1) { m1 = ev[i]; i1 = i; }
                int i2 = -1; float m2 = -INFINITY;
#pragma unroll
                for (int i = 0; i < 8; ++i) if (i != i1 && ev[i] > m2) { m2 = ev[i]; i2 = i; }
                const float tt = fast_exp2((m2 - m1) * LOG2E); const float w0 = gval / (1.f + tt), w1 = gval * tt / (1.f + tt);
                const int E0 = gi * 8 + i1, E1 = gi * 8 + i2;
                const int ls0 = __hip_atomic_fetch_add(lcnt + E0, 1, __ATOMIC_RELAXED, __HIP_MEMORY_SCOPE_WORKGROUP);
                const int ls1 = __hip_atomic_fetch_add(lcnt + E1, 1, __ATOMIC_RELAXED, __HIP_MEMORY_SCOPE_WORKGROUP);
                LAS unsigned* ri = rinfo + lr * 8;
                ri[0] = (unsigned)E0; ri[1] = (unsigned)ls0; ri[2] = __float_as_uint(w0); ri[3] = (unsigned)E1; ri[4] = (unsigned)ls1; ri[5] = __float_as_uint(w1);
                ri[6] = (unsigned)(r == 0 ? urows[0] : urows[RG - 1]);
            }
            asm volatile("s_waitcnt lgkmcnt(0)" ::: "memory");
        }
        __syncthreads();
        if (F.tid < 32) { const int n = lcnt[F.tid]; lbase[F.tid] = n > 0 ? (int)__hip_atomic_fetch_add(gcnt + F.tid, (unsigned)n, __ATOMIC_RELAXED, __HIP_MEMORY_SCOPE_AGENT) : 0; }
        __syncthreads();
        for (int lr = F.tid; lr < npass; lr += 512) {
            const LAS unsigned* ri = rinfo + lr * 8;
            const int E0 = (int)ri[0], E1 = (int)ri[3]; const int s0 = lbase[E0] + (int)ri[1], s1 = lbase[E1] + (int)ri[4]; const int urow = (int)ri[6];
            list[(size_t)E0 * LIST_CAP + s0] = urow; list[(size_t)E1 * LIST_CAP + s1] = urow;
            u32x4 a; a.x = (unsigned)E0; a.y = (unsigned)s0; a.z = ri[2]; a.w = (unsigned)E1; u32x4 b; b.x = (unsigned)s1; b.y = ri[5]; b.z = 0u; b.w = 0u;
            *(u32x4*)(tokinfo + (size_t)urow * 8) = a; *(u32x4*)(tokinfo + (size_t)urow * 8 + 4) = b;
        }
        __syncthreads();
        if (F.tid < 32) lcnt[F.tid] = 0;
        __syncthreads();
    }
}

DI void moe_tables(const Ctx& F, int l) {
    LAS int* tb = (LAS int*)(F.lds + LDS_AUX);
    if (F.tid < 32) tb[64 + F.tid] = (int)__hip_atomic_load(F.ctl + CW_CNT + l * 32 + F.tid, RLX_AGENT);
    __syncthreads();
    if (F.tid == 0) { int a = 0; for (int e = 0; e < 32; ++e) { tb[e] = a; a += (tb[64 + e] + 255) >> 8; } tb[32] = a; }
    __syncthreads();
}
struct MoeOrder {
    const LAS int* tb; int G, c; const char* A; const char* W; size_t wstride, tstepB, tstepA; const int* list; unsigned lda2; bool gatherA;
    DI bool next(int i, pg8::Unit& u) const {
        const int ntot = tb[32]; const long L = (long)i * G + c; if (L >= (long)ntot * 4) return false;
        const int rt = (int)(L >> 2), pn = (int)(L & 3); int e = 0;
        for (int j = 1; j < 32; ++j) e += (tb[j] <= rt) ? 1 : 0;
        e = __builtin_amdgcn_readfirstlane(e);
        u.pm = rt; u.pn = pn; u.aux0 = e; u.aux1 = __builtin_amdgcn_readfirstlane((rt - tb[e]) * 256);
        u.A = gatherA ? A : A + (size_t)rt * tstepA; u.B = W + (size_t)e * wstride + (size_t)pn * tstepB; return true;
    }
    DI unsigned gather(const pg8::Unit& u, int r) const {
        const int slot = u.aux1 + r, n = tb[64 + u.aux0];
        const int tok = list[(size_t)u.aux0 * LIST_CAP + (slot < n ? slot : 0)];
        return (unsigned)tok * lda2;
    }
};

DI void phase_ln2(const Ctx& F, const int l) {
    moe_tables(F, l);
    const LAS int* tb = (const LAS int*)(F.lds + LDS_AUX);
    const bf16_t* YS = (const bf16_t*)(F.ws + WS_YS); const bf16_t* XA = (const bf16_t*)(F.ws + WS_XA); bf16_t* XB = (bf16_t*)(F.ws + WS_XB); bf16_t* H = (bf16_t*)(F.ws + WS_H);
    const unsigned* tokinfo = (const unsigned*)(F.ws + WS_TOKINFO);
    const float* lng = F.inp[6] + (size_t)(l * 2 + 1) * 1024; const float* lnb = F.inp[7] + (size_t)(l * 2 + 1) * 1024;
    const int nrows = (l == 0) ? MU : NB * SEQ;
    const int stride = F.G * 8;
    for (int j0 = F.vcu * 8 + F.wave; j0 < nrows; j0 += 2 * stride) {
        int urow[2], which[2], bb[2], ss[2]; bool ok[2]; u32x4 ia[2]; u32x2 ib[2]; f32x4 v[2][4], ya[2][4], yb[2][4];
#pragma unroll
        for (int r = 0; r < 2; ++r) { const int j = j0 + r * stride; ok[r] = j < nrows; const int jj = ok[r] ? j : j0;
            if (l == 0) { urow[r] = jj; bb[r] = jj / RB; which[r] = (jj - bb[r] * RB) < CTXL ? 2 : bb[r]; ss[r] = 0; }
            else { bb[r] = jj >> 14; ss[r] = jj & 16383; urow[r] = bb[r] * RB + CTXL + ss[r]; which[r] = bb[r]; }
            ia[r] = *(const u32x4*)(tokinfo + (size_t)urow[r] * 8); ib[r] = *(const u32x2*)(tokinfo + (size_t)urow[r] * 8 + 4);
            ld_bf16_nt(XA + (size_t)urow[r] * 1024, F.lane, v[r]); }
#pragma unroll
        for (int r = 0; r < 2; ++r) { const int p0 = tb[ia[r].x] * 256 + (int)ia[r].y, p1 = tb[ia[r].w] * 256 + (int)ib[r].x;
            ld_fp8x64_nt((const unsigned char*)YS + (size_t)p0 * 1024, F.lane, ya[r]); ld_fp8x64_nt((const unsigned char*)YS + (size_t)p1 * 1024, F.lane, yb[r]); }
#pragma unroll
        for (int r = 0; r < 2; ++r) {
            if (!ok[r]) continue;
            const float w0 = __uint_as_float(ia[r].z), w1 = __uint_as_float(ib[r].y);
            f32x4 g2[4]; ld_f32(modp(F, l, which[r], 5), F.lane, g2);
#pragma unroll
            for (int jj = 0; jj < 4; ++jj) v[r][jj] = v[r][jj] * DN_ALPHA + g2[jj] * (ya[r][jj] * w0 + yb[r][jj] * w1);
            layer_norm_row(v[r], lng, lnb, F.lane);
            if (l == 0) {
                st_bf16_nt(XB + (size_t)urow[r] * 1024, F.lane, v[r]);
                f32x4 h[4]; modulate_row(h, v[r], modp(F, 1, which[r], 1), modp(F, 1, which[r], 0), F.lane);
                st_fp8row((unsigned char*)H + (size_t)urow[r] * 1024, F.lane, h);
            } else st_f32_nt(F.out + ((size_t)bb[r] * SEQ + ss[r]) * 1024, F.lane, v[r]);
        }
    }
}

template <class Sched> DI void rms_tables(const Ctx& F, const Sched& S, const bf16_t* base, int col0, int ncols, LAS float* rs) {
    pg8::Unit u;
    for (int i = 0; i < 16 && S.next(i, u); ++i) {
        const int r = F.tid >> 1, hsel = F.tid & 1; const int half = ncols / 2;
        const bf16_t* p = base + (size_t)(u.pm * 256 + r) * NQKV + col0 + hsel * half; float ss = 0.f;
        for (int k = 0; k < half; k += 8) { const u32x4 w = *(const u32x4*)(p + k);
            ss += bf_lo(w.x) * bf_lo(w.x) + bf_hi(w.x) * bf_hi(w.x) + bf_lo(w.y) * bf_lo(w.y) + bf_hi(w.y) * bf_hi(w.y) + bf_lo(w.z) * bf_lo(w.z) + bf_hi(w.z) * bf_hi(w.z) + bf_lo(w.w) * bf_lo(w.w) + bf_hi(w.w) * bf_hi(w.w); }
        ss += __shfl_xor(ss, 1);
        if (hsel == 0) rs[i * 256 + r] = 1.0f / sqrtf(ss / (float)ncols + 1e-6f);
    }
    __syncthreads();
}

#ifndef MK_PER_PHASE
#define MK_PER_PHASE 0
#endif
constexpr int N_PHASES = 17;
struct Args { const float* in[26]; float* out; unsigned char* ws; int ph_lo, ph_hi; };

__global__ void __launch_bounds__(512, 2) mk_fwd(Args args) {
    extern __shared__ __attribute__((aligned(16))) unsigned char lds_raw[];
    Ctx F;
    F.lds = (LAS unsigned char*)lds_raw; F.ws = args.ws; F.ctl = (gu32*)(args.ws + WS_CTL);
    F.tid = threadIdx.x; F.lane = F.tid & 63; F.wave = __builtin_amdgcn_readfirstlane(F.tid >> 6);
    F.G = gridDim.x; { const int bx = blockIdx.x; F.vcu = (F.G % 8 == 0) ? (bx % 8) * (F.G / 8) + bx / 8 : bx; }
    F.inp = (const float* const __attribute__((address_space(4)))*)__builtin_amdgcn_kernarg_segment_ptr();
    F.out = args.out;
    volatile LAS unsigned* MISC = (volatile LAS unsigned*)(F.lds + LDS_MISC);
    if (F.tid < 16) MISC[F.tid] = 0u;
    __syncthreads();
    XcdBarrier bar; bar.bar = (unsigned*)(F.ctl + CW_BAR); bar.x = 0; bar.st = nullptr;
    if (!MK_PER_PHASE) bar = xcd_barrier_post((unsigned*)(F.ctl + CW_BAR), MISC);
    const int lo = args.ph_lo, hi = args.ph_hi;
#define IN(k) (lo <= (k) && (k) < hi)
#define SEAM(k) do { if (IN(k) && IN((k) + 1)) xcd_barrier(bar); } while (0)
#define H ((bf16_t*)(F.ws + WS_H))
#define AO ((bf16_t*)(F.ws + WS_AO))
#define QKV ((bf16_t*)(F.ws + WS_QKV))
#define YP ((bf16_t*)(F.ws + WS_YP))
#define ACT ((bf16_t*)(F.ws + WS_ACT))
#define YS ((bf16_t*)(F.ws + WS_YS))
#define QM ((bf16_t*)(F.ws + WS_QM))
#define KVM ((bf16_t*)(F.ws + WS_KVM))
#define r32c ((const float*)(F.ws + WS_ROPE) + 8192)
#define r32s ((const float*)(F.ws + WS_ROPE) + 8192 + 2048)
    LAS unsigned char* ring = F.lds;

    if (IN(0)) { phase_prologue(F); } SEAM(0);
    if (IN(1)) { phase_modulate0(F); } SEAM(1);

    if (IN(2)) {
        pg8::DenseOrder S; S.init(130, 9, F.G, (int)blockIdx.x, false, H, 512, F.ws + WS_WAB_IN, 512);
        pg8::EpiInProj<0> E{F.ws};
        pg8::gemm_phase<pg8::EpiInProj<0>, pg8::DenseOrder, false, true>(ring, 512, 512, S, E);
    } SEAM(2);
    if (IN(3)) {
        LAS float* rpbL = (LAS float*)(F.lds + LDS_AUX); int nconv = 0;
        for (int i = 0;; ++i) {
            const int L = i * F.G + F.vcu; if (L >= 2048 + 32) break;
            att::P p; p.opitch = 1024; p.qpitch = 512; p.k8r = nullptr; p.lam = 0.f; p.subln = nullptr; p.sink2 = 0.f; p.t_lo = 4; p.s0 = 0;
            int b, head, mixer; size_t qr0;
            if (L >= 2048) { const int Lc = L - 2048, j = Lc & 15; mixer = Lc >> 4; b = j >> 3; head = j & 7; p.kind = 2 + mixer; p.nt = 4; qr0 = (size_t)(b * RB); }
            else { const int j = L & 1023; mixer = L >> 10; const int qb = j & 63; head = (j >> 6) & 7; b = j >> 9; p.kind = mixer; p.s0 = qb * 256; qr0 = (size_t)(b * RB + CTXL + p.s0);
                int tlo, thi;
                if (mixer == 0) { tlo = p.s0 / 64 - 2; thi = p.s0 / 64 + 5; tlo = tlo < 0 ? 0 : tlo; thi = thi > 255 ? 255 : thi; }
                else { const int R0 = p.s0 >> 6; tlo = R0 - 4; tlo = tlo < 0 ? 0 : (tlo > 248 ? 248 : tlo); thi = R0 - 1; thi = thi < 0 ? 0 : (thi > 248 ? 248 : thi); thi += 7; }
                p.t_lo = 4 + tlo; p.nt = 4 + (thi - tlo + 1); }
            p.o = (unsigned char*)AO + qr0 * 1024;
            if (mixer == 0) { p.o += head * 64; p.sink2 = F.inp[9][head] * LOG2E;
                p.k8 = F.ws + WS_K8A + (size_t)(b * 2 + (head >> 2)) * 260 * 4096; p.v8 = F.ws + WS_VT8A + (size_t)(b * 2 + (head >> 2)) * 260 * 4096; p.q8 = F.ws + WS_Q8A + qr0 * 512 + head * 64; }
            else { p.o += 512 + head * 64;
                p.k8 = F.ws + WS_K8B + (size_t)(b * 8 + head) * 260 * 4096; p.v8 = F.ws + WS_VT8B + (size_t)(b * 8 + head) * 260 * 4096; p.q8 = F.ws + WS_Q8B + qr0 * 512 + head * 64;
                if (p.kind == 1) for (int idx = F.tid; idx < 465; idx += 512) rpbL[idx] = F.inp[10][head * 465 + idx] * LOG2E; }
            p.nt += (p.nt & 1);
            att::attn_unit_f8l0(p, ring, rpbL);
            if (i < 8) { conv_moe_slice(F, 0, i); __syncthreads(); }
            nconv = i + 1;
        }
        for (int s = nconv; s < 8; ++s) { conv_moe_slice(F, 0, s); __syncthreads(); }
    } SEAM(3);

#define LAYER_TAIL(l) do {\
        const int pb = (l == 0) ? 4 : 12;\
        if (IN(pb)) {\
            pg8::DenseOrder S; S.init(l == 0 ? 130 : 128, 4, F.G, (int)blockIdx.x, l == 1, AO, 512, F.ws + (l == 0 ? WS_WAB_OUT : WS_WCD_OUT), 512);\
            pg8::EpiPlain E{YP, 1024};\
            pg8::gemm_phase<pg8::EpiPlain, pg8::DenseOrder, false, true>(ring, 512, 512, S, E, 0x7a7a7a7a);    \
        } SEAM(pb);\
        if (IN(pb + 1)) { phase_ln1_router(F, l); } SEAM(pb + 1);\
        if (IN(pb + 2)) {\
            moe_tables(F, l);\
            MoeOrder S{(const LAS int*)(F.lds + LDS_AUX), F.G, (int)blockIdx.x, (const char*)H, (const char*)(F.ws + WS_WGU) + (size_t)l * 32 * 1024 * 1024, (size_t)1024 * 1024, (size_t)256 * 1024, 0,\
                       (const int*)(F.ws + WS_LIST), 1024u, true};\
            pg8::EpiGU E{(unsigned char*)ACT};\
            pg8::gemm_phase<pg8::EpiGU, MoeOrder, true, true>(ring, 512, 512, S, E);                     \
        } SEAM(pb + 2);\
        if (IN(pb + 3)) {\
            moe_tables(F, l);\
            MoeOrder S{(const LAS int*)(F.lds + LDS_AUX), F.G, (int)blockIdx.x, (const char*)ACT, (const char*)(F.ws + WS_WDN) + (size_t)l * 32 * 1024 * 512, (size_t)1024 * 512, (size_t)256 * 512, (size_t)256 * 512,\
                       (const int*)(F.ws + WS_LIST), 0u, false};\
            pg8::EpiPlain8 E{(unsigned char*)YS, 1024};\
            pg8::gemm_phase<pg8::EpiPlain8, MoeOrder, false, true>(ring, 256, 256, S, E);                \
        } SEAM(pb + 3);\
        if (IN(pb + 4)) { phase_ln2(F, l); }\
    } while (0)
    LAYER_TAIL(0); SEAM(8);

    if (IN(9)) {
        pg8::DenseOrder S; S.init(130, 9, F.G, (int)blockIdx.x, false, H, 512, F.ws + WS_WCD_IN, 512);
        pg8::EpiInProj<1> E{F.ws};
        pg8::gemm_phase<pg8::EpiInProj<1>, pg8::DenseOrder, false, true>(ring, 512, 512, S, E);
    } SEAM(9);
    if (IN(10)) {
        LAS float* rsq = (LAS float*)(F.lds + LDS_AUX); LAS float* rskv = rsq + 1024;
        pg8::DenseOrder Sq; Sq.init(128, 3, F.G, (int)blockIdx.x, true, QKV + 1536, NQKV, F.ws + WS_WUQ, 384);
        pg8::DenseOrder Skv; Skv.init(130, 4, F.G, (int)blockIdx.x, false, QKV + 1920, NQKV, F.ws + WS_WUKV, 256);
        rms_tables(F, Sq, QKV, 1536, 384, rsq);
        rms_tables(F, Skv, QKV, 1920, 256, rskv);
        pg8::EpiUQ Eq{F.ws + WS_Q8M, rsq, r32c, r32s};
        pg8::gemm_phase<pg8::EpiUQ, pg8::DenseOrder, false>(ring, NQKV, 384, Sq, Eq);
        pg8::EpiUKV Ekv{F.ws + WS_K8M, rskv, F.ws + WS_VT8M};
        pg8::gemm_phase<pg8::EpiUKV, pg8::DenseOrder, false>(ring, NQKV, 256, Skv, Ekv);
    } SEAM(10);
    if (IN(11)) {
        float lam; { const float* lp = F.inp[17]; float s01 = 0.f, s23 = 0.f; for (int i = 0; i < 64; ++i) { s01 += lp[i] * lp[64 + i]; s23 += lp[128 + i] * lp[192 + i]; }
            lam = fast_exp2(s01 * LOG2E) - fast_exp2(s23 * LOG2E) + LAM_INIT; }
        int nconv = 0;
        for (int i = 0;; ++i) {
            const int L = i * F.G + F.vcu; if (L >= 2048) break;
            att::P p; p.kind = 0; p.t_lo = 0; p.s0 = 0; p.sink2 = 0.f; p.nt = RB / 64; p.opitch = 1024; p.lam = lam; p.subln = F.inp[18];
            if (L < 1024) { const int qb = L & 63, head = (L >> 6) & 7, b = L >> 9; const size_t qrow0 = (size_t)(b * RB + CTXL + qb * 256);
                p.o = (unsigned char*)AO + qrow0 * 1024 + head * 64; p.v8 = F.ws + WS_VT8M + (size_t)(b * 8 + head) * 260 * 4096; p.k8 = F.ws + WS_K8M + (size_t)(b * 8 + head) * 260 * 4096; p.k8r = F.ws + WS_K8R + (size_t)b * 260 * 2048;
                p.q8 = F.ws + WS_Q8M + qrow0 * 768 + head * 96; p.qpitch = 768;
                att::attn_unit_f8q<1>(p, ring);
            } else { const int j = L - 1024; const int qb = j & 127, head = (j >> 7) & 3, b = j >> 9; const size_t qrow0 = (size_t)(b * RB + CTXL + qb * 128);
                p.o = (unsigned char*)AO + qrow0 * 1024 + 512 + head * 128; p.v8 = F.ws + WS_VT8D + (size_t)(b * 4 + head) * 260 * 8192; p.k8 = F.ws + WS_K8D + (size_t)(b * 4 + head) * 260 * 8192; p.k8r = nullptr;
                p.q8 = F.ws + WS_Q8D + qrow0 * 512 + head * 128; p.qpitch = 512;
                att::attn_unit_f8q<2>(p, ring);
            }
            if (i < 8) { conv_moe_slice(F, 1, i); __syncthreads(); }
            nconv = i + 1;
        }
        for (int s = nconv; s < 8; ++s) { conv_moe_slice(F, 1, s); __syncthreads(); }
    } SEAM(11);

    LAYER_TAIL(1);
#undef LAYER_TAIL
#undef IN
#undef SEAM
#undef H
#undef AO
#undef QKV
#undef YP
#undef ACT
#undef YS
#undef QM
#undef KVM
#undef r32c
#undef r32s
}

extern "C" void kernel_launch(void* const* d_in, const int* in_sizes, int n_in, void* d_out, int out_size, void* d_ws, size_t ws_size, hipStream_t stream) {
    static int grid = 0;
    if (grid == 0) {
        if (n_in != 26 || out_size != NB * SEQ * DM || ws_size < WS_END) { fprintf(stderr, "kernel_launch: unexpected shapes (n_in %d, out %d, ws %zu < %zu)\n", n_in, out_size, ws_size, (size_t)WS_END); grid = -1; return; }
        int dev = 0, cus = 0, per_cu = 0;
        if (hipGetDevice(&dev) != hipSuccess || hipDeviceGetAttribute(&cus, hipDeviceAttributeMultiprocessorCount, dev) != hipSuccess) { grid = -1; return; }
        if (hipFuncSetAttribute((const void*)mk_fwd, hipFuncAttributeMaxDynamicSharedMemorySize, LDS_BYTES) != hipSuccess) { fprintf(stderr, "kernel_launch: hipFuncSetAttribute failed\n"); grid = -1; return; }
        if (hipOccupancyMaxActiveBlocksPerMultiprocessor(&per_cu, (const void*)mk_fwd, 512, LDS_BYTES) != hipSuccess || per_cu < 1) fprintf(stderr, "kernel_launch: occupancy query says %d\n", per_cu);
        (void)hipGetLastError();
        grid = cus;
    }
    if (grid < 0) return;
    (void)hipMemsetAsync((char*)d_ws + WS_CTL, 0, CTL_ZERO_BYTES, stream);
    Args a{};
    for (int i = 0; i < 26; ++i) a.in[i] = (const float*)d_in[i];
    a.out = (float*)d_out; a.ws = (unsigned char*)d_ws;
#if MK_PER_PHASE
    for (int ph = 0; ph < N_PHASES; ++ph) { a.ph_lo = ph; a.ph_hi = ph + 1; hipLaunchKernelGGL(mk_fwd, dim3(grid), dim3(512), LDS_BYTES, stream, a); }
#else
    a.ph_lo = 0; a.ph_hi = N_PHASES;
    hipLaunchKernelGGL(mk_fwd, dim3(grid), dim3(512), LDS_BYTES, stream, a);
#endif
}
```

```cpp
#include <hip/hip_runtime.h>
#include <cstdio>
#include <cstdint>

#define GAS __attribute__((address_space(1)))
#define LAS __attribute__((address_space(3)))
typedef unsigned short bf16_t;
typedef short bf16x8 __attribute__((ext_vector_type(8)));
typedef short s16x4 __attribute__((ext_vector_type(4)));
typedef float f32x4 __attribute__((ext_vector_type(4)));
typedef float f32x2 __attribute__((ext_vector_type(2)));
typedef float f32x16 __attribute__((ext_vector_type(16)));
typedef unsigned u32x4 __attribute__((ext_vector_type(4)));
typedef unsigned u32x2 __attribute__((ext_vector_type(2)));
typedef __bf16 bf16x2_t __attribute__((ext_vector_type(2)));
typedef short v4i16_t __attribute__((ext_vector_type(4)));
typedef GAS unsigned gu32;
#define RLX_AGENT __ATOMIC_RELAXED, __HIP_MEMORY_SCOPE_AGENT
#define DI __device__ __forceinline__

constexpr int DM = 1024, NB = 2, SEQ = 16384, CTXL = 256;
constexpr int RB = SEQ + CTXL;
constexpr int MU = NB * RB;
constexpr int NEXP = 32, DEXP = 512;
constexpr float LOG2E = 1.4426950408889634f;
constexpr float DN_ALPHA = 1.4142135623730951f;
constexpr float LAM_INIT = 0.8f - 0.6f * 0.7408182206817179f;
constexpr int NQKV = 2304;
constexpr int LIST_CAP = MU;
constexpr int RMAX = 74752;

constexpr size_t MiB = 1u << 20;
constexpr size_t WS_CTL = 0, CTL_ZERO_BYTES = 64 * 1024;
constexpr size_t WS_MOD = 1 * MiB;
constexpr size_t WS_ROPE = 1 * MiB + 256 * 1024;
constexpr size_t WS_TOKINFO = 2 * MiB;
constexpr size_t WS_LIST = 4 * MiB;
constexpr size_t WS_WAB_IN = 10 * MiB, WS_WAB_OUT = 15 * MiB, WS_WCD_IN = 17 * MiB, WS_WCD_OUT = 22 * MiB, WS_WUQ = 24 * MiB, WS_WUKV = 25 * MiB;
constexpr size_t WS_WGU = 26 * MiB;
constexpr size_t WS_WDN = 154 * MiB;
constexpr size_t WS_XA = 218 * MiB, WS_XB = 348 * MiB;
constexpr size_t WS_H = 478 * MiB;
constexpr size_t WS_AO = 543 * MiB;
constexpr size_t WS_S = 608 * MiB;
constexpr size_t WS_QKV = WS_S;
constexpr size_t WS_QM = WS_S + 147 * MiB;
constexpr size_t WS_KVM = WS_S + 196 * MiB;
constexpr size_t WS_YP = WS_S;
constexpr size_t WS_ACT = WS_S + 65 * MiB;
constexpr size_t WS_YS = WS_S + 138 * MiB;
constexpr size_t WS_END = WS_S + 284 * MiB;
constexpr size_t WS_VT8M = 892 * MiB, WS_VT8D = 910 * MiB;
constexpr size_t WS_K8M = 928 * MiB, WS_K8D = 946 * MiB, WS_K8R = 964 * MiB;
constexpr size_t WS_Q8M = WS_QM, WS_Q8D = WS_QM + 26 * MiB;
constexpr size_t WS_Q8A = WS_QM, WS_Q8B = WS_QM + 17 * MiB, WS_K8A = WS_K8D, WS_K8B = WS_K8M, WS_VT8A = WS_VT8D, WS_VT8B = WS_VT8M;
static_assert(WS_YS + (size_t)RMAX * 1024 * 2 <= WS_END && WS_KVM + (size_t)MU * 1024 * 2 <= WS_END && WS_QM + (size_t)MU * 768 * 2 <= WS_KVM && WS_QKV + (size_t)MU * NQKV * 2 <= WS_QM, "ws map");
static_assert(WS_ACT + (size_t)RMAX * 512 * 2 <= WS_YS && WS_YP + (size_t)MU * 1024 * 2 <= WS_ACT, "ws map 2");

constexpr int CW_TMO = 0, CW_CODE = 1;
constexpr int CW_BAR = 4096;
constexpr int CW_CNT = 8192;

constexpr int RING_BYTES = 131072;
constexpr int LDS_AUX = RING_BYTES;
constexpr int LDS_MISC = 159744 - 64;
constexpr int LDS_BYTES = 159744;

DI unsigned cvtpk(float lo, float hi) { f32x2 v = {lo, hi}; bf16x2_t b = __builtin_convertvector(v, bf16x2_t); return __builtin_bit_cast(unsigned, b); }
DI float bf_lo(unsigned u) { return __uint_as_float(u << 16); }
DI float bf_hi(unsigned u) { return __uint_as_float(u & 0xffff0000u); }
DI float wave_sum(float v) {
#pragma unroll
    for (int o = 1; o < 64; o <<= 1) v += __shfl_xor(v, o);
    return v;
}
DI float fast_exp2(float x) { return __builtin_amdgcn_exp2f(x); }
DI float fast_rcp(float x) { return __builtin_amdgcn_rcpf(x); }

#define XB_TMO      128
#define XB_XCNT(j)  (256  + 64 * (j))
#define XB_XSUB(j)  (1280 + 64 * (j))
#define XB_XGEN(j)  (2304 + 64 * (j))
#define XB_TOP      3328
#define XB_TOPGEN   3392
#define XCD_BAR_WORDS 3456
#define XB_SPIN_CAP (1u << 22)

DI unsigned xb_ld(unsigned* p)              { return __hip_atomic_load(p, __ATOMIC_RELAXED, __HIP_MEMORY_SCOPE_AGENT); }
DI unsigned xb_add(unsigned* p, unsigned v) { return __hip_atomic_fetch_add(p, v, __ATOMIC_RELAXED, __HIP_MEMORY_SCOPE_AGENT); }
DI unsigned xb_xcc_id() { return (unsigned)__builtin_amdgcn_s_getreg((3 << 11) | 20) & 0xFu; }
#define XB_SPIN(cond, bar) do { unsigned _sp = 0; while (cond) { __builtin_amdgcn_s_sleep(1); \
    if ((++_sp & 255u) == 0u) { if (xb_ld(&(bar)[XB_TMO])) break; if (_sp > XB_SPIN_CAP) { atomicAdd(&(bar)[XB_TMO], 1u); break; } } } } while (0)

struct XcdBarrier { unsigned* bar; unsigned x; volatile LAS unsigned* st; };

DI XcdBarrier xcd_barrier_post(unsigned* bar, volatile LAS unsigned* st) {
    XcdBarrier b; b.bar = bar; b.x = xb_xcc_id(); b.st = st;
    if (threadIdx.x == 0) (void)xb_add(&bar[XB_XCNT(b.x)], 1u);
    return b;
}
DI void xcd_barrier_complete(unsigned* bar, unsigned x, unsigned& nloc, unsigned& nx) {
    const unsigned G = gridDim.x * gridDim.y * gridDim.z;
    unsigned sum, cnt, mine, sp = 0u;
    for (;;) {
        sum = 0u; cnt = 0u; mine = 0u;
#pragma unroll
        for (unsigned j = 0; j < 16; ++j) { const unsigned c = xb_ld(&bar[XB_XCNT(j)]); sum += c; cnt += (c > 0u) ? 1u : 0u; mine = (j == x) ? c : mine; }
        if (sum == G) break;
        __builtin_amdgcn_s_sleep(1);
        if ((++sp & 255u) == 0u) { if (xb_ld(&bar[XB_TMO])) break; if (sp > XB_SPIN_CAP) { atomicAdd(&bar[XB_TMO], 1u); break; } }
    }
    nloc = mine > 0u ? mine : 1u; nx = cnt > 0u ? cnt : 1u;
}
DI void xcd_barrier(const XcdBarrier& b) {
    asm volatile("s_waitcnt vmcnt(0)" ::: "memory");
    __syncthreads();
    if (threadIdx.x == 0) {
        unsigned* bar = b.bar;
        __builtin_amdgcn_s_waitcnt(0);
        unsigned nloc = b.st[0], nx = b.st[1];
        if (nloc == 0u) { xcd_barrier_complete(bar, b.x, nloc, nx); b.st[0] = nloc; b.st[1] = nx; }
        const unsigned old = xb_add(&bar[XB_XSUB(b.x)], 1u);
        const unsigned gen = old / nloc;
        if (old + 1u == (gen + 1u) * nloc) {
            __builtin_amdgcn_fence(__ATOMIC_RELEASE, "agent");
            asm volatile("s_waitcnt vmcnt(0)" ::: "memory");
            const unsigned og = xb_add(&bar[XB_TOP], 1u);
            const unsigned tg = og / nx;
            if (og + 1u == (tg + 1u) * nx) xb_add(&bar[XB_TOPGEN], 1u);
            else XB_SPIN(xb_ld(&bar[XB_TOPGEN]) == tg, bar);
            __builtin_amdgcn_fence(__ATOMIC_ACQUIRE, "agent");
            xb_add(&bar[XB_XGEN(b.x)], 1u);
            asm volatile("s_waitcnt vmcnt(0)" ::: "memory");
        } else {
            XB_SPIN(xb_ld(&bar[XB_XGEN(b.x)]) == gen, bar);
            __builtin_amdgcn_fence(__ATOMIC_ACQUIRE, "agent");
            asm volatile("s_waitcnt vmcnt(0)" ::: "memory");
        }
    }
    __syncthreads();
}

namespace pg8 {
constexpr int BM = 256, BK = 64, HALF = 128, HTB = HALF * BK * 2, STAGE_BYTES = 8 * HTB, NXCD = 8, WGM = 8;
__host__ __device__ __forceinline__ int lds_byte(int r, int c) { const int st = (r >> 4) * 2 + (c >> 5), rr = r & 15, cc = c & 31, ob = rr * 64 + cc * 2; return st * 1024 + (ob ^ (((ob >> 9) & 1) << 5)); }
__host__ __device__ __forceinline__ void stage_rc(int b, int& R, int& C) { const int st = b / 1024, sb = b % 1024, swz = sb ^ (((sb >> 9) & 1) << 5); R = (st >> 1) * 16 + swz / 64; C = (st & 1) * 32 + (swz % 64) / 2; }
__host__ __device__ __forceinline__ int perm32(int rho) { const int n = rho >> 4, i = rho & 15; return 8 * (i >> 2) + 4 * n + (i & 3); }

typedef int v8i_g __attribute__((ext_vector_type(8)));
struct Unit { int pm, pn; const char* A; const char* B; int aux0, aux1; };

struct DenseOrder {
    int nM, nN, nwg, G, c; bool latent_only; const char* A; const char* Bt; size_t tstepA, tstepB;
    DI void init(int nM_, int nN_, int G_, int c_, bool lat, const void* A_, int lda, const void* Bt_, int K) {
        nM = nM_; nN = nN_; nwg = nM * nN; G = G_; c = c_; latent_only = lat; A = (const char*)A_; Bt = (const char*)Bt_; tstepA = (size_t)BM * lda * 2; tstepB = (size_t)BM * K * 2; }
    DI bool next(int i, Unit& u) const {
        const long L = (long)i * G + c; if (L >= nwg) return false;
        int wgid = (int)L; { const int q = nwg / NXCD, r = nwg % NXCD, xcd = wgid % NXCD, off = wgid / NXCD; wgid = (xcd < r ? xcd * (q + 1) : r * (q + 1) + (xcd - r) * q) + off; }
        const int nig = WGM * nN, gid = wgid / nig, fm = gid * WGM, gsz = (nM - fm) < WGM ? (nM - fm) : WGM;
        int pm = fm + ((wgid % nig) % gsz); const int pn = (wgid % nig) / gsz;
        if (latent_only) pm = pm + 1 + (pm >= 64 ? 1 : 0);
        u.pm = pm; u.pn = pn; u.A = A + (size_t)pm * tstepA; u.B = Bt + (size_t)pn * tstepB; u.aux0 = 0; u.aux1 = 0; return true;
    }
    DI unsigned gather(const Unit&, int) const { return 0u; }
};

template <class Epi, class Sched, bool GATHER, bool F8 = false>
DI void gemm_phase(LAS unsigned char* lds, const int lda, const int K, const Sched& S, const Epi& E, const int sc_x8 = 0x7f7f7f7f) {
    const int tid = threadIdx.x, wid = __builtin_amdgcn_readfirstlane(tid >> 6), lane = tid & 63, wr = wid >> 2, wc = wid & 3, fr = lane & 15, fq = lane >> 4;
    const int nt = K / BK;
    int RR[2], CC[2]; unsigned voffB[2];
#pragma unroll
    for (int i = 0; i < 2; ++i) { stage_rc(tid * 16 + i * 8192, RR[i], CC[i]); const int Rb = Epi::PERM ? ((RR[i] & ~31) + perm32(RR[i] & 31)) : RR[i]; voffB[i] = (unsigned)(Rb * K + CC[i]) * 2u; }
    unsigned cv0[2], cv1[2], nv0[2], nv1[2];
    const size_t kstep = (size_t)(BK * 2);
    const size_t hstepB = (size_t)HALF * K * 2;
    const unsigned ldsw = (unsigned)wid * 1024u;
    const int aoff = lds_byte(wr * 64 + fr, fq * 8), boff = lds_byte(wc * 32 + fr, fq * 8);
#define PG8_SA(b, h) (((b) * 2 + (h)) * HTB)
#define PG8_SB(b, h) ((4 + (b) * 2 + (h)) * HTB)
#define PG8_STAGE(bufoff, gbase, voff) do { _Pragma("unroll") for (int _i = 0; _i < 2; ++_i) \
        __builtin_amdgcn_global_load_lds((const unsigned*)((const char*)(gbase) + (voff)[_i]), (LAS unsigned*)(lds + (bufoff) + ldsw + _i * 8192), 16, 0, 0); } while (0)
#define PG8_LDA(dst, b, h) do { _Pragma("unroll") for (int m = 0; m < 4; ++m) _Pragma("unroll") for (int k = 0; k < 2; ++k) dst[m][k] = *(const LAS bf16x8*)(lds + PG8_SA(b, h) + aoff + m * 2048 + k * 1024); } while (0)
#define PG8_LDB(dst, b, h) do { _Pragma("unroll") for (int n = 0; n < 2; ++n) _Pragma("unroll") for (int k = 0; k < 2; ++k) dst[n][k] = *(const LAS bf16x8*)(lds + PG8_SB(b, h) + boff + n * 2048 + k * 1024); } while (0)
#define PG8_MMA(ai, bj, At, Bt) do { __builtin_amdgcn_s_setprio(1); _Pragma("unroll") for (int m = 0; m < 4; ++m) _Pragma("unroll") for (int n = 0; n < 2; ++n) { \
        if (F8) { const u32x4 b0_ = __builtin_bit_cast(u32x4, Bt[n][0]), b1_ = __builtin_bit_cast(u32x4, Bt[n][1]), a0_ = __builtin_bit_cast(u32x4, At[m][0]), a1_ = __builtin_bit_cast(u32x4, At[m][1]); \
            const v8i_g wf_ = (v8i_g){(int)b0_[0], (int)b0_[1], (int)b0_[2], (int)b0_[3], (int)b1_[0], (int)b1_[1], (int)b1_[2], (int)b1_[3]}; \
            const v8i_g xf_ = (v8i_g){(int)a0_[0], (int)a0_[1], (int)a0_[2], (int)a0_[3], (int)a1_[0], (int)a1_[1], (int)a1_[2], (int)a1_[3]}; \
            asm volatile("v_mfma_scale_f32_16x16x128_f8f6f4 %0, %1, %2, %0, %3, %4 op_sel_hi:[0,0,0]" : "+v"(acc[ai][bj][m][n]) : "v"(wf_), "v"(xf_), "v"(sc_w8), "v"(sc_x8)); } \
        else { _Pragma("unroll") for (int k = 0; k < 2; ++k) acc[ai][bj][m][n] = __builtin_amdgcn_mfma_f32_16x16x32_bf16(Bt[n][k], At[m][k], acc[ai][bj][m][n], 0, 0, 0); } } \
        __builtin_amdgcn_s_setprio(0); } while (0)
#define PG8_WAIT_V(n) asm volatile("s_waitcnt vmcnt(" #n ")" ::: "memory")
#define PG8_WAIT_L(n) asm volatile("s_waitcnt lgkmcnt(" #n ")" ::: "memory")
#define PG8_BAR __builtin_amdgcn_s_barrier()
#define PG8_SCHED __builtin_amdgcn_sched_barrier(0)
#define PG8_SETV(v0, v1, u) do { _Pragma("unroll") for (int _i = 0; _i < 2; ++_i) { \
        if (GATHER) { v0[_i] = S.gather(u, RR[_i]) + (unsigned)CC[_i] * 2u; v1[_i] = S.gather(u, HALF + RR[_i]) + (unsigned)CC[_i] * 2u; } \
        else { v0[_i] = (unsigned)(RR[_i] * lda + CC[_i]) * 2u; v1[_i] = (unsigned)((HALF + RR[_i]) * lda + CC[_i]) * 2u; } } } while (0)
    const int sc_w8 = 0x79797979;
    Unit cur, nxt; int ui = 0;
    if (!S.next(0, cur)) return;
    PG8_SETV(cv0, cv1, cur);
    f32x4 acc[2][2][4][2];
#pragma unroll
    for (int a = 0; a < 2; ++a)
#pragma unroll
        for (int b = 0; b < 2; ++b)
#pragma unroll
            for (int m = 0; m < 4; ++m)
#pragma unroll
                for (int n = 0; n < 2; ++n) acc[a][b][m][n] = (f32x4){0.f, 0.f, 0.f, 0.f};
    bf16x8 At[4][2], B0[2][2], B1[2][2];
    const char* cA = cur.A; const char* cB = cur.B;
    PG8_STAGE(PG8_SB(0, 0), cB, voffB); PG8_STAGE(PG8_SB(0, 1), cB + hstepB, voffB); PG8_STAGE(PG8_SA(0, 0), cA, cv0); PG8_STAGE(PG8_SA(0, 1), cA, cv1);
    if (wr == 1) PG8_BAR;
    PG8_WAIT_V(2); PG8_BAR;
    PG8_STAGE(PG8_SB(1, 0), cB + kstep, voffB); PG8_STAGE(PG8_SA(1, 0), cA + kstep, cv0); PG8_STAGE(PG8_SB(1, 1), cB + hstepB + kstep, voffB);
    PG8_WAIT_V(6); PG8_BAR;
    for (;;) {
        const bool has_next = S.next(ui + 1, nxt);
        const char* nA = has_next ? nxt.A : cA; const char* nB = has_next ? nxt.B : cB;
        if (GATHER) { if (has_next) { PG8_SETV(nv0, nv1, nxt); } else {
#pragma unroll
            for (int i = 0; i < 2; ++i) { nv0[i] = cv0[i]; nv1[i] = cv1[i]; } } }
#pragma nounroll
        for (int t = 0; t < nt; t += 2) {
            const bool last = (t == nt - 2);
            const char* a1 = cA + (size_t)(t + 1) * kstep;
            const char* a2 = last ? nA : cA + (size_t)(t + 2) * kstep; const char* b2 = last ? nB : cB + (size_t)(t + 2) * kstep;
            const char* a3 = a2 + kstep; const char* b3 = b2 + kstep;
            unsigned s0[2], s1[2];
#pragma unroll
            for (int i = 0; i < 2; ++i) { s0[i] = (GATHER && last) ? nv0[i] : cv0[i]; s1[i] = (GATHER && last) ? nv1[i] : cv1[i]; }
            PG8_LDB(B0, 0, 0); PG8_LDB(B1, 0, 1); PG8_SCHED; PG8_LDA(At, 0, 0); PG8_STAGE(PG8_SA(1, 1), a1, cv1);
            PG8_WAIT_V(8); PG8_WAIT_L(0); PG8_BAR; PG8_MMA(0, 0, At, B0); PG8_MMA(0, 1, At, B1); PG8_BAR; PG8_SCHED;
            PG8_LDA(At, 0, 1); PG8_STAGE(PG8_SB(0, 0), b2, voffB); PG8_STAGE(PG8_SB(0, 1), b2 + hstepB, voffB); PG8_STAGE(PG8_SA(0, 0), a2, s0);
            PG8_WAIT_V(8); PG8_WAIT_L(0); PG8_BAR; PG8_MMA(1, 0, At, B0); PG8_MMA(1, 1, At, B1); PG8_BAR; PG8_SCHED;
            PG8_LDB(B0, 1, 0); PG8_LDB(B1, 1, 1); PG8_SCHED; PG8_LDA(At, 1, 0); PG8_STAGE(PG8_SA(0, 1), a2, s1);
            PG8_WAIT_V(8); PG8_WAIT_L(0); PG8_BAR; PG8_MMA(0, 0, At, B0); PG8_MMA(0, 1, At, B1); PG8_BAR; PG8_SCHED;
            PG8_LDA(At, 1, 1); PG8_STAGE(PG8_SB(1, 0), b3, voffB); PG8_STAGE(PG8_SB(1, 1), b3 + hstepB, voffB); PG8_STAGE(PG8_SA(1, 0), a3, s0);
            PG8_WAIT_V(8); PG8_WAIT_L(0); PG8_BAR; PG8_MMA(1, 0, At, B0); PG8_MMA(1, 1, At, B1); PG8_BAR; PG8_SCHED;
        }
        if (wr == 0) PG8_BAR;
        if (F8) asm volatile("s_nop 15\n\ts_nop 7" ::: "memory");
        E(acc, cur, ui, wr, wc, fr, fq);
        if (!has_next) break;
#pragma unroll
        for (int a = 0; a < 2; ++a)
#pragma unroll
            for (int b = 0; b < 2; ++b)
#pragma unroll
                for (int m = 0; m < 4; ++m)
#pragma unroll
                    for (int n = 0; n < 2; ++n) acc[a][b][m][n] = (f32x4){0.f, 0.f, 0.f, 0.f};
        cur = nxt; cA = nA; cB = nB; ++ui;
        if (GATHER) {
#pragma unroll
            for (int i = 0; i < 2; ++i) { cv0[i] = nv0[i]; cv1[i] = nv1[i]; } }
        if (wr == 1) PG8_BAR;
    }
    PG8_WAIT_V(0);
    PG8_BAR;
#undef PG8_SA
#undef PG8_SB
#undef PG8_STAGE
#undef PG8_LDA
#undef PG8_LDB
#undef PG8_MMA
#undef PG8_WAIT_V
#undef PG8_WAIT_L
#undef PG8_BAR
#undef PG8_SCHED
#undef PG8_SETV
}

DI void st4(bf16_t* p, f32x4 v) { u32x2 w; w.x = cvtpk(v[0], v[1]); w.y = cvtpk(v[2], v[3]); *(u32x2*)p = w; }
DI void st8(bf16_t* p, f32x4 a, f32x4 b) { u32x4 w; w.x = cvtpk(a[0], a[1]); w.y = cvtpk(a[2], a[3]); w.z = cvtpk(b[0], b[1]); w.w = cvtpk(b[2], b[3]); *(u32x4*)p = w; }

DI unsigned pk_fp8x4(f32x4 v) { int w = __builtin_amdgcn_cvt_pk_fp8_f32(v[0], v[1], 0, false); w = __builtin_amdgcn_cvt_pk_fp8_f32(v[2], v[3], w, true); return (unsigned)w; }
DI unsigned vt8_keyoff(int kap) { const int a = kap >> 5, c = kap & 31, h = (c >> 2) & 1, i = (c & 3) | ((c >> 3) << 2); return (unsigned)((h * 2 + a) * 512 + i); }
DI void st_fp8x4_strided(unsigned char* p, f32x4 v) {
    int w = __builtin_amdgcn_cvt_pk_fp8_f32(v[0], v[1], 0, false); w = __builtin_amdgcn_cvt_pk_fp8_f32(v[2], v[3], w, true);
    p[0] = (unsigned char)(w & 0xff); p[16] = (unsigned char)((w >> 8) & 0xff); p[32] = (unsigned char)((w >> 16) & 0xff); p[48] = (unsigned char)((unsigned)w >> 24);
}
struct EpiPlain {
    static constexpr bool PERM = true;
    bf16_t* O; int ldc;
    DI void operator()(const f32x4 (&acc)[2][2][4][2], const Unit& u, int ui, int wr, int wc, int fr, int fq) const {
        const int row0 = u.pm * BM + wr * 64 + fr, col0 = u.pn * BM + wc * 32 + 8 * fq;
#pragma unroll
        for (int ai = 0; ai < 2; ++ai)
#pragma unroll
            for (int m = 0; m < 4; ++m) { bf16_t* rowp = O + (size_t)(row0 + ai * HALF + m * 16) * ldc + col0;
#pragma unroll
                for (int bj = 0; bj < 2; ++bj) st8(rowp + bj * HALF, acc[ai][bj][m][0], acc[ai][bj][m][1]); }
    }
};
struct EpiPlain8 {
    static constexpr bool PERM = true;
    unsigned char* O; int ldc;
    DI void operator()(const f32x4 (&acc)[2][2][4][2], const Unit& u, int ui, int wr, int wc, int fr, int fq) const {
        const int row0 = u.pm * BM + wr * 64 + fr, col0 = u.pn * BM + wc * 32 + 8 * fq;
#pragma unroll
        for (int ai = 0; ai < 2; ++ai)
#pragma unroll
            for (int m = 0; m < 4; ++m) { unsigned char* rowp = O + (size_t)(row0 + ai * HALF + m * 16) * ldc + col0;
#pragma unroll
                for (int bj = 0; bj < 2; ++bj) { u32x2 w; w.x = pk_fp8x4(acc[ai][bj][m][0] * 64.f); w.y = pk_fp8x4(acc[ai][bj][m][1] * 64.f); *(u32x2*)(rowp + bj * HALF) = w; } }
    }
};
struct EpiGU {
    static constexpr bool PERM = true;
    unsigned char* O;
    DI static f32x4 silu_mul(f32x4 g, f32x4 u) { f32x4 r;
#pragma unroll
        for (int e = 0; e < 4; ++e) r[e] = g[e] * fast_rcp(1.f + fast_exp2(-g[e] * LOG2E)) * u[e];
        return r; }
    DI void operator()(const f32x4 (&acc)[2][2][4][2], const Unit& u, int ui, int wr, int wc, int fr, int fq) const {
        const int row0 = u.pm * BM + wr * 64 + fr, col0 = u.pn * HALF + wc * 32 + 8 * fq;
#pragma unroll
        for (int ai = 0; ai < 2; ++ai)
#pragma unroll
            for (int m = 0; m < 4; ++m) { unsigned char* rowp = O + (size_t)(row0 + ai * HALF + m * 16) * DEXP + col0;
                u32x2 w; w.x = pk_fp8x4(silu_mul(acc[ai][0][m][0], acc[ai][1][m][0])); w.y = pk_fp8x4(silu_mul(acc[ai][0][m][1], acc[ai][1][m][1])); *(u32x2*)rowp = w; }
    }
};
template <int LAYER> struct EpiInProj {
    static constexpr bool PERM = false;
    unsigned char* ws;
    DI void operator()(const f32x4 (&acc)[2][2][4][2], const Unit& u, int ui, int wr, int wc, int fr_in, int fq) const {
        int fr = fr_in; asm volatile("" : "+v"(fr));
        bf16_t* const O = (bf16_t*)(ws + WS_QKV); const float* const r64c = (const float*)(ws + WS_ROPE); const float* const r64s = r64c + 4096; const float* const r32c = r64s + 4096; const float* const r32s = r32c + 2048;
        unsigned char* const vt8 = ws + WS_VT8D; unsigned char* const q8d = ws + WS_Q8D; unsigned char* const k8d = ws + WS_K8D; unsigned char* const k8r = ws + WS_K8R;
        const int bidx = u.pm / 65; const bool ctx = (u.pm - bidx * 65) == 0;
        const float C2 = 0.125f * LOG2E;
#pragma unroll
        for (int bj = 0; bj < 2; ++bj) {
            const int g = 2 * u.pn + bj;
            bool rope64, scale, rope32 = false, skip = false;
            if (LAYER == 0) { rope64 = !ctx && g <= 4; scale = (g <= 3) || (g >= 6 && g <= 9); }
            else { rope64 = !ctx && g <= 7; scale = g <= 3; rope32 = !ctx && g == 17 && wc == 0; skip = (g == 17 && wc != 0); }
            if (skip) continue;
            const int col0 = g * HALF + wc * 32 + 4 * fq;
#pragma unroll
            for (int ai = 0; ai < 2; ++ai)
#pragma unroll
                for (int m = 0; m < 4; ++m) {
                    const int row = u.pm * BM + ai * HALF + wr * 64 + m * 16 + fr;
                    const int s = row - (bidx * RB + CTXL);
                    f32x4 v0 = acc[ai][bj][m][0], v1 = acc[ai][bj][m][1];
                    if (rope64) { const int pos = (wc & 1) ? (s & 63) : (s >> 6);
                        const f32x4 c4 = *(const f32x4*)(r64c + pos * 16 + 4 * fq), s4 = *(const f32x4*)(r64s + pos * 16 + 4 * fq);
                        const f32x4 y0 = v0 * c4 - v1 * s4, y1 = v1 * c4 + v0 * s4; v0 = y0; v1 = y1; }
                    if (rope32) { const int pos = (fq >= 2) ? (s & 63) : (s >> 6);
                        const f32x4 c4 = *(const f32x4*)(r32c + pos * 8 + 4 * (fq & 1)), s4 = *(const f32x4*)(r32s + pos * 8 + 4 * (fq & 1));
                        const f32x4 y0 = v0 * c4 - v1 * s4, y1 = v1 * c4 + v0 * s4; v0 = y0; v1 = y1; }
                    if (scale) { v0 = v0 * C2; v1 = v1 * C2; }
                    if (LAYER == 0) {
                        const int hsel = wc >> 1, dim0 = (wc & 1) * 32 + 4 * fq;
                        const int rr = row - bidx * RB, kt = rr >> 6, kap = rr & 63;
                        if (g <= 3 || (g >= 6 && g <= 9)) {
                            const int head = (g <= 3) ? (2 * g + hsel) : (2 * (g - 6) + hsel);
                            unsigned char* p8 = ws + (g <= 3 ? WS_Q8A : WS_Q8B) + (size_t)row * 512 + head * 64 + dim0;
                            *(unsigned*)p8 = pk_fp8x4(v0 * 8.f); *(unsigned*)(p8 + 16) = pk_fp8x4(v1 * 8.f);
                        } else if (g == 4 || (g >= 10 && g <= 13)) {
                            const size_t img = (g == 4) ? ((size_t)(bidx * 2 + hsel) * 260 + kt) : ((size_t)(bidx * 8 + 2 * (g - 10) + hsel) * 260 + kt);
                            unsigned char* p8 = ws + (g == 4 ? WS_K8A : WS_K8B) + img * 4096 + ((wc & 1) * 2) * 1024 + kap * 16 + 4 * fq;
                            *(unsigned*)p8 = pk_fp8x4(v0); *(unsigned*)(p8 + 1024) = pk_fp8x4(v1);
                        } else {
                            const size_t img = (g == 5) ? ((size_t)(bidx * 2 + hsel) * 260 + kt) : ((size_t)(bidx * 8 + 2 * (g - 14) + hsel) * 260 + kt);
                            unsigned char* p8 = ws + (g == 5 ? WS_VT8A : WS_VT8B) + img * 4096 + (wc & 1) * 2048 + vt8_keyoff(kap) + (4 * fq) * 16;
                            st_fp8x4_strided(p8, v0); st_fp8x4_strided(p8 + 256, v1);
                        }
                        if (m & 1) asm volatile("" ::: "memory"); continue;
                    }
                    if (LAYER == 1 && g <= 3) {
                        unsigned char* p8 = q8d + (size_t)row * 512 + g * HALF + wc * 32 + 4 * fq;
                        *(unsigned*)p8 = pk_fp8x4(v0 * 8.f); *(unsigned*)(p8 + 16) = pk_fp8x4(v1 * 8.f);
                        if (m & 1) asm volatile("" ::: "memory"); continue;
                    }
                    if (LAYER == 1 && g >= 4 && g <= 7) {
                        const int rr = row - bidx * RB, kt = rr >> 6, kap = rr & 63;
                        unsigned char* p8 = k8d + ((size_t)(bidx * 4 + (g - 4)) * 260 + kt) * 8192 + (wc >> 1) * 4096 + ((wc & 1) * 2) * 1024 + kap * 16 + 4 * fq;
                        *(unsigned*)p8 = pk_fp8x4(v0); *(unsigned*)(p8 + 1024) = pk_fp8x4(v1);
                        if (m & 1) asm volatile("" ::: "memory"); continue;
                    }
                    if (LAYER == 1 && g == 17) {
                        const int rr = row - bidx * RB, kt = rr >> 6, kap = rr & 63;
                        unsigned char* p8 = k8r + ((size_t)bidx * 260 + kt) * 2048 + kap * 16 + 4 * fq;
                        *(unsigned*)p8 = pk_fp8x4(v0); *(unsigned*)(p8 + 1024) = pk_fp8x4(v1);
                        if (m & 1) asm volatile("" ::: "memory"); continue;
                    }
                    if (LAYER == 1 && g >= 8 && g <= 11) {
                        const int rr = row - bidx * RB, kt = rr >> 6;
                        unsigned char* p8 = vt8 + ((size_t)(bidx * 4 + (g - 8)) * 260 + kt) * 8192 + wc * 2048 + vt8_keyoff(rr & 63) + (4 * fq) * 16;
                        st_fp8x4_strided(p8, v0); st_fp8x4_strided(p8 + 256, v1);
                        if (m & 1) asm volatile("" ::: "memory"); continue;
                    }
                    bf16_t* p = O + (size_t)row * NQKV + col0;
                    st4(p, v0); st4(p + 16, v1);
                    if (m & 1) asm volatile("" ::: "memory");
                }
        }
    }
};

struct EpiUKV {
    static constexpr bool PERM = true;
    unsigned char* k8; const LAS float* rs; unsigned char* vt8;
    DI void operator()(const f32x4 (&acc)[2][2][4][2], const Unit& u, int ui, int wr, int wc, int fr_in, int fq) const {
        int fr = fr_in;
        asm volatile("" : "+v"(fr));
        const int lr0 = wr * 64 + fr, bidx = u.pm / 65;
#pragma unroll
        for (int ai = 0; ai < 2; ++ai)
#pragma unroll
            for (int m = 0; m < 4; ++m) { const int lr = lr0 + ai * HALF + m * 16; const float s = rs[ui * 256 + lr]; const int row = u.pm * BM + lr;
                if (u.pn < 2) { const int rr = row - bidx * RB, kt = rr >> 6, kap = rr & 63;
#pragma unroll
                    for (int bj = 0; bj < 2; ++bj) { const int col = u.pn * BM + bj * HALF + wc * 32 + 8 * fq, head = col >> 6, dim = col & 63;
                        unsigned char* p = k8 + ((size_t)(bidx * 8 + head) * 260 + kt) * 4096 + (dim >> 4) * 1024 + kap * 16 + (dim & 15);
                        u32x2 w; w.x = pk_fp8x4(acc[ai][bj][m][0] * s); w.y = pk_fp8x4(acc[ai][bj][m][1] * s); *(u32x2*)p = w; }
                } else { const int rr = row - bidx * RB, kt = rr >> 6;
#pragma unroll
                    for (int bj = 0; bj < 2; ++bj) { const int col = (u.pn - 2) * BM + bj * HALF + wc * 32 + 8 * fq, head = col >> 6, d = col & 63;
                        unsigned char* p = vt8 + ((size_t)(bidx * 8 + head) * 260 + kt) * 4096 + (d >> 5) * 2048 + vt8_keyoff(rr & 63) + (d & 31) * 16;
                        st_fp8x4_strided(p, acc[ai][bj][m][0] * s); st_fp8x4_strided(p + 64, acc[ai][bj][m][1] * s); } }
            }
    }
};
struct EpiUQ {
    static constexpr bool PERM = false;
    unsigned char* q8; const LAS float* rs; const float* r32c; const float* r32s;
    DI void operator()(const f32x4 (&acc)[2][2][4][2], const Unit& u, int ui, int wr, int wc, int fr, int fq) const {
        const int bidx = u.pm / 65;
        const float C2 = 0.10206207261596577f * LOG2E * 8.f;
#pragma unroll
        for (int bj = 0; bj < 2; ++bj) {
            int off;
            if (u.pn < 2) { const int col = u.pn * BM + bj * HALF + wc * 32 + 4 * fq; off = (col >> 6) * 96 + (col & 63); }
            else off = (bj * 4 + wc) * 96 + 64 + 4 * fq;
#pragma unroll
            for (int ai = 0; ai < 2; ++ai)
#pragma unroll
                for (int m = 0; m < 4; ++m) {
                    const int lr = ai * HALF + wr * 64 + m * 16 + fr, row = u.pm * BM + lr;
                    const int s = row - (bidx * RB + CTXL);
                    const float sc = rs[ui * 256 + lr] * C2;
                    f32x4 v0 = acc[ai][bj][m][0] * sc, v1 = acc[ai][bj][m][1] * sc;
                    if (u.pn == 2) { const int pos = (fq >= 2) ? (s & 63) : (s >> 6);
                        const f32x4 c4 = *(const f32x4*)(r32c + pos * 8 + 4 * (fq & 1)), s4 = *(const f32x4*)(r32s + pos * 8 + 4 * (fq & 1));
                        const f32x4 y0 = v0 * c4 - v1 * s4, y1 = v1 * c4 + v0 * s4; v0 = y0; v1 = y1; }
                    unsigned char* p = q8 + (size_t)row * 768 + off;
                    *(unsigned*)p = pk_fp8x4(v0); *(unsigned*)(p + 16) = pk_fp8x4(v1);
                }
        }
    }
};
}

namespace att {
constexpr float THR = 8.f;
struct P {
    const unsigned char* q8; int qpitch;
    const unsigned char* k8; const unsigned char* k8r;
    const unsigned char* v8;
    unsigned char* o; int opitch;
    int nt, t_lo, kind, s0;
    float sink2, lam; const float* subln;
};
DI int crow(int r, int hi) { return (r & 3) + 8 * (r >> 2) + 4 * hi; }
DI float xsum32(float v) { auto rr = __builtin_amdgcn_permlane32_swap(__float_as_uint(v), __float_as_uint(v), false, false); return __uint_as_float(rr[0]) + __uint_as_float(rr[1]); }
DI int ximax32(int v) { auto rr = __builtin_amdgcn_permlane32_swap((unsigned)v, (unsigned)v, false, false); const int a = (int)rr[0], b = (int)rr[1]; return a > b ? a : b; }
DI float xmax32(float v) { auto rr = __builtin_amdgcn_permlane32_swap(__float_as_uint(v), __float_as_uint(v), false, false); float r; asm("v_max_f32 %0, %1, %2" : "=v"(r) : "v"(rr[0]), "v"(rr[1])); return r; }
#define ATT_WAITBAR() asm volatile("s_waitcnt vmcnt(0) lgkmcnt(0)\n\ts_barrier" ::: "memory")

DI void glds16s(unsigned voff, const void* sbase, unsigned lds_dst) { unsigned keep;
    asm volatile("s_mov_b32 %0, m0\n\ts_mov_b32 m0, %3\n\ts_nop 0\n\tglobal_load_lds_dwordx4 %1, %2\n\ts_mov_b32 m0, %0" : "=&s"(keep) : "v"(voff), "s"(sbase), "s"(lds_dst) : "memory"); }
#define ATT_WAITN_BAR(N) asm volatile("s_waitcnt vmcnt(" #N ") lgkmcnt(0)\n\ts_barrier" ::: "memory")
typedef int v8i_t __attribute__((ext_vector_type(8)));
DI f32x16 mfma_f8(v8i_t a, v8i_t b, f32x16 c) { return __builtin_amdgcn_mfma_scale_f32_32x32x64_f8f6f4(a, b, c, 0, 0, 0, 0x7f7f7f7f, 0, 0x7f7f7f7f); }
DI f32x16 mfma_f8s(v8i_t a, v8i_t b, f32x16 c, int sb) { return __builtin_amdgcn_mfma_scale_f32_32x32x64_f8f6f4(a, b, c, 0, 0, 0, 0x7f7f7f7f, 0, sb); }
typedef float f32x4v __attribute__((ext_vector_type(4)));
DI f32x4v mfma_f8s16(v8i_t a, v8i_t b, f32x4v c, int sb) { return __builtin_amdgcn_mfma_scale_f32_16x16x128_f8f6f4(a, b, c, 0, 0, 0, 0x7f7f7f7f, 0, sb); }
constexpr float F8_OFF = 4.f;
DI f32x16 mfma_f8q(v8i_t a, v8i_t b, f32x16 c) { return __builtin_amdgcn_mfma_scale_f32_32x32x64_f8f6f4(a, b, c, 0, 0, 0, 0x7f7f7f7f, 0, 0x7c7c7c7c); }
template <int MODE> DI void attn_unit_f8q(const P& p, LAS unsigned char* lds) {
    constexpr int DV = MODE == 2 ? 128 : 64;
    constexpr int NKC = MODE == 1 ? 6 : 8;
    constexpr int KSLOT = NKC * 1024, VSLOT = DV * 64, VRING = 4 * KSLOT, NDB = DV / 32;
    constexpr int NQK = MODE == 1 ? 4 : 2;
    const int tid = threadIdx.x, lane = tid & 63, r32 = lane & 31, hi = lane >> 5; const int wid = __builtin_amdgcn_readfirstlane(tid >> 6);
    const int sub = (MODE == 2) ? (wid >> 2) : 0;
    const int qrow = (MODE == 2) ? (32 * (wid & 3) + r32) : (32 * wid + r32);
    const int nt = p.nt;
    const unsigned ldsb = (unsigned)(size_t)lds;
    v8i_t qf[MODE == 1 ? 2 : 1];
    { const unsigned char* qp = p.q8 + (size_t)qrow * p.qpitch + (MODE == 2 ? sub * 64 : 0);
      const u32x4 a0 = *(const u32x4*)(qp + 32 * hi), a1 = *(const u32x4*)(qp + 32 * hi + 16);
      qf[0] = (v8i_t){(int)a0[0], (int)a0[1], (int)a0[2], (int)a0[3], (int)a1[0], (int)a1[1], (int)a1[2], (int)a1[3]};
      if (MODE == 1) { u32x4 b0 = *(const u32x4*)(qp + 64), b1 = *(const u32x4*)(qp + 80);
          if (hi) { b0 = (u32x4){0u, 0u, 0u, 0u}; b1 = b0; }
          qf[MODE == 1 ? 1 : 0] = (v8i_t){(int)b0[0], (int)b0[1], (int)b0[2], (int)b0[3], (int)b1[0], (int)b1[1], (int)b1[2], (int)b1[3]}; } }
    const int kpc = (MODE == 1) ? (wid < 6 ? wid : wid - 2) : wid;
    const int vpc = (MODE == 1) ? (wid & 3) : wid;
    const unsigned koff = (unsigned)(((MODE == 1 && kpc >= 4) ? (kpc - 4) : kpc) * 1024 + lane * 16);
    const unsigned voff = (unsigned)(vpc * 1024 + lane * 16);
    const unsigned char* kbase = (MODE == 1 && kpc >= 4) ? p.k8r : p.k8;
    const size_t kstep = (MODE == 1) ? ((kpc >= 4) ? 2048 : 4096) : 8192;
#define AQ_ISSUE_K(t) do { const int t_ = (t); if (t_ < nt) { const unsigned sb_ = ldsb + (unsigned)((t_ & 3) * KSLOT); \
        glds16s(koff, kbase + (size_t)t_ * kstep, (unsigned)__builtin_amdgcn_readfirstlane(sb_ + kpc * 1024)); } } while (0)
#define AQ_ISSUE_V(t) do { const int t_ = (t); if (t_ < nt) { const unsigned sb_ = ldsb + (unsigned)(VRING + ((t_ + 3) & 7) * VSLOT); \
        glds16s(voff, p.v8 + (size_t)t_ * VSLOT, (unsigned)__builtin_amdgcn_readfirstlane(sb_ + vpc * 1024)); } } while (0)
    float m = 0.f, l = 0.f;
    if (wid >= 4) __builtin_amdgcn_s_setprio(1);
    f32x16 o[NDB], negm, sa0, sa1, sb0, sb1;
#pragma unroll
    for (int db = 0; db < NDB; ++db)
#pragma unroll
        for (int i = 0; i < 16; ++i) o[db][i] = 0.f;
#pragma unroll
    for (int i = 0; i < 16; ++i) negm[i] = 0.f;
    const int vo = hi * 1024 + r32 * 16;
    const int ko_n = ((MODE == 2 ? sub * 4 : 0) + 2 * hi) * 1024 + r32 * 16;
    const int ko_r = 4 * 1024 + r32 * 16;
    u32x4 kfl[MODE == 1 ? 2 : 1], kfh[MODE == 1 ? 2 : 1], vfl[MODE == 1 ? 2 : 1], vfh[MODE == 1 ? 2 : 1]; v8i_t pfa, pfb;
    f32x4v ol = (f32x4v){0.f, 0.f, 0.f, 0.f};
    const int onesw = ((lane & 15) == ((lane >> 4) & 1)) ? 0x38383838 : 0;
    const v8i_t ones_fr = (v8i_t){onesw, onesw, onesw, onesw, onesw, onesw, onesw, onesw};
#define AQ_SB() __builtin_amdgcn_sched_barrier(0)
#define AQ_LDKF(s_, j, Ks_) do { const int o_ = ((MODE == 1 && ((j) >> 1)) ? ko_r : ko_n) + ((j) & 1) * 512; kfl[s_] = *(const LAS u32x4*)((Ks_) + o_); kfh[s_] = *(const LAS u32x4*)((Ks_) + o_ + 1024); } while (0)
#define AQ_LDVF(s_, db, Vs_) do { vfl[s_] = *(const LAS u32x4*)((Vs_) + (db) * 2048); vfh[s_] = *(const LAS u32x4*)((Vs_) + (db) * 2048 + 512); } while (0)
#define AQ_KF(s_) ((v8i_t){(int)kfl[s_][0], (int)kfl[s_][1], (int)kfl[s_][2], (int)kfl[s_][3], (int)kfh[s_][0], (int)kfh[s_][1], (int)kfh[s_][2], (int)kfh[s_][3]})
#define AQ_VF(s_) ((v8i_t){(int)vfl[s_][0], (int)vfl[s_][1], (int)vfl[s_][2], (int)vfl[s_][3], (int)vfh[s_][0], (int)vfh[s_][1], (int)vfh[s_][2], (int)vfh[s_][3]})
#define AQ_Q(j, s_, N0, N1) do { if ((j) & 1) { if ((j) < 2) N1 = mfma_f8q(AQ_KF(s_), qf[0], negm); else N1 = mfma_f8q(AQ_KF(s_), qf[MODE == 1 ? 1 : 0], N1); asm volatile("" : "+v"(N1)); } \
        else { if ((j) < 2) N0 = mfma_f8q(AQ_KF(s_), qf[0], negm); else N0 = mfma_f8q(AQ_KF(s_), qf[MODE == 1 ? 1 : 0], N0); asm volatile("" : "+v"(N0)); } } while (0)
#define AQ_P(db, s_, PF) do { o[db] = mfma_f8(AQ_VF(s_), PF, o[db]); asm volatile("" : "+v"(o[db])); } while (0)
#define AQ_PL(PF) do { ol = mfma_f8s16(ones_fr, PF, ol, 0x7f7f7f7f); asm volatile("" : "+v"(ol)); } while (0)
#define AQ_EXP8(g, C) do { const int b_ = 8 * ((g) & 1); _Pragma("unroll") for (int i_ = 0; i_ < 8; ++i_) { C[b_ + i_] = fast_exp2(C[b_ + i_]); asm volatile("" : "+v"(C[b_ + i_])); } } while (0)
#define AQ_CVT4(g, C, PF) do { const int b_ = 8 * ((g) & 1); \
        int w0_, w1_; asm volatile("" : "=v"(w0_), "=v"(w1_));                                                    \
        w0_ = __builtin_amdgcn_cvt_pk_fp8_f32(C[b_ + 0], C[b_ + 1], w0_, false); w0_ = __builtin_amdgcn_cvt_pk_fp8_f32(C[b_ + 2], C[b_ + 3], w0_, true); \
        w1_ = __builtin_amdgcn_cvt_pk_fp8_f32(C[b_ + 4], C[b_ + 5], w1_, false); w1_ = __builtin_amdgcn_cvt_pk_fp8_f32(C[b_ + 6], C[b_ + 7], w1_, true); \
        asm volatile("" : "+v"(w0_), "+v"(w1_)); PF[2 * (g)] = w0_; PF[2 * (g) + 1] = w1_; } while (0)
#define AQ_EXP(g, C0, C1) do { if ((g) < 2) AQ_EXP8(g, C0); else AQ_EXP8(g, C1); } while (0)
#define AQ_CVT(g, C0, C1, PF) do { if ((g) < 2) AQ_CVT4(g, C0, PF); else AQ_CVT4(g, C1, PF); } while (0)
#define AQ_IMAX(a_, b_) ((a_) > (b_) ? (a_) : (b_))
#define AQ_TILE(C0, C1, N0, N1, PFC, PFP, HASN, HASP, MID, tm, KSC, VSC) do { \
        const LAS unsigned char* Ks_ = ((KSC) >= 0) ? lds + (KSC) * KSLOT : lds + ks_next * KSLOT;                   \
        const LAS unsigned char* Vs_ = ((VSC) >= 0) ? vqb + (VSC) * VSLOT : lds + VRING + vs_prev * VSLOT + vo; \
        if (HASN) { AQ_LDKF(0, 0, Ks_); if (MODE == 1) AQ_LDKF(1, 1, Ks_); } if (HASP) { AQ_LDVF(0, 0, Vs_); if (MODE == 1) AQ_LDVF(1, 1, Vs_); } \
        AQ_EXP(0, C0, C1); AQ_SB(); \
        if (MODE == 1) { if (HASN) { AQ_Q(0, 0, N0, N1); AQ_Q(1, 1, N0, N1); AQ_LDKF(0, 2, Ks_); AQ_LDKF(1, 3, Ks_); } } \
        else { if (HASN) { AQ_Q(0, 0, N0, N1); AQ_LDKF(0, 1, Ks_); } if (HASP) { AQ_P(0, 0, PFP); AQ_LDVF(0, 1, Vs_); } } AQ_SB(); \
        AQ_CVT(0, C0, C1, PFC); AQ_EXP(1, C0, C1); AQ_SB(); \
        if (MODE == 1) { if (HASN) { AQ_Q(2, 0, N0, N1); AQ_Q(3, 1, N0, N1); } } \
        else { if (HASN) AQ_Q(1, 0, N0, N1); if (HASP) { AQ_P(1, 0, PFP); AQ_LDVF(0, 2, Vs_); } } AQ_SB(); \
        AQ_CVT(1, C0, C1, PFC); AQ_SB(); \
        if (MID) ATT_WAITN_BAR(0);                                         \
        if (HASP) { if (MODE == 1) { AQ_P(0, 0, PFP); AQ_P(1, 1, PFP); } else { AQ_P(2, 0, PFP); AQ_LDVF(0, 3, Vs_); AQ_PL(PFP); } } \
        if (MID) { AQ_ISSUE_K((tm) + 4); AQ_ISSUE_K((tm) + 5); AQ_ISSUE_V((tm) + 2); AQ_ISSUE_V((tm) + 3); } AQ_SB(); \
        AQ_EXP(2, C0, C1); AQ_CVT(2, C0, C1, PFC); AQ_EXP(3, C0, C1); AQ_SB(); \
        if (HASP) { if (MODE == 1) AQ_PL(PFP); else AQ_P(3, 0, PFP); } AQ_SB(); \
        AQ_CVT(3, C0, C1, PFC); \
        if (HASN) { int ri_ = AQ_IMAX(AQ_IMAX(__float_as_int(N0[0]), __float_as_int(N1[0])), __float_as_int(N0[1]));     \
            _Pragma("unroll") for (int i_ = 1; i_ < 15; ++i_) ri_ = AQ_IMAX(AQ_IMAX(ri_, __float_as_int(N1[i_])), __float_as_int(N0[i_ + 1])); \
            ri_ = AQ_IMAX(ri_, __float_as_int(N1[15])); \
            if (__any(__int_as_float(ri_) > THR)) {                                                                                    \
                const float rm_ = __int_as_float(ximax32(ri_)); \
                { const LAS unsigned char* Vn_ = lds + VRING + ((vs_prev + 1) & 7) * VSLOT + vo;                    \
                  _Pragma("unroll") for (int db_ = 0; db_ < NDB; ++db_) { AQ_LDVF(0, db_, Vn_); AQ_P(db_, 0, PFC); } AQ_PL(PFC); \
                  _Pragma("unroll") for (int i_ = 0; i_ < 8; ++i_) PFC[i_] = 0; } \
                const float dl_ = fmaxf(rm_ - F8_OFF, 0.f); m += dl_; const float f_ = fast_exp2(-dl_); ol[0] *= __shfl(f_, lane & 15); ol[1] *= __shfl(f_, (lane & 15) + 16); \
                _Pragma("unroll") for (int i_ = 0; i_ < 16; ++i_) { N0[i_] -= dl_; N1[i_] -= dl_; negm[i_] = -m; } \
                _Pragma("unroll") for (int db_ = 0; db_ < NDB; ++db_) _Pragma("unroll") for (int i_ = 0; i_ < 16; ++i_) o[db_][i_] *= f_; } } \
        ks_next = (ks_next + 1) & 3; vs_prev = (vs_prev + 1) & 7; } while (0)
    AQ_ISSUE_K(0); AQ_ISSUE_K(1); AQ_ISSUE_K(2); AQ_ISSUE_V(0);
    ATT_WAITN_BAR(0);
    { const LAS unsigned char* Ks_ = lds;
#pragma unroll
      for (int j = 0; j < NQK; ++j) { AQ_LDKF(MODE == 1 ? (j & 1) : 0, j, Ks_); AQ_Q(j, MODE == 1 ? (j & 1) : 0, sa0, sa1); }
      float rm = fmaxf(sa0[0], sa1[0]);
#pragma unroll
      for (int i = 1; i < 16; ++i) rm = fmaxf(fmaxf(rm, sa0[i]), sa1[i]);
      rm = xmax32(rm) - F8_OFF; m = rm;
#pragma unroll
      for (int i = 0; i < 16; ++i) { sa0[i] -= rm; sa1[i] -= rm; negm[i] = -rm; } }
    const LAS unsigned char* vqb = lds;
    int ks_next = 1, vs_prev = 2;
    ATT_WAITN_BAR(0); AQ_ISSUE_K(3); AQ_ISSUE_K(4); AQ_ISSUE_V(1); AQ_ISSUE_V(2);
    AQ_TILE(sa0, sa1, sb0, sb1, pfa, pfb, true, false, false, 0, -1, -1); AQ_TILE(sb0, sb1, sa0, sa1, pfb, pfa, true, true, true, 1, -1, -1);
    int t = 2;
    for (; t + 4 <= nt - 2; t += 4) {
        vqb = lds + VRING + ((t + 2) & 7) * VSLOT + vo;
        AQ_TILE(sa0, sa1, sb0, sb1, pfa, pfb, true, true, false, 0, 3, 0); AQ_TILE(sb0, sb1, sa0, sa1, pfb, pfa, true, true, true, t + 1, 0, 1);
        AQ_TILE(sa0, sa1, sb0, sb1, pfa, pfb, true, true, false, 0, 1, 2); AQ_TILE(sb0, sb1, sa0, sa1, pfb, pfa, true, true, true, t + 3, 2, 3);
    }
    for (; t < nt - 2; t += 2) {
        AQ_TILE(sa0, sa1, sb0, sb1, pfa, pfb, true, true, false, 0, -1, -1); AQ_TILE(sb0, sb1, sa0, sa1, pfb, pfa, true, true, true, t + 1, -1, -1);
    }
    AQ_TILE(sa0, sa1, sb0, sb1, pfa, pfb, true, true, false, 0, -1, -1); AQ_TILE(sb0, sb1, sa0, sa1, pfb, pfa, false, true, true, nt - 1, -1, -1);
    { const LAS unsigned char* Vs_ = lds + VRING + vs_prev * VSLOT + vo;
      if (MODE == 1) { AQ_LDVF(0, 0, Vs_); AQ_LDVF(1, 1, Vs_); AQ_P(0, 0, pfb); AQ_P(1, 1, pfb); }
      else {
#pragma unroll
          for (int db = 0; db < NDB; ++db) { AQ_LDVF(0, db, Vs_); AQ_P(db, 0, pfb); } }
      AQ_PL(pfb); }
    { const float l0 = __shfl(ol[0], lane & 15), l1 = __shfl(ol[1], lane & 15); l = (lane & 16) ? l1 : l0; }
    const float inv = fast_rcp(l);
    if (MODE != 2) {
#pragma unroll
        for (int db = 0; db < NDB; ++db)
#pragma unroll
            for (int g = 0; g < 4; ++g) { const f32x4 v4 = (f32x4){o[db][4 * g], o[db][4 * g + 1], o[db][4 * g + 2], o[db][4 * g + 3]} * inv;
                *(unsigned*)(p.o + (size_t)qrow * p.opitch + 32 * db + 8 * g + 4 * hi) = pg8::pk_fp8x4(v4 * 32.f); }
    } else {
        LAS float* X = (LAS float*)lds;
        ATT_WAITBAR();
        if (sub == 1) {
#pragma unroll
            for (int db = 0; db < NDB; ++db)
#pragma unroll
                for (int i = 0; i < 16; ++i) X[((wid - 4) * 64 + db * 16 + i) * 64 + lane] = o[db][i] * inv;
        }
        ATT_WAITBAR();
        if (sub == 0) {
            float ss = 0.f;
#pragma unroll
            for (int db = 0; db < NDB; ++db)
#pragma unroll
                for (int i = 0; i < 16; ++i) { const float val = o[db][i] * inv - p.lam * X[(wid * 64 + db * 16 + i) * 64 + lane]; o[db][i] = val; ss += val * val; }
            ss = xsum32(ss);
            const float rstd = (1.0f - LAM_INIT) / sqrtf(ss * (1.0f / 128.0f) + 1e-6f);
#pragma unroll
            for (int db = 0; db < NDB; ++db)
#pragma unroll
                for (int g = 0; g < 4; ++g) { const int d = 32 * db + 8 * g + 4 * hi; const f32x4 w4 = *(const f32x4*)(p.subln + d);
                    const f32x4 v4 = (f32x4){o[db][4 * g], o[db][4 * g + 1], o[db][4 * g + 2], o[db][4 * g + 3]} * rstd * w4;
                    *(unsigned*)(p.o + (size_t)qrow * p.opitch + d) = pg8::pk_fp8x4(v4 * 32.f); }
        }
    }
    __builtin_amdgcn_s_setprio(0);
    ATT_WAITBAR();
#undef AQ_ISSUE_K
#undef AQ_ISSUE_V
#undef AQ_SB
#undef AQ_LDKF
#undef AQ_LDVF
#undef AQ_KF
#undef AQ_VF
#undef AQ_Q
#undef AQ_P
#undef AQ_PL
#undef AQ_EXP8
#undef AQ_CVT4
#undef AQ_EXP
#undef AQ_CVT
#undef AQ_IMAX
#undef AQ_TILE
}

DI void attn_unit_f8l0(const P& p, LAS unsigned char* lds, const LAS float* rpbL) {
    constexpr int KSLOT = 4096, VSLOT = 4096, VRING = 3 * KSLOT, NDB = 2;
    const int tid = threadIdx.x, lane = tid & 63, r32 = lane & 31, hi = lane >> 5; const int wid = __builtin_amdgcn_readfirstlane(tid >> 6);
    const int qrow = 32 * wid + r32;
    const int nt = p.nt;
    const unsigned ldsb = (unsigned)(size_t)lds;
    v8i_t qf;
    { const unsigned char* qp = p.q8 + (size_t)qrow * p.qpitch;
      const u32x4 a0 = *(const u32x4*)(qp + 32 * hi), a1 = *(const u32x4*)(qp + 32 * hi + 16);
      qf = (v8i_t){(int)a0[0], (int)a0[1], (int)a0[2], (int)a0[3], (int)a1[0], (int)a1[1], (int)a1[2], (int)a1[3]}; }
    const bool isk = wid < 4; const int pc = wid & 3;
    const unsigned doff = (unsigned)(pc * 1024 + lane * 16);
    const unsigned char* dbase = isk ? p.k8 : p.v8;
#define L0_UT(t) (((t) >= 4) ? (p.t_lo + (t) - 4) : (t))
#define L0_ISSUE(t) do { const int tt_ = isk ? (t) + 3 : (t) + 2; if (tt_ >= 0 && tt_ < nt) { const unsigned sb_ = ldsb + (unsigned)((isk ? 0 : VRING) + (tt_ % 3) * 4096); \
        glds16s(doff, dbase + (size_t)L0_UT(tt_) * 4096, (unsigned)__builtin_amdgcn_readfirstlane(sb_ + pc * 1024)); } } while (0)
    float m = 0.f, l = 0.f;
    f32x16 o[NDB], negm, sa0, sa1, sb0, sb1, ol;
#pragma unroll
    for (int db = 0; db < NDB; ++db)
#pragma unroll
        for (int i = 0; i < 16; ++i) o[db][i] = 0.f;
#pragma unroll
    for (int i = 0; i < 16; ++i) { negm[i] = 0.f; ol[i] = 0.f; }
    const int onesw = (r32 == 0) ? 0x38383838 : 0;
    const v8i_t ones_fr = (v8i_t){onesw, onesw, onesw, onesw, onesw, onesw, onesw, onesw};
    const bool has_sink = (p.kind & 1) == 0;
    const int vo = hi * 1024 + r32 * 16;
    const int ko_n = (2 * hi) * 1024 + r32 * 16;
    u32x4 klo[2], khi[2]; v8i_t pf; u32x4 vlo[NDB], vhi[NDB];
#define L0_SB() __builtin_amdgcn_sched_barrier(0)
#define L0_LDK(j, Ks_) do { klo[j] = *(const LAS u32x4*)((Ks_) + ko_n + (j) * 512); khi[j] = *(const LAS u32x4*)((Ks_) + ko_n + (j) * 512 + 1024); } while (0)
#define L0_LDV(Vs_) do { _Pragma("unroll") for (int db_ = 0; db_ < NDB; ++db_) { vlo[db_] = *(const LAS u32x4*)((Vs_) + db_ * 2048); vhi[db_] = *(const LAS u32x4*)((Vs_) + db_ * 2048 + 512); } } while (0)
#define L0_KFR(j) ((v8i_t){(int)klo[j][0], (int)klo[j][1], (int)klo[j][2], (int)klo[j][3], (int)khi[j][0], (int)khi[j][1], (int)khi[j][2], (int)khi[j][3]})
#define L0_PV() do { _Pragma("unroll") for (int db_ = 0; db_ < NDB; ++db_) { \
        const v8i_t vfr_ = (v8i_t){(int)vlo[db_][0], (int)vlo[db_][1], (int)vlo[db_][2], (int)vlo[db_][3], (int)vhi[db_][0], (int)vhi[db_][1], (int)vhi[db_][2], (int)vhi[db_][3]}; \
        o[db_] = mfma_f8(vfr_, pf, o[db_]); } ol = mfma_f8(ones_fr, pf, ol); } while (0)
#define L0_VALU8(g, C) do { const int b_ = 8 * ((g) & 1); \
        _Pragma("unroll") for (int i_ = 0; i_ < 8; ++i_) { C[b_ + i_] = fast_exp2(C[b_ + i_]); } \
        int w0_, w1_; asm volatile("" : "=v"(w0_), "=v"(w1_));                                                    \
        w0_ = __builtin_amdgcn_cvt_pk_fp8_f32(C[b_ + 0], C[b_ + 1], w0_, false); w0_ = __builtin_amdgcn_cvt_pk_fp8_f32(C[b_ + 2], C[b_ + 3], w0_, true); \
        w1_ = __builtin_amdgcn_cvt_pk_fp8_f32(C[b_ + 4], C[b_ + 5], w1_, false); w1_ = __builtin_amdgcn_cvt_pk_fp8_f32(C[b_ + 6], C[b_ + 7], w1_, true); \
        asm volatile("" : "+v"(w0_), "+v"(w1_)); pf[2 * (g)] = w0_; pf[2 * (g) + 1] = w1_; } while (0)
#define L0_VALU(g, C0, C1) do { if ((g) < 2) L0_VALU8(g, C0); else L0_VALU8(g, C1); } while (0)
#define L0_CR(i_) (((i_) & 3) + 8 * ((i_) >> 2))
#define L0_MASK(tn, N0, N1) do { if ((tn) >= 4) { const int ut_ = L0_UT(tn); \
        if (p.kind == 0) { const int kb_ = (ut_ - 4) * 64 - (p.s0 + qrow) + 4 * hi + 128;                 \
            if (!__all(kb_ >= 0 && kb_ + 59 <= 256)) { \
            _Pragma("unroll") for (int i_ = 0; i_ < 16; ++i_) { if ((unsigned)(kb_ + L0_CR(i_)) > 256u) N0[i_] = -INFINITY; if ((unsigned)(kb_ + L0_CR(i_) + 32) > 256u) N1[i_] = -INFINITY; } } \
        } else if (p.kind == 1) { const int kr_ = ut_ - 4, r_ = (p.s0 >> 6) + (wid >> 1), qc_ = 32 * (wid & 1) + r32; int rs_ = r_ - 4; rs_ = rs_ < 0 ? 0 : (rs_ > 248 ? 248 : rs_); \
            const bool rowok_ = (kr_ >= rs_) && (kr_ < rs_ + 8); int cs_ = qc_ - 8; cs_ = cs_ < 0 ? 0 : (cs_ > 48 ? 48 : cs_); \
            int bri_ = kr_ - r_ + 7; bri_ = bri_ < 0 ? 0 : (bri_ > 14 ? 14 : bri_); \
            const LAS float* bp_ = rpbL + bri_ * 31 + (4 * hi - qc_ + 15);                                  \
            const int cb_ = rowok_ ? (4 * hi - cs_) : 4096;                                                     \
            _Pragma("unroll") for (int i_ = 0; i_ < 16; ++i_) { \
                const float b0_ = bp_[L0_CR(i_)], b1_ = bp_[L0_CR(i_) + 32]; \
                N0[i_] = ((unsigned)(cb_ + L0_CR(i_)) < 16u) ? N0[i_] + b0_ : -INFINITY; N1[i_] = ((unsigned)(cb_ + L0_CR(i_) + 32) < 16u) ? N1[i_] + b1_ : -INFINITY; } } } } while (0)
#define L0_TILE(t, C0, C1, N0, N1, HASN) do { \
        const LAS unsigned char* Ks_ = lds + ks_next * KSLOT; const LAS unsigned char* Vs_ = lds + VRING + vs_cur * VSLOT + vo; \
        if (HASN) L0_LDK(0, Ks_); L0_VALU(0, C0, C1); L0_SB(); \
        L0_VALU(1, C0, C1); if (HASN) { N0 = mfma_f8q(L0_KFR(0), qf, negm); asm volatile("" : "+v"(N0)); } L0_SB(); \
        if (HASN) L0_LDK(1, Ks_); L0_VALU(2, C0, C1); L0_SB(); \
        L0_LDV(Vs_); L0_VALU(3, C0, C1); if (HASN) { N1 = mfma_f8q(L0_KFR(1), qf, negm); asm volatile("" : "+v"(N1)); } L0_SB(); \
        L0_PV(); \
        if (HASN) { L0_MASK((t) + 1, N0, N1); float rm_ = fmaxf(N0[0], N1[0]); \
            _Pragma("unroll") for (int i_ = 1; i_ < 16; ++i_) rm_ = fmaxf(fmaxf(rm_, N0[i_]), N1[i_]); \
            rm_ = xmax32(rm_); \
            if (__any(rm_ > THR)) { const float dl_ = fmaxf(rm_ - F8_OFF, 0.f); m += dl_; const float f_ = fast_exp2(-dl_); ol[0] *= f_; \
                _Pragma("unroll") for (int i_ = 0; i_ < 16; ++i_) { N0[i_] -= dl_; N1[i_] -= dl_; negm[i_] = -m; } \
                _Pragma("unroll") for (int db_ = 0; db_ < NDB; ++db_) _Pragma("unroll") for (int i_ = 0; i_ < 16; ++i_) o[db_][i_] *= f_; } } \
        ks_next = (ks_next == 2) ? 0 : ks_next + 1; vs_cur = (vs_cur == 2) ? 0 : vs_cur + 1; } while (0)
#define L0_TOP(t) do { if ((t) + 2 < nt) ATT_WAITN_BAR(1); else ATT_WAITN_BAR(0); L0_ISSUE(t); } while (0)
    L0_ISSUE(-3);
    L0_ISSUE(-2);
    ATT_WAITBAR();
    L0_ISSUE(-1);
    { const LAS unsigned char* Ks_ = lds;
      L0_LDK(0, Ks_); L0_LDK(1, Ks_); sa0 = mfma_f8q(L0_KFR(0), qf, negm); sa1 = mfma_f8q(L0_KFR(1), qf, negm);
      float rm = fmaxf(sa0[0], sa1[0]);
#pragma unroll
      for (int i = 1; i < 16; ++i) rm = fmaxf(fmaxf(rm, sa0[i]), sa1[i]);
      rm = xmax32(rm); if (has_sink) rm = fmaxf(rm, p.sink2);
      rm -= F8_OFF; m = rm;
#pragma unroll
      for (int i = 0; i < 16; ++i) { sa0[i] -= rm; sa1[i] -= rm; negm[i] = -rm; }
      if (has_sink && hi == 0) ol[0] = fast_exp2(p.sink2 - m); }
    int ks_next = 1, vs_cur = 0;
    for (int t = 0; t < nt - 2; t += 2) {
        L0_TOP(t);     L0_TILE(t, sa0, sa1, sb0, sb1, true);
        L0_TOP(t + 1); L0_TILE(t + 1, sb0, sb1, sa0, sa1, true);
    }
    L0_TOP(nt - 2); L0_TILE(nt - 2, sa0, sa1, sb0, sb1, true);
    ATT_WAITN_BAR(0); L0_TILE(nt - 1, sb0, sb1, sa0, sa1, false);
    l = hi ? 0.f : ol[0];
    const float inv = fast_rcp(xsum32(l));
#pragma unroll
    for (int db = 0; db < NDB; ++db)
#pragma unroll
        for (int g = 0; g < 4; ++g) { const f32x4 v4 = (f32x4){o[db][4 * g], o[db][4 * g + 1], o[db][4 * g + 2], o[db][4 * g + 3]} * inv;
            *(unsigned*)(p.o + (size_t)qrow * p.opitch + 32 * db + 8 * g + 4 * hi) = pg8::pk_fp8x4(v4 * 32.f); }
    ATT_WAITBAR();
#undef L0_UT
#undef L0_ISSUE
#undef L0_SB
#undef L0_LDK
#undef L0_LDV
#undef L0_KFR
#undef L0_PV
#undef L0_VALU8
#undef L0_VALU
#undef L0_MASK
#undef L0_CR
#undef L0_TILE
#undef L0_TOP
}
}

struct Ctx {
    LAS unsigned char* lds; gu32* ctl; unsigned char* ws;
    int tid, lane, wave, vcu, G;
    const float* const __attribute__((address_space(4)))* inp;
    float* out;
};
DI const float* modp(const Ctx& F, int l, int which, int chunk) { return (const float*)(F.ws + WS_MOD) + ((size_t)(l * 3 + which) * 6 + chunk) * 1024; }

DI void ld_f32(const float* p, int lane, f32x4 (&v)[4]) {
#pragma unroll
    for (int j = 0; j < 4; ++j) v[j] = *(const f32x4*)(p + 4 * lane + 256 * j); }
DI void ld_bf16(const bf16_t* p, int lane, f32x4 (&v)[4]) {
#pragma unroll
    for (int j = 0; j < 4; ++j) { const u32x2 w = *(const u32x2*)(p + 4 * lane + 256 * j); v[j] = (f32x4){bf_lo(w.x), bf_hi(w.x), bf_lo(w.y), bf_hi(w.y)}; } }
DI void st_f32(float* p, int lane, const f32x4 (&v)[4]) {
#pragma unroll
    for (int j = 0; j < 4; ++j) *(f32x4*)(p + 4 * lane + 256 * j) = v[j]; }
DI void st_bf16(bf16_t* p, int lane, const f32x4 (&v)[4]) {
#pragma unroll
    for (int j = 0; j < 4; ++j) pg8::st4(p + 4 * lane + 256 * j, v[j]); }
DI void st_fp8row(unsigned char* p, int lane, const f32x4 (&v)[4]) {
#pragma unroll
    for (int j = 0; j < 4; ++j) *(unsigned*)(p + 4 * lane + 256 * j) = pg8::pk_fp8x4(v[j]); }
DI void ld_f32_nt(const float* p, int lane, f32x4 (&v)[4]) {
#pragma unroll
    for (int j = 0; j < 4; ++j) v[j] = __builtin_nontemporal_load((const f32x4*)(p + 4 * lane + 256 * j)); }
DI void ld_bf16_nt(const bf16_t* p, int lane, f32x4 (&v)[4]) {
#pragma unroll
    for (int j = 0; j < 4; ++j) { const u32x2 w = __builtin_nontemporal_load((const u32x2*)(p + 4 * lane + 256 * j)); v[j] = (f32x4){bf_lo(w.x), bf_hi(w.x), bf_lo(w.y), bf_hi(w.y)}; } }
DI void st_f32_nt(float* p, int lane, const f32x4 (&v)[4]) {
#pragma unroll
    for (int j = 0; j < 4; ++j) __builtin_nontemporal_store(v[j], (f32x4*)(p + 4 * lane + 256 * j)); }
DI void ld_fp8x64_nt(const unsigned char* p, int lane, f32x4 (&v)[4]) {
#pragma unroll
    for (int j = 0; j < 4; ++j) { const int w = (int)__builtin_nontemporal_load((const unsigned*)(p + 4 * lane + 256 * j));
        const auto lo = __builtin_amdgcn_cvt_pk_f32_fp8(w, false), hi = __builtin_amdgcn_cvt_pk_f32_fp8(w, true);
        v[j] = (f32x4){lo[0], lo[1], hi[0], hi[1]} * (1.f / 64.f); } }
DI void st_bf16_nt(bf16_t* p, int lane, const f32x4 (&v)[4]) {
#pragma unroll
    for (int j = 0; j < 4; ++j) { u32x2 w; w.x = cvtpk(v[j][0], v[j][1]); w.y = cvtpk(v[j][2], v[j][3]); __builtin_nontemporal_store(w, (u32x2*)(p + 4 * lane + 256 * j)); } }
DI void layer_norm_row(f32x4 (&v)[4], const float* g, const float* b, int lane) {
    float s = 0.f;
#pragma unroll
    for (int j = 0; j < 4; ++j) s += (v[j][0] + v[j][1]) + (v[j][2] + v[j][3]);
    const float mean = wave_sum(s) * (1.f / 1024.f); float s2 = 0.f;
#pragma unroll
    for (int j = 0; j < 4; ++j) { v[j] = v[j] - mean; s2 += (v[j][0] * v[j][0] + v[j][1] * v[j][1]) + (v[j][2] * v[j][2] + v[j][3] * v[j][3]); }
    const float rstd = 1.0f / sqrtf(wave_sum(s2) * (1.f / 1024.f) + 1e-5f);
    f32x4 gg[4], bb[4]; ld_f32(g, lane, gg); ld_f32(b, lane, bb);
#pragma unroll
    for (int j = 0; j < 4; ++j) v[j] = v[j] * rstd * gg[j] + bb[j];
}
DI void modulate_row(f32x4 (&h)[4], const f32x4 (&v)[4], const float* sc, const float* sh, int lane) {
    f32x4 a[4], b[4]; ld_f32(sc, lane, a); ld_f32(sh, lane, b);
#pragma unroll
    for (int j = 0; j < 4; ++j) h[j] = v[j] * (1.0f + a[j]) + b[j];
}

DI void conv_item(const float* W, int K, int Nsrc, bf16_t* WT, int Ndst, int kind, const float* gk, LAS float* scr, int item, int lane, bool f8 = false) {
    const int nblk = Ndst / 32, kb = item / nblk, nb = item % nblk, k0 = 64 * kb, n0 = 32 * nb;
    int srcb = n0; bool perm = false;
    if (kind == 1) { if (n0 < 512) srcb = 672 + n0; else if (n0 < 1024) srcb = 1184 + (n0 - 512); else if (n0 < 1536) srcb = 1696 + (n0 - 1024); else if (n0 < 1920) srcb = n0 - 1536;
                     else if (n0 < 2176) srcb = 384 + (n0 - 1920); else if (n0 == 2176) { srcb = 640; perm = true; } else srcb = -1; }
    else if (kind == 2) { if (n0 < 512) srcb = (n0 >> 6) * 96 + (n0 & 63); else { srcb = ((n0 - 512) >> 5) * 96 + 64; perm = true; } }
    else if (kind == 3) { if (n0 < 512) srcb = (n0 >> 6) * 128 + (n0 & 63); else srcb = ((n0 - 512) >> 6) * 128 + 64 + ((n0 - 512) & 63); }
    else if (kind == 4) { const int pn = n0 >> 8, w = n0 & 255; srcb = (w < 128) ? (128 * pn + w) : (512 + 128 * pn + (w - 128)); }
    const int nl = lane & 31; int sc = nl; if (perm) sc = (nl < 8) ? nl : (nl < 16 ? nl + 8 : (nl < 24 ? nl - 8 : nl));
    float vv[32];
#pragma unroll
    for (int i = 0; i < 32; ++i) { const int kk = 2 * i + (lane >> 5); vv[i] = (srcb >= 0) ? __builtin_nontemporal_load(W + (size_t)(k0 + kk) * Nsrc + srcb + sc) : 0.f; }
    if (gk) {
#pragma unroll
        for (int i = 0; i < 32; ++i) vv[i] *= gk[k0 + 2 * i + (lane >> 5)]; }
#pragma unroll
    for (int i = 0; i < 32; ++i) scr[(2 * i + (lane >> 5)) * 33 + nl] = vv[i];
    asm volatile("s_waitcnt lgkmcnt(0)" ::: "memory");
    const int c = lane & 7;
#pragma unroll
    for (int j = 0; j < 4; ++j) { const int n = (lane >> 3) + 8 * j; const LAS float* s = scr + (8 * c) * 33 + n;
        u32x4 o; o.x = cvtpk(s[0 * 33], s[1 * 33]); o.y = cvtpk(s[2 * 33], s[3 * 33]); o.z = cvtpk(s[4 * 33], s[5 * 33]); o.w = cvtpk(s[6 * 33], s[7 * 33]);
        if (f8) { u32x2 o8; o8.x = pg8::pk_fp8x4((f32x4){s[0 * 33], s[1 * 33], s[2 * 33], s[3 * 33]} * 64.f); o8.y = pg8::pk_fp8x4((f32x4){s[4 * 33], s[5 * 33], s[6 * 33], s[7 * 33]} * 64.f);
            *(u32x2*)((unsigned char*)WT + (size_t)(n0 + n) * K + k0 + 8 * c) = o8; }
        else __builtin_nontemporal_store(o, (u32x4*)(WT + (size_t)(n0 + n) * K + k0 + 8 * c)); }
    asm volatile("s_waitcnt lgkmcnt(0)" ::: "memory");
}

DI void phase_prologue(const Ctx& F) {
    LAS float* sl = (LAS float*)F.lds;
    LAS float* red = sl + 3072;
    for (int u = blockIdx.x; u < 193; u += F.G) {
        if (u < 192) {
            const int l = u / 96, n0 = (u % 96) * 64;
            for (int idx = F.tid; idx < 3072; idx += 512) { const int which = idx >> 10, k = idx & 1023; const float v = which < 2 ? F.inp[1][which * 1024 + k] : F.inp[3][k]; sl[idx] = v * fast_rcp(1.f + fast_exp2(-v * LOG2E)); }
            __syncthreads();
            float a0 = 0.f, a1 = 0.f, a2 = 0.f; const float* wp = F.inp[4] + ((size_t)l * 1024 + F.wave * 128) * 6144 + n0 + F.lane;
#pragma unroll 32
            for (int k = 0; k < 128; ++k) { const float w = __builtin_nontemporal_load(wp + (size_t)k * 6144);     const int kk = F.wave * 128 + k; a0 += sl[kk] * w; a1 += sl[1024 + kk] * w; a2 += sl[2048 + kk] * w; }
            red[(F.wave * 3 + 0) * 64 + F.lane] = a0; red[(F.wave * 3 + 1) * 64 + F.lane] = a1; red[(F.wave * 3 + 2) * 64 + F.lane] = a2;
            __syncthreads();
            if (F.wave < 3) { float s = F.inp[5][l * 6144 + n0 + F.lane];
#pragma unroll
                for (int w = 0; w < 8; ++w) s += red[(w * 3 + F.wave) * 64 + F.lane];
                ((float*)(F.ws + WS_MOD))[(size_t)(l * 3 + F.wave) * 6144 + n0 + F.lane] = s; }
            __syncthreads();
        } else {
            float* r64c = (float*)(F.ws + WS_ROPE); float* r64s = r64c + 4096; float* r32c = r64s + 4096; float* r32s = r32c + 2048;
            for (int idx = F.tid; idx < 4096 + 2048; idx += 512) {
                const bool big = idx < 4096; const int id = big ? idx : idx - 4096; const int pos = big ? (id >> 4) : (id >> 3), i = big ? (id & 15) : (id & 7);
                const float inv = exp2f(-(float)i * (big ? (13.287712379549449f / 16.f) : (13.287712379549449f / 8.f)));
                const float ang = (float)pos * inv;
                const float kq = rintf(ang * 0.15915494309189535f);
                float r = fmaf(-kq, 6.2831854820251465f, ang); r = fmaf(-kq, -1.7484555314695172e-07f, r);
                const float cs = __cosf(r), sn = __sinf(r);
                if (big) { r64c[id] = cs; r64s[id] = sn; } else { r32c[id] = cs; r32s[id] = sn; }
            }
        }
    }
    __syncthreads();
    LAS float* scr = (LAS float*)(F.lds + F.wave * 8448);
    const int gw = F.vcu * 8 + F.wave, NGW = F.G * 8;
    constexpr int I_IN = 16 * 72, I_SQ = 16 * 32, I_UQ = 6 * 24, I_UKV = 4 * 32;
    constexpr int NITEMS = 2 * I_IN + 2 * I_SQ + I_UQ + I_UKV;
    for (int it = gw; it < NITEMS; it += NGW) {
        int r = it;
        if (r < I_IN) { conv_item(F.inp[8], 1024, 2304, (bf16_t*)(F.ws + WS_WAB_IN), 2304, 0, nullptr, scr, r, F.lane, true); continue; } r -= I_IN;
        if (r < I_IN) { conv_item(F.inp[12], 1024, 2208, (bf16_t*)(F.ws + WS_WCD_IN), 2304, 1, nullptr, scr, r, F.lane, true); continue; } r -= I_IN;
        if (r < I_SQ) { conv_item(F.inp[11], 1024, 1024, (bf16_t*)(F.ws + WS_WAB_OUT), 1024, 0, nullptr, scr, r, F.lane, true); continue; } r -= I_SQ;
        if (r < I_SQ) { conv_item(F.inp[19], 1024, 1024, (bf16_t*)(F.ws + WS_WCD_OUT), 1024, 0, nullptr, scr, r, F.lane, true); continue; } r -= I_SQ;
        if (r < I_UQ) { conv_item(F.inp[14], 384, 768, (bf16_t*)(F.ws + WS_WUQ), 768, 2, F.inp[13], scr, r, F.lane); continue; } r -= I_UQ;
        conv_item(F.inp[16], 256, 1024, (bf16_t*)(F.ws + WS_WUKV), 1024, 3, F.inp[15], scr, r, F.lane);
    }
}

DI void conv_moe_slice(const Ctx& F, int l, int step) {
    constexpr int I_GU = 16 * 32, I_DN = 8 * 32, PER_L = 32 * I_GU + 32 * I_DN;
    LAS float* scr = (LAS float*)(F.lds + F.wave * 8448);
    const int per_wg = (PER_L + F.G - 1) / F.G, per_step = (per_wg + 7) / 8;
    const int lo = (int)blockIdx.x * per_wg + step * per_step;
    int hi = lo + per_step; const int wg_hi = ((int)blockIdx.x + 1) * per_wg; hi = hi < wg_hi ? hi : wg_hi; hi = hi < PER_L ? hi : PER_L;
    for (int r = lo + F.wave; r < hi; r += 8) {
        if (r < 32 * I_GU) { const int mtx = l * 32 + r / I_GU; conv_item(F.inp[24] + (size_t)mtx * 1024 * 1024, 1024, 1024, (bf16_t*)(F.ws + WS_WGU + (size_t)mtx * 1024 * 1024), 1024, 4, nullptr, scr, r % I_GU, F.lane, true); }
        else { const int r2 = r - 32 * I_GU; const int mtx = l * 32 + r2 / I_DN; conv_item(F.inp[25] + (size_t)mtx * 512 * 1024, 512, 1024, (bf16_t*)(F.ws + WS_WDN + (size_t)mtx * 1024 * 512), 1024, 0, nullptr, scr, r2 % I_DN, F.lane, true); }
    }
}

DI const float* src_row_l0(const Ctx& F, int urow, int& which) {
    const int b = urow / RB, rr = urow - b * RB;
    if (rr < CTXL) { which = 2; return F.inp[2] + ((size_t)b * CTXL + rr) * 1024; }
    which = b; return F.inp[0] + ((size_t)b * SEQ + (rr - CTXL)) * 1024;
}

DI void phase_modulate0(const Ctx& F) {
    bf16_t* H = (bf16_t*)(F.ws + WS_H);
    for (int urow = F.vcu * 8 + F.wave; urow < MU; urow += F.G * 8) {
        int which; const float* src = src_row_l0(F, urow, which);
        f32x4 v[4], h[4]; ld_f32_nt(src, F.lane, v);
        modulate_row(h, v, modp(F, 0, which, 1), modp(F, 0, which, 0), F.lane);
        st_fp8row((unsigned char*)H + (size_t)urow * 1024, F.lane, h);
    }
}

constexpr int PASS_ROWS = 136;
template <int CTRL> DI float dpp_ror_add(float v) { return v + __builtin_bit_cast(float, __builtin_amdgcn_update_dpp(0, __builtin_bit_cast(int, v), CTRL, 0xf, 0xf, false)); }
DI float reduce4(float a, float b, float c, float d) {
    auto r1 = __builtin_amdgcn_permlane32_swap(__float_as_uint(a), __float_as_uint(b), false, false);
    auto r2 = __builtin_amdgcn_permlane32_swap(__float_as_uint(c), __float_as_uint(d), false, false);
    const float z1 = __uint_as_float(r1[0]) + __uint_as_float(r1[1]);
    const float z2 = __uint_as_float(r2[0]) + __uint_as_float(r2[1]);
    auto r3 = __builtin_amdgcn_permlane16_swap(__float_as_uint(z1), __float_as_uint(z2), false, false);
    float w = __uint_as_float(r3[0]) + __uint_as_float(r3[1]);
    w = dpp_ror_add<0x128>(w); w = dpp_ror_add<0x124>(w); w = dpp_ror_add<0x122>(w); w = dpp_ror_add<0x121>(w);
    return w;
}
DI void phase_ln1_router(const Ctx& F, const int l) {
    constexpr int RG = 2;
    constexpr int WRS = 1028;
    LAS float* Wr = (LAS float*)F.lds;
    LAS unsigned* rinfo = (LAS unsigned*)(F.lds + 148480);
    LAS int* lcnt = (LAS int*)(F.lds + 148480 + PASS_ROWS * 32);
    LAS int* lbase = lcnt + 32;
    LAS float* lgs = (LAS float*)(F.lds + 148480 + PASS_ROWS * 32 + 256) + F.wave * (RG * 36);
    const float* wg = F.inp[20] + (size_t)l * 4096; const float* we = F.inp[22] + (size_t)l * 32768;
    for (int idx = F.tid; idx < 4096; idx += 512) Wr[(idx & 3) * WRS + (idx >> 2)] = wg[idx];
    for (int idx = F.tid; idx < 32768; idx += 512) Wr[(4 + (idx & 31)) * WRS + (idx >> 5)] = we[idx];
    if (F.tid < 32) lcnt[F.tid] = 0;
    __syncthreads();
    const int nrows = (l == 0) ? MU : NB * SEQ;
    const int rpw = (nrows + F.G - 1) / F.G, r_begin = (int)blockIdx.x * rpw, r_end = (r_begin + rpw < nrows) ? r_begin + rpw : nrows;
    const bf16_t* YP = (const bf16_t*)(F.ws + WS_YP); bf16_t* XA = (bf16_t*)(F.ws + WS_XA); const bf16_t* XB = (const bf16_t*)(F.ws + WS_XB); bf16_t* H = (bf16_t*)(F.ws + WS_H);
    int* list = (int*)(F.ws + WS_LIST); unsigned* tokinfo = (unsigned*)(F.ws + WS_TOKINFO); unsigned* gcnt = (unsigned*)(F.ctl + CW_CNT + l * 32);
    const float* lng = F.inp[6] + (size_t)(l * 2 + 0) * 1024; const float* lnb = F.inp[7] + (size_t)(l * 2 + 0) * 1024;
    const float* bgp = F.inp[21] + l * 4; const float* bep = F.inp[23] + l * 32;
    for (int pb = r_begin; pb < r_end; pb += PASS_ROWS) {
        const int npass = (r_end - pb < PASS_ROWS) ? (r_end - pb) : PASS_ROWS;
        for (int g4 = F.wave; RG * g4 < npass; g4 += 8) {
            f32x4 hm[RG][4]; int urows[RG];
#pragma unroll
            for (int r = 0; r < RG; ++r) {
                const int lr = RG * g4 + r;
                if (lr < npass) {
                    const int j = pb + lr; int urow, which; const float* src = nullptr;
                    if (l == 0) { urow = j; src = src_row_l0(F, urow, which); }
                    else { const int b = j >> 14; urow = b * RB + CTXL + (j & 16383); which = b; }
                    urows[r] = urow;
                    f32x4 v[4], y[4], g1[4]; if (l == 0) ld_f32_nt(src, F.lane, v); else ld_bf16_nt(XB + (size_t)urow * 1024, F.lane, v); ld_bf16_nt(YP + (size_t)urow * 1024, F.lane, y); ld_f32(modp(F, l, which, 2), F.lane, g1);
#pragma unroll
                    for (int jj = 0; jj < 4; ++jj) v[jj] = v[jj] * DN_ALPHA + g1[jj] * y[jj];
                    layer_norm_row(v, lng, lnb, F.lane);
                    st_bf16_nt(XA + (size_t)urow * 1024, F.lane, v);
                    modulate_row(hm[r], v, modp(F, l, which, 4), modp(F, l, which, 3), F.lane);
                    st_fp8row((unsigned char*)H + (size_t)urow * 1024, F.lane, hm[r]);
                } else { urows[r] = 0;
#pragma unroll
                    for (int jj = 0; jj < 4; ++jj) hm[r][jj] = (f32x4){0.f, 0.f, 0.f, 0.f}; }
            }
#pragma unroll 3
            for (int c4 = 0; c4 < 9; ++c4) {
                float pr[RG][4];
#pragma unroll
                for (int cc = 0; cc < 4; ++cc) {
                    f32x4 w[4];
#pragma unroll
                    for (int jj = 0; jj < 4; ++jj) w[jj] = *(const LAS f32x4*)(Wr + (c4 * 4 + cc) * WRS + 256 * jj + 4 * F.lane);
#pragma unroll
                    for (int r = 0; r < RG; ++r) { f32x2 a2 = (f32x2){0.f, 0.f};
#pragma unroll
                        for (int jj = 0; jj < 4; ++jj) { a2 += (f32x2){hm[r][jj][0], hm[r][jj][1]} * (f32x2){w[jj][0], w[jj][1]}; a2 += (f32x2){hm[r][jj][2], hm[r][jj][3]} * (f32x2){w[jj][2], w[jj][3]}; }
                        pr[r][cc] = a2[0] + a2[1]; }
                }
#pragma unroll
                for (int r = 0; r < RG; ++r) {
                    const float wv = reduce4(pr[r][0], pr[r][1], pr[r][2], pr[r][3]);
                    const int q = F.lane >> 4; const int cmap = (q == 1) ? 2 : (q == 2 ? 1 : q);
                    if ((F.lane & 15) == 0) lgs[r * 36 + c4 * 4 + cmap] = wv;
                }
            }
            asm volatile("s_waitcnt lgkmcnt(0)" ::: "memory");
            if (F.lane < RG && RG * g4 + F.lane < npass) {
                const int r = F.lane, lr = RG * g4 + r; const LAS float* lg = lgs + r * 36;
                float gv[4];
#pragma unroll
                for (int i = 0; i < 4; ++i) gv[i] = lg[i] + bgp[i];
                int gi = 0; float gm = gv[0];
#pragma unroll
                for (int i = 1; i < 4; ++i) if (gv[i] > gm) { gm = gv[i]; gi = i; }
                float gs = 0.f;
#pragma unroll
                for (int i = 0; i < 4; ++i) gs += fast_exp2((gv[i] - gm) * LOG2E);
                const float gval = 1.0f / gs;
                float ev[8];
#pragma unroll
                for (int i = 0; i < 8; ++i) ev[i] = lg[4 + 8 * gi + i] + bep[8 * gi + i];
                int i1 = 0; float m1 = ev[0];
#pragma unroll
                for (int i = 1; i < 8; ++i) if (ev[i] > m1) { m1 = ev[i]; i1 = i; }
                int i2 = -1; float m2 = -INFINITY;
#pragma unroll
                for (int i = 0; i < 8; ++i) if (i != i1 && ev[i] > m2) { m2 = ev[i]; i2 = i; }
                const float tt = fast_exp2((m2 - m1) * LOG2E); const float w0 = gval / (1.f + tt), w1 = gval * tt / (1.f + tt);
                const int E0 = gi * 8 + i1, E1 = gi * 8 + i2;
                const int ls0 = __hip_atomic_fetch_add(lcnt + E0, 1, __ATOMIC_RELAXED, __HIP_MEMORY_SCOPE_WORKGROUP);
                const int ls1 = __hip_atomic_fetch_add(lcnt + E1, 1, __ATOMIC_RELAXED, __HIP_MEMORY_SCOPE_WORKGROUP);
                LAS unsigned* ri = rinfo + lr * 8;
                ri[0] = (unsigned)E0; ri[1] = (unsigned)ls0; ri[2] = __float_as_uint(w0); ri[3] = (unsigned)E1; ri[4] = (unsigned)ls1; ri[5] = __float_as_uint(w1);
                ri[6] = (unsigned)(r == 0 ? urows[0] : urows[RG - 1]);
            }
            asm volatile("s_waitcnt lgkmcnt(0)" ::: "memory");
        }
        __syncthreads();
        if (F.tid < 32) { const int n = lcnt[F.tid]; lbase[F.tid] = n > 0 ? (int)__hip_atomic_fetch_add(gcnt + F.tid, (unsigned)n, __ATOMIC_RELAXED, __HIP_MEMORY_SCOPE_AGENT) : 0; }
        __syncthreads();
        for (int lr = F.tid; lr < npass; lr += 512) {
            const LAS unsigned* ri = rinfo + lr * 8;
            const int E0 = (int)ri[0], E1 = (int)ri[3]; const int s0 = lbase[E0] + (int)ri[1], s1 = lbase[E1] + (int)ri[4]; const int urow = (int)ri[6];
            list[(size_t)E0 * LIST_CAP + s0] = urow; list[(size_t)E1 * LIST_CAP + s1] = urow;
            u32x4 a; a.x = (unsigned)E0; a.y = (unsigned)s0; a.z = ri[2]; a.w = (unsigned)E1; u32x4 b; b.x = (unsigned)s1; b.y = ri[5]; b.z = 0u; b.w = 0u;
            *(u32x4*)(tokinfo + (size_t)urow * 8) = a; *(u32x4*)(tokinfo + (size_t)urow * 8 + 4) = b;
        }
        __syncthreads();
        if (F.tid < 32) lcnt[F.tid] = 0;
        __syncthreads();
    }
}

DI void moe_tables(const Ctx& F, int l) {
    LAS int* tb = (LAS int*)(F.lds + LDS_AUX);
    if (F.tid < 32) tb[64 + F.tid] = (int)__hip_atomic_load(F.ctl + CW_CNT + l * 32 + F.tid, RLX_AGENT);
    __syncthreads();
    if (F.tid == 0) { int a = 0; for (int e = 0; e < 32; ++e) { tb[e] = a; a += (tb[64 + e] + 255) >> 8; } tb[32] = a; }
    __syncthreads();
}
struct MoeOrder {
    const LAS int* tb; int G, c; const char* A; const char* W; size_t wstride, tstepB, tstepA; const int* list; unsigned lda2; bool gatherA;
    DI bool next(int i, pg8::Unit& u) const {
        const int ntot = tb[32]; const long L = (long)i * G + c; if (L >= (long)ntot * 4) return false;
        const int rt = (int)(L >> 2), pn = (int)(L & 3); int e = 0;
        for (int j = 1; j < 32; ++j) e += (tb[j] <= rt) ? 1 : 0;
        e = __builtin_amdgcn_readfirstlane(e);
        u.pm = rt; u.pn = pn; u.aux0 = e; u.aux1 = __builtin_amdgcn_readfirstlane((rt - tb[e]) * 256);
        u.A = gatherA ? A : A + (size_t)rt * tstepA; u.B = W + (size_t)e * wstride + (size_t)pn * tstepB; return true;
    }
    DI unsigned gather(const pg8::Unit& u, int r) const {
        const int slot = u.aux1 + r, n = tb[64 + u.aux0];
        const int tok = list[(size_t)u.aux0 * LIST_CAP + (slot < n ? slot : 0)];
        return (unsigned)tok * lda2;
    }
};

DI void phase_ln2(const Ctx& F, const int l) {
    moe_tables(F, l);
    const LAS int* tb = (const LAS int*)(F.lds + LDS_AUX);
    const bf16_t* YS = (const bf16_t*)(F.ws + WS_YS); const bf16_t* XA = (const bf16_t*)(F.ws + WS_XA); bf16_t* XB = (bf16_t*)(F.ws + WS_XB); bf16_t* H = (bf16_t*)(F.ws + WS_H);
    const unsigned* tokinfo = (const unsigned*)(F.ws + WS_TOKINFO);
    const float* lng = F.inp[6] + (size_t)(l * 2 + 1) * 1024; const float* lnb = F.inp[7] + (size_t)(l * 2 + 1) * 1024;
    const int nrows = (l == 0) ? MU : NB * SEQ;
    const int stride = F.G * 8;
    for (int j0 = F.vcu * 8 + F.wave; j0 < nrows; j0 += 2 * stride) {
        int urow[2], which[2], bb[2], ss[2]; bool ok[2]; u32x4 ia[2]; u32x2 ib[2]; f32x4 v[2][4], ya[2][4], yb[2][4];
#pragma unroll
        for (int r = 0; r < 2; ++r) { const int j = j0 + r * stride; ok[r] = j < nrows; const int jj = ok[r] ? j : j0;
            if (l == 0) { urow[r] = jj; bb[r] = jj / RB; which[r] = (jj - bb[r] * RB) < CTXL ? 2 : bb[r]; ss[r] = 0; }
            else { bb[r] = jj >> 14; ss[r] = jj & 16383; urow[r] = bb[r] * RB + CTXL + ss[r]; which[r] = bb[r]; }
            ia[r] = *(const u32x4*)(tokinfo + (size_t)urow[r] * 8); ib[r] = *(const u32x2*)(tokinfo + (size_t)urow[r] * 8 + 4);
            ld_bf16_nt(XA + (size_t)urow[r] * 1024, F.lane, v[r]); }
#pragma unroll
        for (int r = 0; r < 2; ++r) { const int p0 = tb[ia[r].x] * 256 + (int)ia[r].y, p1 = tb[ia[r].w] * 256 + (int)ib[r].x;
            ld_fp8x64_nt((const unsigned char*)YS + (size_t)p0 * 1024, F.lane, ya[r]); ld_fp8x64_nt((const unsigned char*)YS + (size_t)p1 * 1024, F.lane, yb[r]); }
#pragma unroll
        for (int r = 0; r < 2; ++r) {
            if (!ok[r]) continue;
            const float w0 = __uint_as_float(ia[r].z), w1 = __uint_as_float(ib[r].y);
            f32x4 g2[4]; ld_f32(modp(F, l, which[r], 5), F.lane, g2);
#pragma unroll
            for (int jj = 0; jj < 4; ++jj) v[r][jj] = v[r][jj] * DN_ALPHA + g2[jj] * (ya[r][jj] * w0 + yb[r][jj] * w1);
            layer_norm_row(v[r], lng, lnb, F.lane);
            if (l == 0) {
                st_bf16_nt(XB + (size_t)urow[r] * 1024, F.lane, v[r]);
                f32x4 h[4]; modulate_row(h, v[r], modp(F, 1, which[r], 1), modp(F, 1, which[r], 0), F.lane);
                st_fp8row((unsigned char*)H + (size_t)urow[r] * 1024, F.lane, h);
            } else st_f32_nt(F.out + ((size_t)bb[r] * SEQ + ss[r]) * 1024, F.lane, v[r]);
        }
    }
}

template <class Sched> DI void rms_tables(const Ctx& F, const Sched& S, const bf16_t* base, int col0, int ncols, LAS float* rs) {
    pg8::Unit u;
    for (int i = 0; i < 16 && S.next(i, u); ++i) {
        const int r = F.tid >> 1, hsel = F.tid & 1; const int half = ncols / 2;
        const bf16_t* p = base + (size_t)(u.pm * 256 + r) * NQKV + col0 + hsel * half; float ss = 0.f;
        for (int k = 0; k < half; k += 8) { const u32x4 w = *(const u32x4*)(p + k);
            ss += bf_lo(w.x) * bf_lo(w.x) + bf_hi(w.x) * bf_hi(w.x) + bf_lo(w.y) * bf_lo(w.y) + bf_hi(w.y) * bf_hi(w.y) + bf_lo(w.z) * bf_lo(w.z) + bf_hi(w.z) * bf_hi(w.z) + bf_lo(w.w) * bf_lo(w.w) + bf_hi(w.w) * bf_hi(w.w); }
        ss += __shfl_xor(ss, 1);
        if (hsel == 0) rs[i * 256 + r] = 1.0f / sqrtf(ss / (float)ncols + 1e-6f);
    }
    __syncthreads();
}

#ifndef MK_PER_PHASE
#define MK_PER_PHASE 0
#endif
constexpr int N_PHASES = 17;
struct Args { const float* in[26]; float* out; unsigned char* ws; int ph_lo, ph_hi; };

__global__ void __launch_bounds__(512, 2) mk_fwd(Args args) {
    extern __shared__ __attribute__((aligned(16))) unsigned char lds_raw[];
    Ctx F;
    F.lds = (LAS unsigned char*)lds_raw; F.ws = args.ws; F.ctl = (gu32*)(args.ws + WS_CTL);
    F.tid = threadIdx.x; F.lane = F.tid & 63; F.wave = __builtin_amdgcn_readfirstlane(F.tid >> 6);
    F.G = gridDim.x; { const int bx = blockIdx.x; F.vcu = (F.G % 8 == 0) ? (bx % 8) * (F.G / 8) + bx / 8 : bx; }
    F.inp = (const float* const __attribute__((address_space(4)))*)__builtin_amdgcn_kernarg_segment_ptr();
    F.out = args.out;
    volatile LAS unsigned* MISC = (volatile LAS unsigned*)(F.lds + LDS_MISC);
    if (F.tid < 16) MISC[F.tid] = 0u;
    __syncthreads();
    XcdBarrier bar; bar.bar = (unsigned*)(F.ctl + CW_BAR); bar.x = 0; bar.st = nullptr;
    if (!MK_PER_PHASE) bar = xcd_barrier_post((unsigned*)(F.ctl + CW_BAR), MISC);
    const int lo = args.ph_lo, hi = args.ph_hi;
#define IN(k) (lo <= (k) && (k) < hi)
#define SEAM(k) do { if (IN(k) && IN((k) + 1)) xcd_barrier(bar); } while (0)
#define H ((bf16_t*)(F.ws + WS_H))
#define AO ((bf16_t*)(F.ws + WS_AO))
#define QKV ((bf16_t*)(F.ws + WS_QKV))
#define YP ((bf16_t*)(F.ws + WS_YP))
#define ACT ((bf16_t*)(F.ws + WS_ACT))
#define YS ((bf16_t*)(F.ws + WS_YS))
#define QM ((bf16_t*)(F.ws + WS_QM))
#define KVM ((bf16_t*)(F.ws + WS_KVM))
#define r32c ((const float*)(F.ws + WS_ROPE) + 8192)
#define r32s ((const float*)(F.ws + WS_ROPE) + 8192 + 2048)
    LAS unsigned char* ring = F.lds;

    if (IN(0)) { phase_prologue(F); } SEAM(0);
    if (IN(1)) { phase_modulate0(F); } SEAM(1);

    if (IN(2)) {
        pg8::DenseOrder S; S.init(130, 9, F.G, (int)blockIdx.x, false, H, 512, F.ws + WS_WAB_IN, 512);
        pg8::EpiInProj<0> E{F.ws};
        pg8::gemm_phase<pg8::EpiInProj<0>, pg8::DenseOrder, false, true>(ring, 512, 512, S, E);
    } SEAM(2);
    if (IN(3)) {
        LAS float* rpbL = (LAS float*)(F.lds + LDS_AUX); int nconv = 0;
        for (int i = 0;; ++i) {
            const int L = i * F.G + F.vcu; if (L >= 2048 + 32) break;
            att::P p; p.opitch = 1024; p.qpitch = 512; p.k8r = nullptr; p.lam = 0.f; p.subln = nullptr; p.sink2 = 0.f; p.t_lo = 4; p.s0 = 0;
            int b, head, mixer; size_t qr0;
            if (L >= 2048) { const int Lc = L - 2048, j = Lc & 15; mixer = Lc >> 4; b = j >> 3; head = j & 7; p.kind = 2 + mixer; p.nt = 4; qr0 = (size_t)(b * RB); }
            else { const int j = L & 1023; mixer = L >> 10; const int qb = j & 63; head = (j >> 6) & 7; b = j >> 9; p.kind = mixer; p.s0 = qb * 256; qr0 = (size_t)(b * RB + CTXL + p.s0);
                int tlo, thi;
                if (mixer == 0) { tlo = p.s0 / 64 - 2; thi = p.s0 / 64 + 5; tlo = tlo < 0 ? 0 : tlo; thi = thi > 255 ? 255 : thi; }
                else { const int R0 = p.s0 >> 6; tlo = R0 - 4; tlo = tlo < 0 ? 0 : (tlo > 248 ? 248 : tlo); thi = R0 - 1; thi = thi < 0 ? 0 : (thi > 248 ? 248 : thi); thi += 7; }
                p.t_lo = 4 + tlo; p.nt = 4 + (thi - tlo + 1); }
            p.o = (unsigned char*)AO + qr0 * 1024;
            if (mixer == 0) { p.o += head * 64; p.sink2 = F.inp[9][head] * LOG2E;
                p.k8 = F.ws + WS_K8A + (size_t)(b * 2 + (head >> 2)) * 260 * 4096; p.v8 = F.ws + WS_VT8A + (size_t)(b * 2 + (head >> 2)) * 260 * 4096; p.q8 = F.ws + WS_Q8A + qr0 * 512 + head * 64; }
            else { p.o += 512 + head * 64;
                p.k8 = F.ws + WS_K8B + (size_t)(b * 8 + head) * 260 * 4096; p.v8 = F.ws + WS_VT8B + (size_t)(b * 8 + head) * 260 * 4096; p.q8 = F.ws + WS_Q8B + qr0 * 512 + head * 64;
                if (p.kind == 1) for (int idx = F.tid; idx < 465; idx += 512) rpbL[idx] = F.inp[10][head * 465 + idx] * LOG2E; }
            p.nt += (p.nt & 1);
            att::attn_unit_f8l0(p, ring, rpbL);
            if (i < 8) { conv_moe_slice(F, 0, i); __syncthreads(); }
            nconv = i + 1;
        }
        for (int s = nconv; s < 8; ++s) { conv_moe_slice(F, 0, s); __syncthreads(); }
    } SEAM(3);

#define LAYER_TAIL(l) do {\
        const int pb = (l == 0) ? 4 : 12;\
        if (IN(pb)) {\
            pg8::DenseOrder S; S.init(l == 0 ? 130 : 128, 4, F.G, (int)blockIdx.x, l == 1, AO, 512, F.ws + (l == 0 ? WS_WAB_OUT : WS_WCD_OUT), 512);\
            pg8::EpiPlain E{YP, 1024};\
            pg8::gemm_phase<pg8::EpiPlain, pg8::DenseOrder, false, true>(ring, 512, 512, S, E, 0x7a7a7a7a);    \
        } SEAM(pb);\
        if (IN(pb + 1)) { phase_ln1_router(F, l); } SEAM(pb + 1);\
        if (IN(pb + 2)) {\
            moe_tables(F, l);\
            MoeOrder S{(const LAS int*)(F.lds + LDS_AUX), F.G, (int)blockIdx.x, (const char*)H, (const char*)(F.ws + WS_WGU) + (size_t)l * 32 * 1024 * 1024, (size_t)1024 * 1024, (size_t)256 * 1024, 0,\
                       (const int*)(F.ws + WS_LIST), 1024u, true};\
            pg8::EpiGU E{(unsigned char*)ACT};\
            pg8::gemm_phase<pg8::EpiGU, MoeOrder, true, true>(ring, 512, 512, S, E);                     \
        } SEAM(pb + 2);\
        if (IN(pb + 3)) {\
            moe_tables(F, l);\
            MoeOrder S{(const LAS int*)(F.lds + LDS_AUX), F.G, (int)blockIdx.x, (const char*)ACT, (const char*)(F.ws + WS_WDN) + (size_t)l * 32 * 1024 * 512, (size_t)1024 * 512, (size_t)256 * 512, (size_t)256 * 512,\
                       (const int*)(F.ws + WS_LIST), 0u, false};\
            pg8::EpiPlain8 E{(unsigned char*)YS, 1024};\
            pg8::gemm_phase<pg8::EpiPlain8, MoeOrder, false, true>(ring, 256, 256, S, E);                \
        } SEAM(pb + 3);\
        if (IN(pb + 4)) { phase_ln2(F, l); }\
    } while (0)
    LAYER_TAIL(0); SEAM(8);

    if (IN(9)) {
        pg8::DenseOrder S; S.init(130, 9, F.G, (int)blockIdx.x, false, H, 512, F.ws + WS_WCD_IN, 512);
        pg8::EpiInProj<1> E{F.ws};
        pg8::gemm_phase<pg8::EpiInProj<1>, pg8::DenseOrder, false, true>(ring, 512, 512, S, E);
    } SEAM(9);
    if (IN(10)) {
        LAS float* rsq = (LAS float*)(F.lds + LDS_AUX); LAS float* rskv = rsq + 1024;
        pg8::DenseOrder Sq; Sq.init(128, 3, F.G, (int)blockIdx.x, true, QKV + 1536, NQKV, F.ws + WS_WUQ, 384);
        pg8::DenseOrder Skv; Skv.init(130, 4, F.G, (int)blockIdx.x, false, QKV + 1920, NQKV, F.ws + WS_WUKV, 256);
        rms_tables(F, Sq, QKV, 1536, 384, rsq);
        rms_tables(F, Skv, QKV, 1920, 256, rskv);
        pg8::EpiUQ Eq{F.ws + WS_Q8M, rsq, r32c, r32s};
        pg8::gemm_phase<pg8::EpiUQ, pg8::DenseOrder, false>(ring, NQKV, 384, Sq, Eq);
        pg8::EpiUKV Ekv{F.ws + WS_K8M, rskv, F.ws + WS_VT8M};
        pg8::gemm_phase<pg8::EpiUKV, pg8::DenseOrder, false>(ring, NQKV, 256, Skv, Ekv);
    } SEAM(10);
    if (IN(11)) {
        float lam; { const float* lp = F.inp[17]; float s01 = 0.f, s23 = 0.f; for (int i = 0; i < 64; ++i) { s01 += lp[i] * lp[64 + i]; s23 += lp[128 + i] * lp[192 + i]; }
            lam = fast_exp2(s01 * LOG2E) - fast_exp2(s23 * LOG2E) + LAM_INIT; }
        int nconv = 0;
        for (int i = 0;; ++i) {
            const int L = i * F.G + F.vcu; if (L >= 2048) break;
            att::P p; p.kind = 0; p.t_lo = 0; p.s0 = 0; p.sink2 = 0.f; p.nt = RB / 64; p.opitch = 1024; p.lam = lam; p.subln = F.inp[18];
            if (L < 1024) { const int qb = L & 63, head = (L >> 6) & 7, b = L >> 9; const size_t qrow0 = (size_t)(b * RB + CTXL + qb * 256);
                p.o = (unsigned char*)AO + qrow0 * 1024 + head * 64; p.v8 = F.ws + WS_VT8M + (size_t)(b * 8 + head) * 260 * 4096; p.k8 = F.ws + WS_K8M + (size_t)(b * 8 + head) * 260 * 4096; p.k8r = F.ws + WS_K8R + (size_t)b * 260 * 2048;
                p.q8 = F.ws + WS_Q8M + qrow0 * 768 + head * 96; p.qpitch = 768;
                att::attn_unit_f8q<1>(p, ring);
            } else { const int j = L - 1024; const int qb = j & 127, head = (j >> 7) & 3, b = j >> 9; const size_t qrow0 = (size_t)(b * RB + CTXL + qb * 128);
                p.o = (unsigned char*)AO + qrow0 * 1024 + 512 + head * 128; p.v8 = F.ws + WS_VT8D + (size_t)(b * 4 + head) * 260 * 8192; p.k8 = F.ws + WS_K8D + (size_t)(b * 4 + head) * 260 * 8192; p.k8r = nullptr;
                p.q8 = F.ws + WS_Q8D + qrow0 * 512 + head * 128; p.qpitch = 512;
                att::attn_unit_f8q<2>(p, ring);
            }
            if (i < 8) { conv_moe_slice(F, 1, i); __syncthreads(); }
            nconv = i + 1;
        }
        for (int s = nconv; s < 8; ++s) { conv_moe_slice(F, 1, s); __syncthreads(); }
    } SEAM(11);

    LAYER_TAIL(1);
#undef LAYER_TAIL
#undef IN
#undef SEAM
#undef H
#undef AO
#undef QKV
#undef YP
#undef ACT
#undef YS
#undef QM
#undef KVM
#undef r32c
#undef r32s
}

extern "C" void kernel_launch(void* const* d_in, const int* in_sizes, int n_in, void* d_out, int out_size, void* d_ws, size_t ws_size, hipStream_t stream) {
    static int grid = 0;
    if (grid == 0) {
        if (n_in != 26 || out_size != NB * SEQ * DM || ws_size < WS_END) { fprintf(stderr, "kernel_launch: unexpected shapes (n_in %d, out %d, ws %zu < %zu)\n", n_in, out_size, ws_size, (size_t)WS_END); grid = -1; return; }
        int dev = 0, cus = 0, per_cu = 0;
        if (hipGetDevice(&dev) != hipSuccess || hipDeviceGetAttribute(&cus, hipDeviceAttributeMultiprocessorCount, dev) != hipSuccess) { grid = -1; return; }
        if (hipFuncSetAttribute((const void*)mk_fwd, hipFuncAttributeMaxDynamicSharedMemorySize, LDS_BYTES) != hipSuccess) { fprintf(stderr, "kernel_launch: hipFuncSetAttribute failed\n"); grid = -1; return; }
        if (hipOccupancyMaxActiveBlocksPerMultiprocessor(&per_cu, (const void*)mk_fwd, 512, LDS_BYTES) != hipSuccess || per_cu < 1) fprintf(stderr, "kernel_launch: occupancy query says %d\n", per_cu);
        (void)hipGetLastError();
        grid = cus;
    }
    if (grid < 0) return;
    (void)hipMemsetAsync((char*)d_ws + WS_CTL, 0, CTL_ZERO_BYTES, stream);
    Args a{};
    for (int i = 0; i < 26; ++i) a.in[i] = (const float*)d_in[i];
    a.out = (float*)d_out; a.ws = (unsigned char*)d_ws;
#if MK_PER_PHASE
    for (int ph = 0; ph < N_PHASES; ++ph) { a.ph_lo = ph; a.ph_hi = ph + 1; hipLaunchKernelGGL(mk_fwd, dim3(grid), dim3(512), LDS_BYTES, stream, a); }
#else
    a.ph_lo = 0; a.ph_hi = N_PHASES;
    hipLaunchKernelGGL(mk_fwd, dim3(grid), dim3(512), LDS_BYTES, stream, a);
#endif
}
```
